# Optimizing an MI355X kernel written in HIP

```python
import math
import jax, jax.numpy as jnp
from jax import lax
import numpy as np

D_MODEL = 2048
BATCH = 4
SEQ = 4096
DEPTH = 2

HEAD_DIM = 128
MLA_HEADS = 6
MLA_Q_LORA = 512
MLA_KV_LORA = 512
MLA_NOPE = 128
MLA_ROPE = 64
MLA_V = 128
MOBA_HEADS = 5
MOBA_BLOCK = 256
MOBA_TOPK = 3
MOBA_QCHUNK = 32
SB_HEADS = 5
N_BRANCH = 3
ATTN_QBLK = 128
ROPE_THETA = 10000.0
MEM_LEN = 256
XATTN_HEADS = 4
XATTN_HEAD_DIM = D_MODEL // XATTN_HEADS
D_FF = 5632
N_EXPERTS = 8
MOE_TOPK = 2
D_FF_EXPERT = 7168
MOE_BLOCK = 256
RMS_EPS = 1e-6
MAX_POS_OFFSET = 1024
IN_WIDTHS = (MLA_Q_LORA, MLA_KV_LORA, MLA_ROPE, 3 * MOBA_HEADS * HEAD_DIM, 3 * SB_HEADS * HEAD_DIM, N_BRANCH * D_MODEL)
IN_COLS = sum(IN_WIDTHS)

kernel_name = 'hybrid_mla_moba_stickbreaking_moe_block'


def rms_norm(x, g):
    xf = x.astype(jnp.float32)
    y = xf * lax.rsqrt(jnp.mean(xf * xf, axis=-1, keepdims=True) + RMS_EPS)
    return (y * g.astype(jnp.float32)).astype(x.dtype)


def rope(x, positions):
    half = x.shape[-1] // 2
    inv_freq = ROPE_THETA ** (-jnp.arange(half, dtype=jnp.float32) / half)
    ang = positions.astype(jnp.float32)[..., None] * inv_freq
    cos = jnp.cos(ang)[:, :, None, :].astype(x.dtype)
    sin = jnp.sin(ang)[:, :, None, :].astype(x.dtype)
    x1, x2 = x[..., :half], x[..., half:]
    return jnp.concatenate([x1 * cos - x2 * sin, x2 * cos + x1 * sin], axis=-1)


def to_query_blocks(t, blk):
    B, S = t.shape[:2]
    return jnp.moveaxis(t.reshape((B, S // blk, blk) + t.shape[2:]), 1, 0)


def from_query_blocks(t):
    n, B, blk = t.shape[:3]
    return jnp.moveaxis(t, 0, 1).reshape((B, n * blk) + t.shape[3:])


def causal_softmax_attention(q, k, v, scale):
    S = q.shape[1]
    kpos = jnp.arange(S)

    def block(args):
        qb, i = args
        s = jnp.einsum('bqhd,bkhd->bhqk', qb, k, preferred_element_type=jnp.float32) * scale
        qpos = i * ATTN_QBLK + jnp.arange(ATTN_QBLK)
        s = jnp.where(kpos[None, :] <= qpos[:, None], s, -jnp.inf)
        p = jax.nn.softmax(s, axis=-1).astype(v.dtype)
        return jnp.einsum('bhqk,bkhd->bqhd', p, v)

    out = lax.map(block, (to_query_blocks(q, ATTN_QBLK), jnp.arange(S // ATTN_QBLK)))
    return from_query_blocks(out)


def stick_breaking_attention(q, k, v):
    S, d = q.shape[1], q.shape[-1]
    scale = d ** -0.5
    kpos = jnp.arange(S)

    def block(args):
        qb, i = args
        z = jnp.einsum('bqhd,bkhd->bhqk', qb, k, preferred_element_type=jnp.float32) * scale
        qpos = i * ATTN_QBLK + jnp.arange(ATTN_QBLK)
        strict = kpos[None, :] < qpos[:, None]
        log_one_minus_beta = jnp.where(strict, jax.nn.log_sigmoid(-z), 0.0)
        later = lax.cumsum(log_one_minus_beta, axis=3, reverse=True) - log_one_minus_beta
        a = jnp.where(strict, jnp.exp(jax.nn.log_sigmoid(z) + later), 0.0).astype(v.dtype)
        return jnp.einsum('bhqk,bkhd->bqhd', a, v)

    out = lax.map(block, (to_query_blocks(q, ATTN_QBLK), jnp.arange(S // ATTN_QBLK)))
    return from_query_blocks(out)


def moba_attention(q, k, v):
    B, S, H, d = q.shape
    scale = d ** -0.5
    nb = -(-S // MOBA_BLOCK)
    pad = nb * MOBA_BLOCK - S
    padw = ((0, 0), (0, pad), (0, 0), (0, 0))
    kt = jnp.pad(k, padw).transpose(0, 2, 1, 3).reshape(B, H, nb, MOBA_BLOCK, d)
    vt = jnp.pad(v, padw).transpose(0, 2, 1, 3).reshape(B, H, nb, MOBA_BLOCK, d)
    qt = q.transpose(0, 2, 1, 3)
    k_mean = jnp.mean(kt, axis=3)
    gate = jnp.einsum('bhsd,bhnd->bhsn', qt, k_mean, preferred_element_type=jnp.float32)
    q_block = jnp.arange(S) // MOBA_BLOCK
    fully_past = jnp.arange(nb)[None, :] < q_block[:, None]
    gate = jnp.where(fully_past, gate, -jnp.inf)
    n_sel = min(MOBA_TOPK, nb)
    _, sel = lax.top_k(gate, n_sel)
    n_chunks = S // MOBA_QCHUNK
    q_chunks = jnp.moveaxis(qt.reshape(B, H, n_chunks, MOBA_QCHUNK, d), 2, 0)
    sel_chunks = jnp.moveaxis(sel.reshape(B, H, n_chunks, MOBA_QCHUNK, n_sel), 2, 0)
    b_idx = jnp.arange(B)[:, None, None, None]
    h_idx = jnp.arange(H)[None, :, None, None]
    kpos_blk = jnp.arange(MOBA_BLOCK)
    n_sel_keys = n_sel * MOBA_BLOCK

    def chunk(args):
        qc, sc, c = args
        q0 = c * MOBA_QCHUNK
        own = q0 // MOBA_BLOCK
        qpos = q0 + jnp.arange(MOBA_QCHUNK)
        k_sel = kt[b_idx, h_idx, sc]
        v_sel = vt[b_idx, h_idx, sc]
        s_sel = jnp.einsum('bhqd,bhqnkd->bhqnk', qc, k_sel, preferred_element_type=jnp.float32) * scale
        s_sel = jnp.where((sc < own)[..., None], s_sel, -jnp.inf)
        k_own = lax.dynamic_index_in_dim(kt, own, axis=2, keepdims=False)
        v_own = lax.dynamic_index_in_dim(vt, own, axis=2, keepdims=False)
        s_own = jnp.einsum('bhqd,bhkd->bhqk', qc, k_own, preferred_element_type=jnp.float32) * scale
        s_own = jnp.where(own * MOBA_BLOCK + kpos_blk[None, :] <= qpos[:, None], s_own, -jnp.inf)
        s_all = jnp.concatenate([s_sel.reshape(B, H, MOBA_QCHUNK, n_sel_keys), s_own], axis=-1)
        p = jax.nn.softmax(s_all, axis=-1).astype(v.dtype)
        p_sel = p[..., :n_sel_keys].reshape(B, H, MOBA_QCHUNK, n_sel, MOBA_BLOCK)
        return (jnp.einsum('bhqnk,bhqnkd->bhqd', p_sel, v_sel)
                + jnp.einsum('bhqk,bhkd->bhqd', p[..., n_sel_keys:], v_own))

    out = lax.map(chunk, (q_chunks, sel_chunks, jnp.arange(n_chunks)))
    return jnp.moveaxis(out, 0, 2).reshape(B, H, S, d).transpose(0, 2, 1, 3)


def hybrid_mixer(h, positions, w_in, g_cq, g_ckv, w_uq, w_ukv, w_up_a, w_up_b, w_up_c, w_o):
    B, S, D = h.shape
    splits = [int(s) for s in np.cumsum(IN_WIDTHS)[:-1]]
    z_cq, z_ckv, z_kr, z_b, z_c, z_g = jnp.split(h @ w_in, splits, axis=-1)
    q_a = (rms_norm(z_cq, g_cq) @ w_uq).reshape(B, S, MLA_HEADS, MLA_NOPE + MLA_ROPE)
    kv_a = (rms_norm(z_ckv, g_ckv) @ w_ukv).reshape(B, S, MLA_HEADS, MLA_NOPE + MLA_V)
    k_pe = rope(z_kr[:, :, None, :], positions)
    q_a = jnp.concatenate([q_a[..., :MLA_NOPE], rope(q_a[..., MLA_NOPE:], positions)], axis=-1)
    k_a = jnp.concatenate([kv_a[..., :MLA_NOPE], jnp.broadcast_to(k_pe, (B, S, MLA_HEADS, MLA_ROPE))], axis=-1)
    o_a = causal_softmax_attention(q_a, k_a, kv_a[..., MLA_NOPE:], (MLA_NOPE + MLA_ROPE) ** -0.5)
    zb = z_b.reshape(B, S, 3, MOBA_HEADS, HEAD_DIM)
    o_b = moba_attention(rope(zb[:, :, 0], positions), rope(zb[:, :, 1], positions), zb[:, :, 2])
    zc = z_c.reshape(B, S, 3, SB_HEADS, HEAD_DIM)
    o_c = stick_breaking_attention(zc[:, :, 0], zc[:, :, 1], zc[:, :, 2])
    g = jax.nn.sigmoid(z_g).reshape(B, S, N_BRANCH, D)
    merged = (g[:, :, 0] * (o_a.reshape(B, S, -1) @ w_up_a)
              + g[:, :, 1] * (o_b.reshape(B, S, -1) @ w_up_b)
              + g[:, :, 2] * (o_c.reshape(B, S, -1) @ w_up_c))
    return merged @ w_o


def memory_cross_attention(h, m, w_q, w_k, w_v, w_o):
    B, S, D = h.shape
    M = m.shape[1]
    q = (h @ w_q).reshape(B, S, XATTN_HEADS, XATTN_HEAD_DIM)
    k = (m @ w_k).reshape(B, M, XATTN_HEADS, XATTN_HEAD_DIM)
    v = (m @ w_v).reshape(B, M, XATTN_HEADS, XATTN_HEAD_DIM)
    s = jnp.einsum('bshd,bmhd->bhsm', q, k, preferred_element_type=jnp.float32) * XATTN_HEAD_DIM ** -0.5
    p = jax.nn.softmax(s, axis=-1).astype(v.dtype)
    o = jnp.einsum('bhsm,bmhd->bshd', p, v).reshape(B, S, D)
    return o @ w_o


def swiglu(h, w1, w3, w2):
    return (jax.nn.silu(h @ w1) * (h @ w3)) @ w2


def moe_swiglu(h, w_router, w_e1, w_e3, w_e2):
    B, S, D = h.shape
    T = B * S
    TK = T * MOE_TOPK
    ht = h.reshape(T, D)
    logits = jnp.matmul(ht, w_router, preferred_element_type=jnp.float32)
    top_val, top_idx = lax.top_k(logits, MOE_TOPK)
    gate = jax.nn.softmax(top_val, axis=-1)
    flat_e = top_idx.reshape(-1)
    flat_t = jnp.arange(TK, dtype=jnp.int32) // MOE_TOPK
    flat_g = gate.reshape(-1)
    order = jnp.argsort(flat_e)
    se, st, sg = flat_e[order], flat_t[order], flat_g[order]
    counts = jnp.bincount(flat_e, length=N_EXPERTS)
    padded = (counts + MOE_BLOCK - 1) // MOE_BLOCK * MOE_BLOCK
    start = jnp.cumsum(counts) - counts
    pad_end = jnp.cumsum(padded)
    pad_start = pad_end - padded
    dest = pad_start[se] + jnp.arange(TK) - start[se]
    n_blocks = -(-TK // MOE_BLOCK) + N_EXPERTS
    n_slots = n_blocks * MOE_BLOCK
    slot_tok = jnp.full((n_slots,), T, jnp.int32).at[dest].set(st)
    slot_g = jnp.zeros((n_slots,), jnp.float32).at[dest].set(sg)
    block_e = jnp.minimum(jnp.searchsorted(pad_end, jnp.arange(n_blocks) * MOE_BLOCK, side='right'), N_EXPERTS - 1)
    h_pad = jnp.concatenate([ht, jnp.zeros((1, D), ht.dtype)], axis=0)
    xs = h_pad[slot_tok].reshape(n_blocks, MOE_BLOCK, D)

    def expert_block(args):
        xb, e = args
        return (jax.nn.silu(xb @ w_e1[e]) * (xb @ w_e3[e])) @ w_e2[e]

    ys = lax.map(expert_block, (xs, block_e)).reshape(n_slots, D)
    ys = ys * slot_g[:, None].astype(ys.dtype)
    out = jnp.zeros((T + 1, D), ys.dtype).at[slot_tok].add(ys)[:T]
    return out.reshape(B, S, D)


def setup_inputs(seed: int = 0) -> dict:
    key = jax.random.key(seed)
    ks = jax.random.split(key, 40)
    f32 = jnp.float32
    D = D_MODEL
    n_dense = (DEPTH + 1) // 2
    n_moe = DEPTH // 2

    def w(k, shape, fan_in):
        return jax.random.normal(k, shape, f32) * fan_in ** -0.5

    def gain(k, shape):
        return 1.0 + 0.02 * jax.random.normal(k, shape, f32)

    x = jax.random.normal(ks[0], (BATCH, SEQ, D), f32)
    mem = jax.random.normal(ks[1], (BATCH, MEM_LEN, D), f32)
    positions = (jnp.arange(SEQ, dtype=jnp.int32)[None, :]
                 + jax.random.randint(ks[2], (BATCH, 1), 0, MAX_POS_OFFSET, dtype=jnp.int32))
    return {
        'x': x,
        'mem': mem,
        'positions': positions,
        'g_mix': gain(ks[3], (DEPTH, D)),
        'w_in': w(ks[4], (DEPTH, D, IN_COLS), D),
        'g_cq': gain(ks[5], (DEPTH, MLA_Q_LORA)),
        'g_ckv': gain(ks[6], (DEPTH, MLA_KV_LORA)),
        'w_uq': w(ks[7], (DEPTH, MLA_Q_LORA, MLA_HEADS * (MLA_NOPE + MLA_ROPE)), MLA_Q_LORA),
        'w_ukv': w(ks[8], (DEPTH, MLA_KV_LORA, MLA_HEADS * (MLA_NOPE + MLA_V)), MLA_KV_LORA),
        'w_up_a': w(ks[9], (DEPTH, MLA_HEADS * MLA_V, D), MLA_HEADS * MLA_V),
        'w_up_b': w(ks[10], (DEPTH, MOBA_HEADS * HEAD_DIM, D), MOBA_HEADS * HEAD_DIM),
        'w_up_c': w(ks[11], (DEPTH, SB_HEADS * HEAD_DIM, D), SB_HEADS * HEAD_DIM),
        'w_o': w(ks[12], (DEPTH, D, D), D),
        'g_x': gain(ks[13], (DEPTH, D)),
        'g_mem': gain(ks[14], (DEPTH, D)),
        'w_xq': w(ks[15], (DEPTH, D, D), D),
        'w_xk': w(ks[16], (DEPTH, D, D), D),
        'w_xv': w(ks[17], (DEPTH, D, D), D),
        'w_xo': w(ks[18], (DEPTH, D, D), D),
        'g_ffn': gain(ks[19], (DEPTH, D)),
        'w_ff1': w(ks[20], (n_dense, D, D_FF), D),
        'w_ff3': w(ks[21], (n_dense, D, D_FF), D),
        'w_ff2': w(ks[22], (n_dense, D_FF, D), D_FF),
        'w_router': w(ks[23], (n_moe, D, N_EXPERTS), D),
        'w_e1': w(ks[24], (n_moe, N_EXPERTS, D, D_FF_EXPERT), D),
        'w_e3': w(ks[25], (n_moe, N_EXPERTS, D, D_FF_EXPERT), D),
        'w_e2': w(ks[26], (n_moe, N_EXPERTS, D_FF_EXPERT, D), D_FF_EXPERT),
        'g_final': gain(ks[27], (D,)),
    }


def reference(x, mem, positions, g_mix, w_in, g_cq, g_ckv, w_uq, w_ukv, w_up_a, w_up_b, w_up_c, w_o,
              g_x, g_mem, w_xq, w_xk, w_xv, w_xo, g_ffn, w_ff1, w_ff3, w_ff2,
              w_router, w_e1, w_e3, w_e2, g_final):
    h = x
    for l in range(DEPTH):
        h = h + hybrid_mixer(rms_norm(h, g_mix[l]), positions, w_in[l], g_cq[l], g_ckv[l], w_uq[l], w_ukv[l],
                             w_up_a[l], w_up_b[l], w_up_c[l], w_o[l])
        h = h + memory_cross_attention(rms_norm(h, g_x[l]), rms_norm(mem, g_mem[l]),
                                       w_xq[l], w_xk[l], w_xv[l], w_xo[l])
        hn = rms_norm(h, g_ffn[l])
        if l % 2 == 0:
            h = h + swiglu(hn, w_ff1[l // 2], w_ff3[l // 2], w_ff2[l // 2])
        else:
            h = h + moe_swiglu(hn, w_router[l // 2], w_e1[l // 2], w_e3[l // 2], w_e2[l // 2])
    return rms_norm(h, g_final)
```

```cpp
#include <hip/hip_runtime.h>
#include <cstdio>
#include <cstdint>

#define LAS __attribute__((address_space(3)))
#define DI __device__ __forceinline__
typedef unsigned short bf16_t;
typedef short bf16x8 __attribute__((ext_vector_type(8)));
typedef short s16x4 __attribute__((ext_vector_type(4)));
typedef float f32x2 __attribute__((ext_vector_type(2)));
typedef float f32x4 __attribute__((ext_vector_type(4)));
typedef float f32x16 __attribute__((ext_vector_type(16)));
typedef unsigned u32x2 __attribute__((ext_vector_type(2)));
typedef unsigned u32x4 __attribute__((ext_vector_type(4)));
typedef __bf16 bf16x2_t __attribute__((ext_vector_type(2)));

#ifndef SIMPLE_GEMM
#define SIMPLE_GEMM 0
#endif
#ifndef N_LAUNCH_MODE
#define N_LAUNCH_MODE 1
#endif

constexpr int NB = 4, SEQ = 4096, T = NB * SEQ, D = 2048;
constexpr int IN_COLS = 11072, NIN = 11264;
constexpr int DFF = 5632, NEXP = 8, DFE = 7168;
constexpr int NSLOT_BLK = 136, NSLOT = NSLOT_BLK * 256;
constexpr float EPS = 1e-6f;
constexpr float LOG2E = 1.4426950408889634f;
constexpr int NWAVES = 8, NTHR = 512;

constexpr size_t MiB = 1u << 20;
constexpr size_t WS_CTL = 0, CTL_BYTES = 4 * MiB;
constexpr size_t WS_WIN = 4 * MiB;
constexpr size_t SZ_WIN = (size_t)NIN * D * 2;
constexpr size_t WS_WUQ = WS_WIN + 2 * SZ_WIN;
constexpr size_t SZ_WUQ = (size_t)1280 * 512 * 2;
constexpr size_t WS_WUKV = WS_WUQ + 2 * SZ_WUQ;
constexpr size_t SZ_WUKV = (size_t)1536 * 512 * 2;
constexpr size_t SZ_SQ = (size_t)D * D * 2;
constexpr size_t WS_WUP = WS_WUKV + 2 * SZ_WUKV;
constexpr size_t WS_WO = WS_WUP + 2 * SZ_SQ;
constexpr size_t WS_WXQ = WS_WO + 2 * SZ_SQ;
constexpr size_t WS_WXK = WS_WXQ + 2 * SZ_SQ;
constexpr size_t WS_WXV = WS_WXK + 2 * SZ_SQ;
constexpr size_t WS_WXO = WS_WXV + 2 * SZ_SQ;
constexpr size_t WS_WFF13 = WS_WXO + 2 * SZ_SQ;
constexpr size_t WS_WFF2 = WS_WFF13 + SZ_WIN;
constexpr size_t SZ_WFF2 = (size_t)D * DFF * 2;
constexpr size_t WS_WE13 = WS_WFF2 + SZ_WFF2;
constexpr size_t SZ_WE13 = (size_t)2 * DFE * D * 2;
constexpr size_t WS_WE2 = WS_WE13 + NEXP * SZ_WE13;
constexpr size_t SZ_WE2 = (size_t)D * DFE * 2;
constexpr size_t WS_HB = WS_WE2 + NEXP * SZ_WE2;
constexpr size_t WS_CS128 = WS_HB + (size_t)T * D * 2;
constexpr size_t WS_CS64 = WS_CS128 + (size_t)T * 64 * 8;
constexpr size_t WS_MEMN = WS_CS64 + (size_t)T * 32 * 8;
constexpr size_t WS_KMEM = WS_MEMN + 8 * MiB;
constexpr size_t WS_VMEMT = WS_KMEM + 8 * MiB;
constexpr size_t WS_TOK = WS_VMEMT + 8 * MiB;
constexpr size_t WS_R1 = WS_TOK + 1 * MiB;
constexpr size_t WS_R2 = WS_R1 + 512 * MiB;
constexpr size_t WS_END = WS_R2 + 288 * MiB;
constexpr size_t R1_ZC = 0, R1_KPE = 32 * MiB, R1_MQK = 34 * MiB, R1_PL = 74 * MiB, R1_G = 154 * MiB;
constexpr size_t R1_ACT = 0;
constexpr size_t R1_ACTE = 0;
static_assert((size_t)NSLOT * DFE * 2 <= 512 * MiB && R1_G + (size_t)T * 6144 * 2 <= 512 * MiB, "R1");
constexpr size_t R2_QA = 0, R2_KVA = 36 * MiB, R2_OCAT = 84 * MiB, R2_MERGED = 148 * MiB;
constexpr size_t R2_QX = 0, R2_PX = 64 * MiB, R2_OX = 96 * MiB;
constexpr size_t R2_XS = 0, R2_YS = 136 * MiB;
static_assert(R2_YS + (size_t)NSLOT * D * 2 <= 288 * MiB, "R2");

constexpr int CW_BAR = 4096;
constexpr int CW_QUEUE = 8192;
constexpr int CW_MOE = 9216;
constexpr int CW_STAT = 16384;
constexpr int CW_KSUM = CW_STAT + 20 * T;
constexpr int KSUM_L = NB * 16 * 5 * 128;
static_assert((size_t)(CW_KSUM + 2 * KSUM_L) * 4 <= CTL_BYTES, "ctl");
enum { ST_MIX = 0, ST_CQ = 1, ST_CKV = 2, ST_X = 3, ST_FFN = 4 };

constexpr int LDS_STAGE = 131072;
constexpr int LDS_EPI = LDS_STAGE;
constexpr int LDS_MISC = LDS_STAGE + 8192;
constexpr int LDS_BYTES = 147456;

DI unsigned cvt_pk_bf16(float lo, float hi) { f32x2 v = {lo, hi}; bf16x2_t b = __builtin_convertvector(v, bf16x2_t); return __builtin_bit_cast(unsigned, b); }
DI u32x4 pack8(f32x4 a, f32x4 b) { u32x4 w; w.x = cvt_pk_bf16(a[0], a[1]); w.y = cvt_pk_bf16(a[2], a[3]); w.z = cvt_pk_bf16(b[0], b[1]); w.w = cvt_pk_bf16(b[2], b[3]); return w; }
DI float bf_lo(unsigned w) { return __uint_as_float(w << 16); }
DI float bf_hi(unsigned w) { return __uint_as_float(w & 0xffff0000u); }
typedef unsigned long long stat_t;
constexpr float STAT_SCALE = 16777216.0f, STAT_INV = 1.0f / 16777216.0f;
DI void atomic_adds(stat_t* p, float v) { __hip_atomic_fetch_add(p, (stat_t)(v * STAT_SCALE), __ATOMIC_RELAXED, __HIP_MEMORY_SCOPE_AGENT); }
DI void atomic_addf(float* p, float v) { __hip_atomic_fetch_add(p, v, __ATOMIC_RELAXED, __HIP_MEMORY_SCOPE_AGENT); }
DI float wave_sum(float v) {
#pragma unroll
    for (int o = 1; o < 64; o <<= 1) v += __shfl_xor(v, o);
    return v;
}
DI float fast_exp2(float x) { return __builtin_amdgcn_exp2f(x); }
DI float fast_log2(float x) { return __builtin_amdgcn_logf(x); }
DI float fast_rcp(float x) { return __builtin_amdgcn_rcpf(x); }
DI float sigmoidf_(float x) { return fast_rcp(1.0f + fast_exp2(-x * LOG2E)); }

#define XB_TMO      128
#define XB_XCNT(j)  (256  + 64 * (j))
#define XB_XSUB(j)  (1280 + 64 * (j))
#define XB_XGEN(j)  (2304 + 64 * (j))
#define XB_TOP      3328
#define XB_TOPGEN   3392
#define XCD_BAR_WORDS 3456
#define XB_SPIN_CAP (1u << 18)

__device__ __forceinline__ unsigned xb_ld(unsigned* p)              { return __hip_atomic_load(p, __ATOMIC_RELAXED, __HIP_MEMORY_SCOPE_AGENT); }
__device__ __forceinline__ unsigned xb_add(unsigned* p, unsigned v) { return __hip_atomic_fetch_add(p, v, __ATOMIC_RELAXED, __HIP_MEMORY_SCOPE_AGENT); }
__device__ __forceinline__ unsigned xb_xcc_id() { return (unsigned)__builtin_amdgcn_s_getreg((3 << 11) | 20) & 0xFu; }
#define XB_SPIN(cond, bar) do { unsigned _sp = 0; while (cond) { __builtin_amdgcn_s_sleep(1); \
    if ((++_sp & 255u) == 0u) { if (xb_ld(&(bar)[XB_TMO])) break; if (_sp > XB_SPIN_CAP) { atomicAdd(&(bar)[XB_TMO], 1u); break; } } } } while (0)

struct XcdBarrier { unsigned* bar; unsigned x; volatile LAS unsigned* st; };

__device__ __forceinline__ XcdBarrier xcd_barrier_post(unsigned* bar, volatile LAS unsigned* st) {
    XcdBarrier b; b.bar = bar; b.x = xb_xcc_id(); b.st = st;
    if (threadIdx.x == 0) (void)xb_add(&bar[XB_XCNT(b.x)], 1u);
    return b;
}
__device__ __forceinline__ void xcd_barrier_complete(unsigned* bar, unsigned x, unsigned& nloc, unsigned& nx) {
    const unsigned G = gridDim.x * gridDim.y * gridDim.z;
    unsigned sum, cnt, mine, sp = 0u;
    for (;;) {
        sum = 0u; cnt = 0u; mine = 0u;
#pragma unroll
        for (unsigned j = 0; j < 16; ++j) { const unsigned c = xb_ld(&bar[XB_XCNT(j)]); sum += c; cnt += (c > 0u) ? 1u : 0u; mine = (j == x) ? c : mine; }
        if (sum == G) break;
        __builtin_amdgcn_s_sleep(1);
        if ((++sp & 255u) == 0u) { if (xb_ld(&bar[XB_TMO])) break; if (sp > XB_SPIN_CAP) { atomicAdd(&bar[XB_TMO], 1u); break; } }
    }
    nloc = mine > 0u ? mine : 1u; nx = cnt > 0u ? cnt : 1u;
}
__device__ __forceinline__ void xcd_barrier(const XcdBarrier& b) {
    asm volatile("s_waitcnt vmcnt(0)" ::: "memory");
    __syncthreads();
    if (threadIdx.x == 0) {
        unsigned* bar = b.bar; asm volatile("" : "+s"(bar));
        __builtin_amdgcn_s_waitcnt(0);
        unsigned nloc = b.st[0], nx = b.st[1];
        if (nloc == 0u) { xcd_barrier_complete(bar, b.x, nloc, nx); b.st[0] = nloc; b.st[1] = nx; }
        const unsigned old = xb_add(&bar[XB_XSUB(b.x)], 1u);
        const unsigned gen = old / nloc;
        if (old + 1u == (gen + 1u) * nloc) {
            __builtin_amdgcn_fence(__ATOMIC_RELEASE, "agent");
            asm volatile("s_waitcnt vmcnt(0)" ::: "memory");
            const unsigned og = xb_add(&bar[XB_TOP], 1u);
            const unsigned tg = og / nx;
            if (og + 1u == (tg + 1u) * nx) xb_add(&bar[XB_TOPGEN], 1u);
            else XB_SPIN(xb_ld(&bar[XB_TOPGEN]) == tg, bar);
            __builtin_amdgcn_fence(__ATOMIC_ACQUIRE, "agent");
            xb_add(&bar[XB_XGEN(b.x)], 1u);
            asm volatile("s_waitcnt vmcnt(0)" ::: "memory");
        } else {
            XB_SPIN(xb_ld(&bar[XB_XGEN(b.x)]) == gen, bar);
            __builtin_amdgcn_fence(__ATOMIC_ACQUIRE, "agent");
            asm volatile("s_waitcnt vmcnt(0)" ::: "memory");
        }
    }
    __syncthreads();
}

namespace pg8 {
constexpr int BM = 256, BK = 64, HALF = 128, HTB = HALF * BK * 2, STAGE_BYTES = 8 * HTB, NXCD = 8, WGM = 8;
DI int lds_byte(int r, int c) { const int st = (r >> 4) * 2 + (c >> 5), rr = r & 15, cc = c & 31, ob = rr * 64 + cc * 2; return st * 1024 + (ob ^ (((ob >> 9) & 1) << 5)); }
DI void stage_rc(int b, int& R, int& C) { const int st = b / 1024, sb = b % 1024, swz = sb ^ (((sb >> 9) & 1) << 5); R = (st >> 1) * 16 + swz / 64; C = (st & 1) * 32 + (swz % 64) / 2; }
DI int perm32(int rho) { const int n = rho >> 4, i = rho & 15; return 8 * (i >> 2) + 4 * n + (i & 3); }

struct Unit { int pm, pn, aux, nt; const char* a; const char* b; };

DI void tile_order(int L, int nM, int nN, int& pm, int& pn) {
    const int nwg = nM * nN; int wgid = L;
    { const int q = nwg / NXCD, r = nwg % NXCD, xcd = wgid % NXCD, off = wgid / NXCD; wgid = (xcd < r ? xcd * (q + 1) : r * (q + 1) + (xcd - r) * q) + off; }
    const int nig = WGM * nN, gid = wgid / nig, fm = gid * WGM, gsz = (nM - fm) < WGM ? (nM - fm) : WGM;
    pm = fm + ((wgid % nig) % gsz); pn = (wgid % nig) / gsz;
}

typedef f32x4 Acc[2][2][4][2];

#if !SIMPLE_GEMM
template <class Epi, class Sched, bool ALIGN_EPI = false>
DI void gemm_phase(LAS unsigned char* lds, const int lda, const int ldb, const Sched& S, const Epi& E) {
    int tid_ = threadIdx.x; asm volatile("" : "+v"(tid_));
    const int tid = tid_, wid = __builtin_amdgcn_readfirstlane(tid >> 6), lane = tid & 63, wr = wid >> 2, wc = wid & 3, fr = lane & 15, fq = lane >> 4;
    unsigned voffA[2], voffB[2];
#pragma unroll
    for (int i = 0; i < 2; ++i) { int R, C; stage_rc(tid * 16 + i * 8192, R, C); const int Rb = (R & ~31) + perm32(R & 31);
        voffA[i] = (unsigned)(R * lda + C * 2); voffB[i] = (unsigned)(Rb * ldb + C * 2); }
    const size_t kstep = (size_t)(BK * 2);
    const size_t hstepA = (size_t)HALF * lda, hstepB = (size_t)HALF * ldb;
    const unsigned ldsw = (unsigned)wid * 1024u;
    const int aoff = lds_byte(wr * 64 + fr, fq * 8), boff = lds_byte(wc * 32 + fr, fq * 8);
#define PG8_SA(b, h) (((b) * 2 + (h)) * HTB)
#define PG8_SB(b, h) ((4 + (b) * 2 + (h)) * HTB)
#define PG8_STAGE(bufoff, gbase, voff) do { _Pragma("unroll") for (int _i = 0; _i < 2; ++_i) \
        __builtin_amdgcn_global_load_lds((const unsigned*)((const char*)(gbase) + (voff)[_i]), (LAS unsigned*)(lds + (bufoff) + ldsw + _i * 8192), 16, 0, 0); } while (0)
#define PG8_LDA(dst, b, h) do { _Pragma("unroll") for (int m = 0; m < 4; ++m) _Pragma("unroll") for (int k = 0; k < 2; ++k) dst[m][k] = *(const LAS bf16x8*)(lds + PG8_SA(b, h) + aoff + m * 2048 + k * 1024); } while (0)
#define PG8_LDB(dst, b, h) do { _Pragma("unroll") for (int n = 0; n < 2; ++n) _Pragma("unroll") for (int k = 0; k < 2; ++k) dst[n][k] = *(const LAS bf16x8*)(lds + PG8_SB(b, h) + boff + n * 2048 + k * 1024); } while (0)
#define PG8_MMA(ai, bj, At, Bt) do { __builtin_amdgcn_s_setprio(1); _Pragma("unroll") for (int m = 0; m < 4; ++m) _Pragma("unroll") for (int n = 0; n < 2; ++n) _Pragma("unroll") for (int k = 0; k < 2; ++k) \
        acc[ai][bj][m][n] = __builtin_amdgcn_mfma_f32_16x16x32_bf16(Bt[n][k], At[m][k], acc[ai][bj][m][n], 0, 0, 0); __builtin_amdgcn_s_setprio(0); } while (0)
#define PG8_WAIT_V(n) asm volatile("s_waitcnt vmcnt(" #n ")" ::: "memory")
#define PG8_WAIT_L(n) asm volatile("s_waitcnt lgkmcnt(" #n ")" ::: "memory")
#define PG8_BAR __builtin_amdgcn_s_barrier()
#define PG8_SCHED __builtin_amdgcn_sched_barrier(0)
    Unit cur, nxt; int ui = 0;
    if (!S.next(0, cur)) return;
    Acc acc;
#pragma unroll
    for (int a = 0; a < 2; ++a)
#pragma unroll
        for (int b = 0; b < 2; ++b)
#pragma unroll
            for (int m = 0; m < 4; ++m)
#pragma unroll
                for (int n = 0; n < 2; ++n) acc[a][b][m][n] = (f32x4){0.f, 0.f, 0.f, 0.f};
    bf16x8 At[4][2], B0[2][2], B1[2][2];
    const char* cA = cur.a; const char* cB = cur.b;
    PG8_STAGE(PG8_SB(0, 0), cB, voffB); PG8_STAGE(PG8_SB(0, 1), cB + hstepB, voffB); PG8_STAGE(PG8_SA(0, 0), cA, voffA); PG8_STAGE(PG8_SA(0, 1), cA + hstepA, voffA);
    if (wr == 1) PG8_BAR;
    PG8_WAIT_V(2); PG8_BAR;
    PG8_STAGE(PG8_SB(1, 0), cB + kstep, voffB); PG8_STAGE(PG8_SA(1, 0), cA + kstep, voffA); PG8_STAGE(PG8_SB(1, 1), cB + hstepB + kstep, voffB);
    PG8_WAIT_V(6); PG8_BAR;
    for (;;) {
        const bool has_next = S.next(ui + 1, nxt);
        const char* nA = has_next ? nxt.a : cA; const char* nB = has_next ? nxt.b : cB;
        const int nt = cur.nt;
        for (int t = 0; t < nt; t += 2) {
            const bool last = (t == nt - 2);
            const char* a1 = cA + (size_t)(t + 1) * kstep;
            const char* a2 = last ? nA : cA + (size_t)(t + 2) * kstep; const char* b2 = last ? nB : cB + (size_t)(t + 2) * kstep;
            const char* a3 = a2 + kstep; const char* b3 = b2 + kstep;
            PG8_LDB(B0, 0, 0); PG8_LDB(B1, 0, 1); PG8_SCHED; PG8_LDA(At, 0, 0); PG8_STAGE(PG8_SA(1, 1), a1 + hstepA, voffA);
            PG8_WAIT_V(8); PG8_WAIT_L(0); PG8_BAR; PG8_MMA(0, 0, At, B0); PG8_MMA(0, 1, At, B1); PG8_BAR; PG8_SCHED;
            PG8_LDA(At, 0, 1); PG8_STAGE(PG8_SB(0, 0), b2, voffB); PG8_STAGE(PG8_SB(0, 1), b2 + hstepB, voffB); PG8_STAGE(PG8_SA(0, 0), a2, voffA);
            PG8_WAIT_V(8); PG8_WAIT_L(0); PG8_BAR; PG8_MMA(1, 0, At, B0); PG8_MMA(1, 1, At, B1); PG8_BAR; PG8_SCHED;
            PG8_LDB(B0, 1, 0); PG8_LDB(B1, 1, 1); PG8_SCHED; PG8_LDA(At, 1, 0); PG8_STAGE(PG8_SA(0, 1), a2 + hstepA, voffA);
            PG8_WAIT_V(8); PG8_WAIT_L(0); PG8_BAR; PG8_MMA(0, 0, At, B0); PG8_MMA(0, 1, At, B1); PG8_BAR; PG8_SCHED;
            PG8_LDA(At, 1, 1); PG8_STAGE(PG8_SB(1, 0), b3, voffB); PG8_STAGE(PG8_SB(1, 1), b3 + hstepB, voffB); PG8_STAGE(PG8_SA(1, 0), a3, voffA);
            PG8_WAIT_V(8); PG8_WAIT_L(0); PG8_BAR; PG8_MMA(1, 0, At, B0); PG8_MMA(1, 1, At, B1); PG8_BAR; PG8_SCHED;
        }
        if constexpr (ALIGN_EPI) { if (wr == 0) PG8_BAR; }
        const bool keep = E(acc, cur, wr, wc, fr, fq);
        if (!has_next) break;
        if (!keep) {
#pragma unroll
            for (int a = 0; a < 2; ++a)
#pragma unroll
                for (int b = 0; b < 2; ++b)
#pragma unroll
                    for (int m = 0; m < 4; ++m)
#pragma unroll
                        for (int n = 0; n < 2; ++n) acc[a][b][m][n] = (f32x4){0.f, 0.f, 0.f, 0.f};
        }
        cur = nxt; cA = nA; cB = nB; ++ui;
        if constexpr (ALIGN_EPI) { if (wr == 1) PG8_BAR; }
    }
    PG8_WAIT_V(0);
    if constexpr (!ALIGN_EPI) { if (wr == 0) PG8_BAR; }
    PG8_BAR;
#undef PG8_SA
#undef PG8_SB
#undef PG8_STAGE
#undef PG8_LDA
#undef PG8_LDB
#undef PG8_MMA
#undef PG8_WAIT_V
#undef PG8_WAIT_L
#undef PG8_BAR
#undef PG8_SCHED
}
#else
template <class Epi, class Sched, bool ALIGN_EPI = false>
DI void gemm_phase(LAS unsigned char* lds, const int lda, const int ldb, const Sched& S, const Epi& E) {
    const int tid = threadIdx.x, wid = __builtin_amdgcn_readfirstlane(tid >> 6), lane = tid & 63, wr = wid >> 2, wc = wid & 3, fr = lane & 15, fq = lane >> 4;
    Unit cur; Acc acc; bool keep = false;
    for (int ui = 0; S.next(ui, cur); ++ui) {
        if (!keep) {
#pragma unroll
            for (int a = 0; a < 2; ++a)
#pragma unroll
                for (int b = 0; b < 2; ++b)
#pragma unroll
                    for (int m = 0; m < 4; ++m)
#pragma unroll
                        for (int n = 0; n < 2; ++n) acc[a][b][m][n] = (f32x4){0.f, 0.f, 0.f, 0.f};
        }
        for (int k0 = 0; k0 < cur.nt * 64; k0 += 32) {
            bf16x8 Af[2][4], Bf[2][2];
#pragma unroll
            for (int ai = 0; ai < 2; ++ai)
#pragma unroll
                for (int m = 0; m < 4; ++m) Af[ai][m] = *(const bf16x8*)(cur.a + (size_t)(ai * 128 + wr * 64 + m * 16 + fr) * lda + (size_t)(k0 + fq * 8) * 2);
#pragma unroll
            for (int bj = 0; bj < 2; ++bj)
#pragma unroll
                for (int n = 0; n < 2; ++n) Bf[bj][n] = *(const bf16x8*)(cur.b + (size_t)(bj * 128 + wc * 32 + perm32(n * 16 + fr)) * ldb + (size_t)(k0 + fq * 8) * 2);
#pragma unroll
            for (int ai = 0; ai < 2; ++ai)
#pragma unroll
                for (int bj = 0; bj < 2; ++bj)
#pragma unroll
                    for (int m = 0; m < 4; ++m)
#pragma unroll
                        for (int n = 0; n < 2; ++n) acc[ai][bj][m][n] = __builtin_amdgcn_mfma_f32_16x16x32_bf16(Bf[bj][n], Af[ai][m], acc[ai][bj][m][n], 0, 0, 0);
        }
        if constexpr (ALIGN_EPI) __syncthreads();
        keep = E(acc, cur, wr, wc, fr, fq);
        if constexpr (ALIGN_EPI) __syncthreads();
    }
    __syncthreads();
}
#endif

struct SchedGrid {
    const char* A; const char* Bt; int lda, ldb, nM, nN, nt, G, c, pn0;
    DI bool next(int i, Unit& u) const {
        const long L = (long)i * G + c; if (L >= (long)nM * nN) return false;
        tile_order((int)L, nM, nN, u.pm, u.pn); u.pn += pn0; u.aux = 0; u.nt = nt;
        u.a = A + (size_t)u.pm * 256 * lda; u.b = Bt + (size_t)u.pn * 256 * ldb; return true;
    }
};
}

namespace epi {
using pg8::Acc; using pg8::Unit;
DI float row_rs(const stat_t* stat, int row, float inv_n) { return 1.0f / sqrtf((float)stat[row] * STAT_INV * inv_n + EPS); }

DI void stat_atomics(const float (&ss)[2][4], stat_t* stat, int row0, int fq) {
#pragma unroll
    for (int ai = 0; ai < 2; ++ai)
#pragma unroll
        for (int m = 0; m < 4; ++m) { float s = ss[ai][m]; s += __shfl_xor(s, 16); s += __shfl_xor(s, 32);
            if (fq == 0) atomic_adds(stat + row0 + ai * 128 + m * 16, s); }
}

template <int EMASK> struct EpiIn {
    const stat_t* stat_in; bf16_t* ZC; bf16_t* KPE; bf16_t* MQK; bf16_t* PL; bf16_t* G;
    stat_t* stat_cq; stat_t* stat_ckv; float* ksum; const f32x2* cs128; const f32x2* cs64;
    DI bool operator()(Acc& acc, const Unit& u, int wr, int wc, int fr, int fq) const {
        const int row0 = u.pm * 256 + wr * 64 + fr, tile = u.pn;
        if ((EMASK & 1) && tile < 4) {
            float ss[2][4];
#pragma unroll
            for (int ai = 0; ai < 2; ++ai)
#pragma unroll
                for (int m = 0; m < 4; ++m) { const int row = row0 + ai * 128 + m * 16; const float rsv = row_rs(stat_in, row, 1.0f / D); asm volatile("" ::: "memory"); float s = 0.f;
#pragma unroll
                    for (int bj = 0; bj < 2; ++bj) { const f32x4 v0 = acc[ai][bj][m][0] * rsv, v1 = acc[ai][bj][m][1] * rsv;
                        s += (v0[0] * v0[0] + v0[1] * v0[1]) + (v0[2] * v0[2] + v0[3] * v0[3]) + (v1[0] * v1[0] + v1[1] * v1[1]) + (v1[2] * v1[2] + v1[3] * v1[3]);
                        *(u32x4*)(ZC + (size_t)row * 1024 + tile * 256 + bj * 128 + wc * 32 + 8 * fq) = pack8(v0, v1); }
                    ss[ai][m] = s; }
            stat_atomics(ss, tile < 2 ? stat_cq : stat_ckv, row0, fq);
        } else if ((EMASK & 2) && tile == 4) {
            if (wc == 0) {
#pragma unroll
                for (int ai = 0; ai < 2; ++ai)
#pragma unroll
                    for (int m = 0; m < 4; ++m) { const int row = row0 + ai * 128 + m * 16; const float rsv = row_rs(stat_in, row, 1.0f / D); asm volatile("" ::: "memory"); const f32x2* cs = cs64 + (size_t)row * 32 + 8 * fq;
                        f32x4 o1[2], o2[2];
#pragma unroll
                        for (int n = 0; n < 2; ++n)
#pragma unroll
                            for (int e = 0; e < 4; ++e) { const f32x2 c = cs[4 * n + e]; const float x1 = acc[ai][0][m][n][e] * rsv, x2 = acc[ai][1][m][n][e] * rsv;
                                o1[n][e] = x1 * c.x - x2 * c.y; o2[n][e] = x2 * c.x + x1 * c.y; }
                        *(u32x4*)(KPE + (size_t)row * 64 + 8 * fq) = pack8(o1[0], o1[1]);
                        *(u32x4*)(KPE + (size_t)row * 64 + 32 + 8 * fq) = pack8(o2[0], o2[1]); }
            }
        } else if ((EMASK & 4) && tile < 10) {
            const int tt = tile - 5, hd = 2 * tt + (wc >> 1), dl0 = (32 * wc + 8 * fq) & 63;
            f32x4 cs1[2], cs2[2];
#pragma unroll
            for (int n = 0; n < 2; ++n) { cs1[n] = (f32x4){0.f, 0.f, 0.f, 0.f}; cs2[n] = (f32x4){0.f, 0.f, 0.f, 0.f}; }
#pragma unroll
            for (int ai = 0; ai < 2; ++ai)
#pragma unroll
                for (int m = 0; m < 4; ++m) { const int row = row0 + ai * 128 + m * 16; const float rsv = row_rs(stat_in, row, 1.0f / D); asm volatile("" ::: "memory"); const f32x2* cs = cs128 + (size_t)row * 64 + dl0;
                    f32x4 o1[2], o2[2];
#pragma unroll
                    for (int n = 0; n < 2; ++n)
#pragma unroll
                        for (int e = 0; e < 4; ++e) { const f32x2 c = cs[4 * n + e]; const float x1 = acc[ai][0][m][n][e] * rsv, x2 = acc[ai][1][m][n][e] * rsv;
                            o1[n][e] = x1 * c.x - x2 * c.y; o2[n][e] = x2 * c.x + x1 * c.y; }
                    *(u32x4*)(MQK + (size_t)row * 1280 + hd * 128 + dl0) = pack8(o1[0], o1[1]);
                    *(u32x4*)(MQK + (size_t)row * 1280 + hd * 128 + 64 + dl0) = pack8(o2[0], o2[1]);
                    cs1[0] += o1[0]; cs1[1] += o1[1]; cs2[0] += o2[0]; cs2[1] += o2[1]; }
            if (hd >= 5) {
                float* kd = ksum + ((size_t)u.pm * 5 + (hd - 5)) * 128 + dl0;
#pragma unroll
                for (int n = 0; n < 2; ++n)
#pragma unroll
                    for (int e = 0; e < 4; ++e) { float a = cs1[n][e], b = cs2[n][e];
#pragma unroll
                        for (int o = 1; o < 16; o <<= 1) { a += __shfl_xor(a, o); b += __shfl_xor(b, o); }
                        if (fr == 0) { atomic_addf(kd + 4 * n + e, a); atomic_addf(kd + 64 + 4 * n + e, b); } }
            }
        } else if ((EMASK & 8) && tile < 20) {
#pragma unroll
            for (int ai = 0; ai < 2; ++ai)
#pragma unroll
                for (int m = 0; m < 4; ++m) { const int row = row0 + ai * 128 + m * 16; const float rsv = row_rs(stat_in, row, 1.0f / D); asm volatile("" ::: "memory");
#pragma unroll
                    for (int bj = 0; bj < 2; ++bj)
                        *(u32x4*)(PL + (size_t)row * 2560 + (tile - 10) * 256 + bj * 128 + wc * 32 + 8 * fq) = pack8(acc[ai][bj][m][0] * rsv, acc[ai][bj][m][1] * rsv); }
        } else if (EMASK & 16) {
#pragma unroll
            for (int ai = 0; ai < 2; ++ai)
#pragma unroll
                for (int m = 0; m < 4; ++m) { const int row = row0 + ai * 128 + m * 16; const float rsv = row_rs(stat_in, row, 1.0f / D); asm volatile("" ::: "memory");
#pragma unroll
                    for (int bj = 0; bj < 2; ++bj) { f32x4 v0 = acc[ai][bj][m][0] * rsv, v1 = acc[ai][bj][m][1] * rsv;
#pragma unroll
                        for (int e = 0; e < 4; ++e) { v0[e] = fmaxf(sigmoidf_(v0[e]), 1e-18f); v1[e] = fmaxf(sigmoidf_(v1[e]), 1e-18f); }
                        *(u32x4*)(G + (size_t)row * 6144 + (tile - 20) * 256 + bj * 128 + wc * 32 + 8 * fq) = pack8(v0, v1); } }
        }
        return false;
    }
};

struct EpiPlain {
    bf16_t* O; int ldo; const stat_t* stat; float inv_n;
    DI bool operator()(Acc& acc, const Unit& u, int wr, int wc, int fr, int fq) const {
        const int row0 = u.pm * 256 + wr * 64 + fr;
#pragma unroll
        for (int ai = 0; ai < 2; ++ai)
#pragma unroll
            for (int m = 0; m < 4; ++m) { const int row = row0 + ai * 128 + m * 16; const float r = stat ? row_rs(stat, row, inv_n) : 1.0f;
#pragma unroll
                for (int bj = 0; bj < 2; ++bj)
                    *(u32x4*)(O + (size_t)row * ldo + u.pn * 256 + bj * 128 + wc * 32 + 8 * fq) = pack8(acc[ai][bj][m][0] * r, acc[ai][bj][m][1] * r); }
        return false;
    }
};

struct EpiUQ {
    bf16_t* QA; const stat_t* stat; const f32x2* cs64;
    DI bool operator()(Acc& acc, const Unit& u, int wr, int wc, int fr, int fq) const {
        const int row0 = u.pm * 256 + wr * 64 + fr, tile = u.pn;
#pragma unroll
        for (int ai = 0; ai < 2; ++ai)
#pragma unroll
            for (int m = 0; m < 4; ++m) { const int row = row0 + ai * 128 + m * 16; const float r = row_rs(stat, row, 1.0f / 512);
                if (tile < 3) {
#pragma unroll
                    for (int bj = 0; bj < 2; ++bj) { const int h = tile * 2 + bj;
                        *(u32x4*)(QA + (size_t)row * 1152 + h * 192 + wc * 32 + 8 * fq) = pack8(acc[ai][bj][m][0] * r, acc[ai][bj][m][1] * r); }
                } else { const int h = (tile - 3) * 4 + wc;
                    if (h < 6) { const f32x2* cs = cs64 + (size_t)row * 32 + 8 * fq; f32x4 o1[2], o2[2];
#pragma unroll
                        for (int n = 0; n < 2; ++n)
#pragma unroll
                            for (int e = 0; e < 4; ++e) { const f32x2 c = cs[4 * n + e]; const float x1 = acc[ai][0][m][n][e] * r, x2 = acc[ai][1][m][n][e] * r;
                                o1[n][e] = x1 * c.x - x2 * c.y; o2[n][e] = x2 * c.x + x1 * c.y; }
                        *(u32x4*)(QA + (size_t)row * 1152 + h * 192 + 128 + 8 * fq) = pack8(o1[0], o1[1]);
                        *(u32x4*)(QA + (size_t)row * 1152 + h * 192 + 160 + 8 * fq) = pack8(o2[0], o2[1]); } } }
        return false;
    }
};

struct EpiUp {
    const bf16_t* G; bf16_t* MERGED;
    DI bool operator()(Acc& acc, const Unit& u, int wr, int wc, int fr, int fq) const {
        const int row0 = u.pm * 256 + wr * 64 + fr, br = u.aux;
#pragma unroll
        for (int ai = 0; ai < 2; ++ai)
#pragma unroll
            for (int m = 0; m < 4; ++m) { const int row = row0 + ai * 128 + m * 16;
#pragma unroll
                for (int bj = 0; bj < 2; ++bj) { const int col = u.pn * 256 + bj * 128 + wc * 32 + 8 * fq;
                    const u32x4 ga = *(const u32x4*)(G + (size_t)row * 6144 + br * 2048 + col);
                    float f[8];
                    if (br < 2) { const u32x4 gb = *(const u32x4*)(G + (size_t)row * 6144 + (br + 1) * 2048 + col);
#pragma unroll
                        for (int q = 0; q < 4; ++q) { f[2 * q] = bf_lo(ga[q]) * fast_rcp(bf_lo(gb[q])); f[2 * q + 1] = bf_hi(ga[q]) * fast_rcp(bf_hi(gb[q])); }
                    } else {
#pragma unroll
                        for (int q = 0; q < 4; ++q) { f[2 * q] = bf_lo(ga[q]); f[2 * q + 1] = bf_hi(ga[q]); } }
#pragma unroll
                    for (int e = 0; e < 4; ++e) { acc[ai][bj][m][0][e] *= f[e]; acc[ai][bj][m][1][e] *= f[4 + e]; }
                    if (br == 2) *(u32x4*)(MERGED + (size_t)row * D + col) = pack8(acc[ai][bj][m][0], acc[ai][bj][m][1]); } }
        return br < 2;
    }
};

struct EpiRes {
    float* H; bf16_t* HB; stat_t* stat;
    DI bool operator()(Acc& acc, const Unit& u, int wr, int wc, int fr, int fq) const {
        const int row0 = u.pm * 256 + wr * 64 + fr; float ss[2][4];
#pragma unroll
        for (int ai = 0; ai < 2; ++ai)
#pragma unroll
            for (int m = 0; m < 4; ++m) { const int row = row0 + ai * 128 + m * 16; float s = 0.f;
#pragma unroll
                for (int bj = 0; bj < 2; ++bj) { const size_t off = (size_t)row * D + u.pn * 256 + bj * 128 + wc * 32 + 8 * fq;
                    const f32x4 v0 = *(const f32x4*)(H + off) + acc[ai][bj][m][0], v1 = *(const f32x4*)(H + off + 4) + acc[ai][bj][m][1];
                    *(f32x4*)(H + off) = v0; *(f32x4*)(H + off + 4) = v1; *(u32x4*)(HB + off) = pack8(v0, v1);
                    s += (v0[0] * v0[0] + v0[1] * v0[1]) + (v0[2] * v0[2] + v0[3] * v0[3]) + (v1[0] * v1[0] + v1[1] * v1[1]) + (v1[2] * v1[2] + v1[3] * v1[3]); }
                ss[ai][m] = s; }
        stat_atomics(ss, stat, row0, fq);
        return false;
    }
};

struct EpiSwiglu {
    bf16_t* O; int ldo; const stat_t* stat;
    DI bool operator()(Acc& acc, const Unit& u, int wr, int wc, int fr, int fq) const {
        const int row0 = u.pm * 256 + wr * 64 + fr;
#pragma unroll
        for (int ai = 0; ai < 2; ++ai)
#pragma unroll
            for (int m = 0; m < 4; ++m) { const int row = row0 + ai * 128 + m * 16; const float r = stat ? row_rs(stat, row, 1.0f / D) : 1.0f;
                f32x4 o[2];
#pragma unroll
                for (int n = 0; n < 2; ++n)
#pragma unroll
                    for (int e = 0; e < 4; ++e) { const float a = acc[ai][0][m][n][e] * r, b = acc[ai][1][m][n][e] * r; o[n][e] = a * sigmoidf_(a) * b; }
                *(u32x4*)(O + (size_t)row * ldo + u.pn * 128 + wc * 32 + 8 * fq) = pack8(o[0], o[1]); }
        return false;
    }
};

struct EpiXS {
    bf16_t* PX; LAS float* scr;
    DI bool operator()(Acc& acc, const Unit& u, int wr, int wc, int fr, int fq) const {
        const int row0 = u.pm * 256 + wr * 64 + fr;
        float mx[2][4];
#pragma unroll
        for (int ai = 0; ai < 2; ++ai)
#pragma unroll
            for (int m = 0; m < 4; ++m) { float v = -3.0e38f;
#pragma unroll
                for (int bj = 0; bj < 2; ++bj)
#pragma unroll
                    for (int n = 0; n < 2; ++n)
#pragma unroll
                        for (int e = 0; e < 4; ++e) v = fmaxf(v, acc[ai][bj][m][n][e]);
                v = fmaxf(v, __shfl_xor(v, 16)); v = fmaxf(v, __shfl_xor(v, 32));
                if (fq == 0) scr[(ai * 128 + wr * 64 + m * 16 + fr) * 4 + wc] = v; }
        asm volatile("s_waitcnt lgkmcnt(0)" ::: "memory"); __builtin_amdgcn_s_barrier(); asm volatile("" ::: "memory");
#pragma unroll
        for (int ai = 0; ai < 2; ++ai)
#pragma unroll
            for (int m = 0; m < 4; ++m) { const f32x4 q = *(const LAS f32x4*)(scr + (ai * 128 + wr * 64 + m * 16 + fr) * 4);
                const float mxr = fmaxf(fmaxf(q[0], q[1]), fmaxf(q[2], q[3])); float s = 0.f;
#pragma unroll
                for (int bj = 0; bj < 2; ++bj)
#pragma unroll
                    for (int n = 0; n < 2; ++n)
#pragma unroll
                        for (int e = 0; e < 4; ++e) { const float p = fast_exp2(acc[ai][bj][m][n][e] - mxr); acc[ai][bj][m][n][e] = p; s += p; }
                s += __shfl_xor(s, 16); s += __shfl_xor(s, 32);
                if (fq == 0) scr[1024 + (ai * 128 + wr * 64 + m * 16 + fr) * 4 + wc] = s; mx[ai][m] = 0.f; }
        asm volatile("s_waitcnt lgkmcnt(0)" ::: "memory"); __builtin_amdgcn_s_barrier(); asm volatile("" ::: "memory");
#pragma unroll
        for (int ai = 0; ai < 2; ++ai)
#pragma unroll
            for (int m = 0; m < 4; ++m) { const int row = row0 + ai * 128 + m * 16; const f32x4 q = *(const LAS f32x4*)(scr + 1024 + (ai * 128 + wr * 64 + m * 16 + fr) * 4);
                const float inv = 1.0f / ((q[0] + q[1]) + (q[2] + q[3]));
#pragma unroll
                for (int bj = 0; bj < 2; ++bj)
                    *(u32x4*)(PX + (size_t)row * 1024 + u.pn * 256 + bj * 128 + wc * 32 + 8 * fq) = pack8(acc[ai][bj][m][0] * inv, acc[ai][bj][m][1] * inv); }
        (void)mx;
        return false;
    }
};
}

namespace pg8 {
struct SchedUp {
    const char* A; const char* Bt; int G, c;
    DI bool next(int i, Unit& u) const {
        const int tr = i / 3, br = i - 3 * tr; const long L = (long)tr * G + c; if (L >= 64 * 8) return false;
        tile_order((int)L, 64, 8, u.pm, u.pn); u.aux = br; u.nt = br == 0 ? 12 : 10;
        const int koff = br == 0 ? 0 : (br == 1 ? 768 : 1408);
        u.a = A + ((size_t)u.pm * 256 * D + koff) * 2; u.b = Bt + ((size_t)u.pn * 256 * D + koff) * 2; return true;
    }
};
struct SchedXS {
    const char* QX; const char* KM; int G, c;
    DI bool next(int i, Unit& u) const {
        const long L = (long)i * G + c; if (L >= 256) return false;
        const int hd = (int)L & 3, rt = (int)L >> 2;
        u.pm = rt; u.pn = hd; u.aux = 0; u.nt = 8;
        u.a = QX + ((size_t)rt * 256 * D + hd * 512) * 2; u.b = KM + ((size_t)(rt >> 4) * 256 * D + hd * 512) * 2; return true;
    }
};
struct SchedXPV {
    const char* PX; const char* VT; int G, c;
    DI bool next(int i, Unit& u) const {
        const long L = (long)i * G + c; if (L >= 512) return false;
        const int pn = (int)L & 7, rt = (int)L >> 3;
        u.pm = rt; u.pn = pn; u.aux = 0; u.nt = 4;
        u.a = PX + ((size_t)rt * 256 * 1024 + (pn >> 1) * 256) * 2; u.b = VT + ((size_t)pn * 256 * 1024 + (rt >> 4) * 256) * 2; return true;
    }
};
struct SchedMoE {
    const char* A; const char* Bt; int lda, nN, nt, G, c; size_t wstride; int nused; int bend[8];
    DI void init_counts(const unsigned* counts) { int b = 0;
#pragma unroll
        for (int e = 0; e < 8; ++e) { const unsigned cnt = __hip_atomic_load(counts + 64 * e, __ATOMIC_RELAXED, __HIP_MEMORY_SCOPE_AGENT); b += (int)((cnt + 255u) >> 8); bend[e] = b; }
        nused = b; }
    DI bool next(int i, Unit& u) const {
        const long L = (long)i * G + c; if (L >= (long)nused * nN) return false;
        tile_order((int)L, nused, nN, u.pm, u.pn); u.aux = 0; u.nt = nt;
        int e = 0;
#pragma unroll
        for (int q = 0; q < 7; ++q) e += (u.pm >= bend[q]) ? 1 : 0;
        u.a = A + (size_t)u.pm * 256 * lda; u.b = Bt + (size_t)e * wstride + (size_t)u.pn * 256 * (size_t)(nt * 128); return true;
    }
};
}

struct Params {
    const float* x; const float* mem; const int* positions;
    const float *g_mix, *w_in, *g_cq, *g_ckv, *w_uq, *w_ukv, *w_up_a, *w_up_b, *w_up_c, *w_o, *g_x, *g_mem, *w_xq, *w_xk, *w_xv, *w_xo, *g_ffn, *w_ff1, *w_ff3, *w_ff2, *w_router, *w_e1, *w_e3, *w_e2, *g_final;
    float* out; unsigned char* ws; int ph_lo, ph_hi;
};
struct Frame { LAS unsigned char* lds; int tid, lane, wave, G, bid; };
typedef const __attribute__((address_space(4))) Params* KPtr;
#define KP_HERE KPtr kp = (KPtr)__builtin_amdgcn_kernarg_segment_ptr(); asm volatile("" : "+s"(kp));
#define FRAME_HERE Frame F; { int t_ = threadIdx.x, b_ = blockIdx.x, g_ = gridDim.x; asm volatile("" : "+v"(t_)); asm volatile("" : "+s"(b_), "+s"(g_)); \
        F.lds = (LAS unsigned char*)lds_; F.tid = t_; F.lane = t_ & 63; F.wave = __builtin_amdgcn_readfirstlane(t_ >> 6); F.G = g_; F.bid = b_; }


template <class Map>
DI void transpose_cvt(const Frame& F, const float* __restrict__ W, int ldw, int K, bf16_t* __restrict__ dst, int ldd, int koff, int ngroups, const float* __restrict__ gain, Map map, int& rot) {
    LAS float* scr = (LAS float*)(F.lds + F.wave * 16384);
    const int NGW = F.G * NWAVES, gw = F.bid * NWAVES + F.wave, lane = F.lane;
    const int items = (K / 64) * ngroups;
    int it = gw - rot; if (it < 0) it += NGW;
    for (; it < items; it += NGW) {
        const int kb = it / ngroups, ng = it - kb * ngroups, k0 = kb * 64;
        int src; float sc; map(ng, src, sc);
        const int c8 = lane & 7;
        if (src == -2) continue;
        if (src < 0) {
#pragma unroll
            for (int j = 0; j < 4; ++j) { const int n = (lane >> 3) + 8 * j; *(u32x4*)(dst + (size_t)(ng * 32 + n) * ldd + koff + k0 + 8 * c8) = (u32x4){0u, 0u, 0u, 0u}; }
            continue;
        }
        f32x4 v[8];
#pragma unroll
        for (int i = 0; i < 8; ++i) { const int kk = 8 * i + (lane >> 3); v[i] = *(const f32x4*)(W + (size_t)(k0 + kk) * ldw + src + 4 * c8); }
#pragma unroll
        for (int i = 0; i < 8; ++i) { const int kk = 8 * i + (lane >> 3); const float g = (gain ? gain[k0 + kk] : 1.0f) * sc;
            LAS float* s = scr + kk * 33 + 4 * c8; s[0] = v[i][0] * g; s[1] = v[i][1] * g; s[2] = v[i][2] * g; s[3] = v[i][3] * g; }
        asm volatile("s_waitcnt lgkmcnt(0)" ::: "memory");
#pragma unroll
        for (int j = 0; j < 4; ++j) { const int n = (lane >> 3) + 8 * j; const LAS float* s = scr + (8 * c8) * 33 + n;
            u32x4 o; o.x = cvt_pk_bf16(s[0 * 33], s[1 * 33]); o.y = cvt_pk_bf16(s[2 * 33], s[3 * 33]); o.z = cvt_pk_bf16(s[4 * 33], s[5 * 33]); o.w = cvt_pk_bf16(s[6 * 33], s[7 * 33]);
            *(u32x4*)(dst + (size_t)(ng * 32 + n) * ldd + koff + k0 + 8 * c8) = o; }
        asm volatile("s_waitcnt lgkmcnt(0)" ::: "memory");
    }
    rot = (rot + items) % NGW;
}

DI void prologue(const Frame& F, KPtr kp) {
    unsigned char* ws = kp->ws; int rot = 0;
    const float QS128 = 0.08838834764831845f * LOG2E, QS192 = 0.07216878364870322f * LOG2E, QS512 = 0.04419417382415922f * LOG2E;
    for (int l = 0; l < 2; ++l) {
        transpose_cvt(F, kp->w_in + (size_t)l * D * IN_COLS, IN_COLS, D, (bf16_t*)(ws + WS_WIN + l * SZ_WIN), D, 0, NIN / 32, kp->g_mix + l * D,
            [=](int ng, int& src, float& sc) { sc = 1.0f; const int n = ng * 32;
                if (n < 1024) { src = n; }
                else if (n < 1280) { const int p = n - 1024; src = (p == 0) ? 1024 : (p == 128 ? 1056 : -1); }
                else if (n < 2560) { const int tt = (n - 1280) >> 8, p = (n - 1280) & 255, bj = p >> 7, pp = p & 127, hd = 2 * tt + (pp >> 6), d = (pp & 63) + 64 * bj; src = 1088 + hd * 128 + d; if (hd < 5) sc = QS128; }
                else if (n < 5120) { src = 2368 + (n - 2560); if (src >= 3008 && src < 3648) sc = QS128; }
                else { src = 4928 + (n - 5120); } }, rot);
        transpose_cvt(F, kp->w_uq + (size_t)l * 512 * 1152, 1152, 512, (bf16_t*)(ws + WS_WUQ + l * SZ_WUQ), 512, 0, 1280 / 32, kp->g_cq + l * 512,
            [=](int ng, int& src, float& sc) { sc = QS192; const int n = ng * 32;
                if (n < 768) { src = (n >> 7) * 192 + (n & 127); }
                else { const int rt = (n - 768) >> 8, p = (n - 768) & 255, bj = p >> 7, hh = (p & 127) >> 5, h = 4 * rt + hh; src = h < 6 ? h * 192 + 128 + 32 * bj : -1; } }, rot);
        transpose_cvt(F, kp->w_ukv + (size_t)l * 512 * 1536, 1536, 512, (bf16_t*)(ws + WS_WUKV + l * SZ_WUKV), 512, 0, 1536 / 32, kp->g_ckv + l * 512,
            [=](int ng, int& src, float& sc) { sc = 1.0f; src = ng * 32; }, rot);
        bf16_t* wup = (bf16_t*)(ws + WS_WUP + l * SZ_SQ);
        transpose_cvt(F, kp->w_up_a + (size_t)l * 768 * D, D, 768, wup, D, 0, D / 32, nullptr, [=](int ng, int& src, float& sc) { sc = 1.0f; src = ng * 32; }, rot);
        transpose_cvt(F, kp->w_up_b + (size_t)l * 640 * D, D, 640, wup, D, 768, D / 32, nullptr, [=](int ng, int& src, float& sc) { sc = 1.0f; src = ng * 32; }, rot);
        transpose_cvt(F, kp->w_up_c + (size_t)l * 640 * D, D, 640, wup, D, 1408, D / 32, nullptr, [=](int ng, int& src, float& sc) { sc = 1.0f; src = ng * 32; }, rot);
        transpose_cvt(F, kp->w_o + (size_t)l * D * D, D, D, (bf16_t*)(ws + WS_WO + l * SZ_SQ), D, 0, D / 32, nullptr, [=](int ng, int& src, float& sc) { sc = 1.0f; src = ng * 32; }, rot);
        transpose_cvt(F, kp->w_xq + (size_t)l * D * D, D, D, (bf16_t*)(ws + WS_WXQ + l * SZ_SQ), D, 0, D / 32, kp->g_x + l * D, [=](int ng, int& src, float& sc) { sc = QS512; src = ng * 32; }, rot);
        transpose_cvt(F, kp->w_xk + (size_t)l * D * D, D, D, (bf16_t*)(ws + WS_WXK + l * SZ_SQ), D, 0, D / 32, nullptr, [=](int ng, int& src, float& sc) { sc = 1.0f; src = ng * 32; }, rot);
        transpose_cvt(F, kp->w_xv + (size_t)l * D * D, D, D, (bf16_t*)(ws + WS_WXV + l * SZ_SQ), D, 0, D / 32, nullptr, [=](int ng, int& src, float& sc) { sc = 1.0f; src = ng * 32; }, rot);
        transpose_cvt(F, kp->w_xo + (size_t)l * D * D, D, D, (bf16_t*)(ws + WS_WXO + l * SZ_SQ), D, 0, D / 32, nullptr, [=](int ng, int& src, float& sc) { sc = 1.0f; src = ng * 32; }, rot);
    }
    { bf16_t* w13 = (bf16_t*)(ws + WS_WFF13);
      for (int half = 0; half < 2; ++half) { const float* W = half ? kp->w_ff3 : kp->w_ff1;
        transpose_cvt(F, W, DFF, D, w13, D, 0, NIN / 32, kp->g_ffn,
            [=](int ng, int& src, float& sc) { sc = 1.0f; const int t = ng >> 3, bj = (ng >> 2) & 1, q = ng & 3; src = (bj == half) ? t * 128 + q * 32 : -2; }, rot); }
      transpose_cvt(F, kp->w_ff2, D, DFF, (bf16_t*)(ws + WS_WFF2), DFF, 0, D / 32, nullptr, [=](int ng, int& src, float& sc) { sc = 1.0f; src = ng * 32; }, rot); }
    for (int e = 0; e < NEXP; ++e) {
        bf16_t* w13 = (bf16_t*)(ws + WS_WE13 + e * SZ_WE13);
        for (int half = 0; half < 2; ++half) { const float* W = (half ? kp->w_e3 : kp->w_e1) + (size_t)e * D * DFE;
            transpose_cvt(F, W, DFE, D, w13, D, 0, 2 * DFE / 32, kp->g_ffn + D,
                [=](int ng, int& src, float& sc) { sc = 1.0f; const int t = ng >> 3, bj = (ng >> 2) & 1, q = ng & 3; src = (bj == half) ? t * 128 + q * 32 : -2; }, rot); }
        transpose_cvt(F, kp->w_e2 + (size_t)e * DFE * D, D, DFE, (bf16_t*)(ws + WS_WE2 + e * SZ_WE2), DFE, 0, D / 32, nullptr, [=](int ng, int& src, float& sc) { sc = 1.0f; src = ng * 32; }, rot);
    }
    { f32x2* cs128 = (f32x2*)(ws + WS_CS128); f32x2* cs64 = (f32x2*)(ws + WS_CS64);
      const int gt = F.bid * NTHR + F.tid, NT_ = F.G * NTHR;
      for (int idx = gt; idx < T * 96; idx += NT_) { const int t = idx / 96, q = idx - t * 96;
          const float inv = q < 64 ? powf(10000.0f, -(float)q / 64.0f) : powf(10000.0f, -(float)(q - 64) / 32.0f);
          const float ang = (float)kp->positions[t] * inv;
          const double rev = (double)ang * 0.15915494309189535; const float fr = (float)(rev - floor(rev));
          const f32x2 v = {__builtin_amdgcn_cosf(fr), __builtin_amdgcn_sinf(fr)};
          if (q < 64) cs128[(size_t)t * 64 + q] = v; else cs64[(size_t)t * 32 + (q - 64)] = v; } }
    { const int gw = F.bid * NWAVES + F.wave, NGW = F.G * NWAVES, lane = F.lane;
      stat_t* stat = (stat_t*)((unsigned*)(ws + WS_CTL) + CW_STAT) + (ST_MIX * 2 + 0) * T;
      for (int r = gw; r < T + 1024; r += NGW) {
          const bool is_mem = r >= T; const float* src = is_mem ? kp->mem + (size_t)(r - T) * D : kp->x + (size_t)r * D;
          f32x4 v[8]; float s = 0.f;
#pragma unroll
          for (int j = 0; j < 8; ++j) { v[j] = *(const f32x4*)(src + 4 * lane + 256 * j); s += (v[j][0] * v[j][0] + v[j][1] * v[j][1]) + (v[j][2] * v[j][2] + v[j][3] * v[j][3]); }
          s = wave_sum(s);
          if (!is_mem) { if (lane == 0) stat[r] = (stat_t)(s * STAT_SCALE);
#pragma unroll
              for (int j = 0; j < 8; ++j) { *(f32x4*)(kp->out + (size_t)r * D + 4 * lane + 256 * j) = v[j];
                  u32x2 w; w.x = cvt_pk_bf16(v[j][0], v[j][1]); w.y = cvt_pk_bf16(v[j][2], v[j][3]); *(u32x2*)((bf16_t*)(ws + WS_HB) + (size_t)r * D + 4 * lane + 256 * j) = w; }
          } else { const float rs = 1.0f / sqrtf(s * (1.0f / D) + EPS);
              for (int l = 0; l < 2; ++l) {
#pragma unroll
                  for (int j = 0; j < 8; ++j) { const f32x4 g = *(const f32x4*)(kp->g_mem + l * D + 4 * lane + 256 * j); const f32x4 o = v[j] * rs * g;
                      u32x2 w; w.x = cvt_pk_bf16(o[0], o[1]); w.y = cvt_pk_bf16(o[2], o[3]); *(u32x2*)((bf16_t*)(ws + WS_MEMN) + ((size_t)l * 1024 + (r - T)) * D + 4 * lane + 256 * j) = w; } } }
      } }
}

DI void moe_router(const Frame& F, KPtr kp) {
    unsigned char* ws = kp->ws;
    LAS float* gwt = (LAS float*)F.lds;
    LAS int* cnt = (LAS int*)(F.lds + 65536);
    for (int i = F.tid; i < D * 8; i += NTHR) gwt[i] = kp->g_ffn[D + (i >> 3)] * kp->w_router[i];
    if (F.tid < 8) cnt[F.tid] = 0;
    __syncthreads();
    unsigned* tokE = (unsigned*)(ws + WS_TOK); f32x2* tokG = (f32x2*)(ws + WS_TOK + 65536); float* tokR = (float*)(ws + WS_TOK + 3 * 65536);
    const int lane = F.lane;
    for (int row = F.bid * NWAVES + F.wave; row < T; row += F.G * NWAVES) {
        float lg[8] = {0.f, 0.f, 0.f, 0.f, 0.f, 0.f, 0.f, 0.f}; float ss = 0.f;
#pragma unroll
        for (int j = 0; j < 8; ++j) { const f32x4 v = *(const f32x4*)(kp->out + (size_t)row * D + 4 * lane + 256 * j);
            ss += (v[0] * v[0] + v[1] * v[1]) + (v[2] * v[2] + v[3] * v[3]);
#pragma unroll
            for (int e = 0; e < 4; ++e) { const LAS f32x4* w = (const LAS f32x4*)(gwt + (size_t)(4 * lane + 256 * j + e) * 8); const f32x4 w0 = w[0], w1 = w[1];
                lg[0] += v[e] * w0[0]; lg[1] += v[e] * w0[1]; lg[2] += v[e] * w0[2]; lg[3] += v[e] * w0[3]; lg[4] += v[e] * w1[0]; lg[5] += v[e] * w1[1]; lg[6] += v[e] * w1[2]; lg[7] += v[e] * w1[3]; } }
        ss = wave_sum(ss);
#pragma unroll
        for (int e = 0; e < 8; ++e) lg[e] = wave_sum(lg[e]);
        const float r = 1.0f / sqrtf(ss * (1.0f / D) + EPS);
        int i0 = 0; float v0 = lg[0];
#pragma unroll
        for (int e = 1; e < 8; ++e) if (lg[e] > v0) { v0 = lg[e]; i0 = e; }
        int i1 = -1; float v1 = -3.0e38f;
#pragma unroll
        for (int e = 0; e < 8; ++e) if (e != i0 && lg[e] > v1) { v1 = lg[e]; i1 = e; }
        const float g0 = 1.0f / (1.0f + expf((v1 - v0) * r)), g1 = 1.0f - g0;
        if (lane == 0) { tokE[row] = (unsigned)i0 | ((unsigned)i1 << 8); tokG[row] = (f32x2){g0, g1}; tokR[row] = r;
            __hip_atomic_fetch_add(cnt + i0, 1, __ATOMIC_RELAXED, __HIP_MEMORY_SCOPE_WORKGROUP); __hip_atomic_fetch_add(cnt + i1, 1, __ATOMIC_RELAXED, __HIP_MEMORY_SCOPE_WORKGROUP); }
    }
    __syncthreads();
    if (F.tid < 8) { const int c = cnt[F.tid]; if (c) __hip_atomic_fetch_add((unsigned*)(ws + WS_CTL) + CW_MOE + 64 * F.tid, (unsigned)c, __ATOMIC_RELAXED, __HIP_MEMORY_SCOPE_AGENT); }
}
DI void moe_assign_gather(const Frame& F, KPtr kp) {
    unsigned char* ws = kp->ws;
    unsigned* ctl = (unsigned*)(ws + WS_CTL);
    const unsigned* tokE = (const unsigned*)(ws + WS_TOK); const float* tokR = (const float*)(ws + WS_TOK + 3 * 65536); int* slot = (int*)(ws + WS_TOK + 4 * 65536);
    bf16_t* XS = (bf16_t*)(ws + WS_R2 + R2_XS);
    LAS int* sl = (LAS int*)F.lds;
    int pstart[8]; { int b = 0;
#pragma unroll
        for (int e = 0; e < 8; ++e) { pstart[e] = b * 256; const unsigned c = __hip_atomic_load(ctl + CW_MOE + 64 * e, __ATOMIC_RELAXED, __HIP_MEMORY_SCOPE_AGENT); b += (int)((c + 255u) >> 8); } }
    const int lane = F.lane;
    for (int batch = F.bid; batch < T / 64; batch += F.G) {
        if (F.wave == 0) { const int t = batch * 64 + lane; const unsigned ee = tokE[t];
#pragma unroll
            for (int k = 0; k < 2; ++k) { const int ek = (int)((ee >> (8 * k)) & 0xffu); int myslot = 0;
#pragma unroll
                for (int e = 0; e < 8; ++e) { const unsigned long long mask = __ballot(ek == e);
                    if (mask) { const int leader = __ffsll((long long)mask) - 1; unsigned base = 0;
                        if (lane == leader) base = __hip_atomic_fetch_add(ctl + CW_MOE + 512 + 64 * e, (unsigned)__popcll(mask), __ATOMIC_RELAXED, __HIP_MEMORY_SCOPE_AGENT);
                        base = (unsigned)__shfl((int)base, leader);
                        if (ek == e) myslot = pstart[e] + (int)base + __popcll(mask & ((1ull << lane) - 1ull)); } }
                sl[lane * 2 + k] = myslot; slot[t * 2 + k] = myslot; } }
        __syncthreads();
        for (int j = 0; j < 8; ++j) { const int tl = F.wave * 8 + j, t = batch * 64 + tl; const int s0 = sl[tl * 2], s1 = sl[tl * 2 + 1]; const float r = tokR[t];
#pragma unroll
            for (int q = 0; q < 8; ++q) { const f32x4 v = *(const f32x4*)(kp->out + (size_t)t * D + 4 * lane + 256 * q) * r;
                u32x2 w; w.x = cvt_pk_bf16(v[0], v[1]); w.y = cvt_pk_bf16(v[2], v[3]);
                *(u32x2*)(XS + (size_t)s0 * D + 4 * lane + 256 * q) = w; *(u32x2*)(XS + (size_t)s1 * D + 4 * lane + 256 * q) = w; } }
        __syncthreads();
    }
}
DI void moe_combine_final(const Frame& F, KPtr kp) {
    unsigned char* ws = kp->ws;
    const f32x2* tokG = (const f32x2*)(ws + WS_TOK + 65536); const int* slot = (const int*)(ws + WS_TOK + 4 * 65536);
    const bf16_t* YS = (const bf16_t*)(ws + WS_R2 + R2_YS); const int lane = F.lane;
    for (int row = F.bid * NWAVES + F.wave; row < T; row += F.G * NWAVES) {
        const int s0 = slot[row * 2], s1 = slot[row * 2 + 1]; const f32x2 g = tokG[row];
        f32x4 v[8]; float ss = 0.f;
#pragma unroll
        for (int j = 0; j < 8; ++j) { const int c = 4 * lane + 256 * j; const f32x4 h = *(const f32x4*)(kp->out + (size_t)row * D + c);
            const u32x2 a = *(const u32x2*)(YS + (size_t)s0 * D + c), b = *(const u32x2*)(YS + (size_t)s1 * D + c);
            f32x4 o; o[0] = h[0] + (g.x * bf_lo(a.x) + g.y * bf_lo(b.x)); o[1] = h[1] + (g.x * bf_hi(a.x) + g.y * bf_hi(b.x)); o[2] = h[2] + (g.x * bf_lo(a.y) + g.y * bf_lo(b.y)); o[3] = h[3] + (g.x * bf_hi(a.y) + g.y * bf_hi(b.y));
            v[j] = o; ss += (o[0] * o[0] + o[1] * o[1]) + (o[2] * o[2] + o[3] * o[3]); }
        ss = wave_sum(ss); const float r = 1.0f / sqrtf(ss * (1.0f / D) + EPS);
#pragma unroll
        for (int j = 0; j < 8; ++j) { const int c = 4 * lane + 256 * j; *(f32x4*)(kp->out + (size_t)row * D + c) = v[j] * r * *(const f32x4*)(kp->g_final + c); }
    }
}

namespace att {
constexpr int SHM_V = 16384;
DI int v_st(int k, int c) { const int kk = (k & ~0xC) | ((k & 4) << 1) | ((k & 8) >> 1); return ((kk >> 3) * 4 + (c >> 5)) * 512 + ((kk & 7) * 32 + (c & 31)) * 2; }
DI int v_rd_base(int lane) { return ((lane & 3) << 3) | (((lane >> 2) & 3) << 6) | (((lane >> 4) & 1) << 5) | (((lane >> 5) & 1) << 8); }
struct Src { const bf16_t* q; const bf16_t* k; const bf16_t* k2; const bf16_t* v; bf16_t* o; int ldq, ldk, ldv; };
DI float swap_max(float x) { auto rr = __builtin_amdgcn_permlane32_swap(__float_as_uint(x), __float_as_uint(x), false, false); return fmaxf(__uint_as_float(rr[0]), __uint_as_float(rr[1])); }
DI float swap_sum(float x) { auto rr = __builtin_amdgcn_permlane32_swap(__float_as_uint(x), __float_as_uint(x), false, false); return __uint_as_float(rr[0]) + __uint_as_float(rr[1]); }
#define ATT_PK4(P, B_, OUT) do { unsigned a0 = cvt_pk_bf16(P[B_+0], P[B_+1]), a1 = cvt_pk_bf16(P[B_+2], P[B_+3]);                          \
        unsigned b0 = cvt_pk_bf16(P[B_+4], P[B_+5]), b1 = cvt_pk_bf16(P[B_+6], P[B_+7]);                                             \
        auto r0 = __builtin_amdgcn_permlane32_swap(a0, b0, false, false); auto r1 = __builtin_amdgcn_permlane32_swap(a1, b1, false, false); \
        u32x4 w = {r0[0], r1[0], r0[1], r1[1]}; OUT = __builtin_bit_cast(bf16x8, w); } while (0)

template <int KIND, int DK>
DI void tile_compute(const unsigned kaddr  , const int (&kx)[4], const unsigned vaddr  ,
                     const bf16x8 (&qr)[DK / 16], f32x16 (&o)[4], float& m_reg, float& l_reg, float& R, const int dq, const bool bmask, const bool blk_ok, const int hi) {
    constexpr int ND = DK / 16, KROW = DK * 2;
    f32x16 p0, p1;
#pragma unroll
    for (int r = 0; r < 16; ++r) { p0[r] = 0.f; p1[r] = 0.f; }
#pragma unroll
    for (int d0 = 0; d0 < ND; ++d0) {
        const LAS unsigned char* a = (const LAS unsigned char*)(size_t)(kaddr + kx[d0 & 3] + (d0 >> 2) * 128);
        const bf16x8 b0 = *(const LAS bf16x8*)a, b1 = *(const LAS bf16x8*)(a + 32 * KROW);
        p0 = __builtin_amdgcn_mfma_f32_32x32x16_bf16(b0, qr[d0], p0, 0, 0, 0);
        p1 = __builtin_amdgcn_mfma_f32_32x32x16_bf16(b1, qr[d0], p1, 0, 0, 0);
    }
    const float NEG = -__builtin_inff();
    if constexpr (KIND != 2) {
        if (bmask) {
#pragma unroll
            for (int r = 0; r < 16; ++r) { const int c = (r & 3) + 8 * (r >> 2); if (c > dq) p0[r] = NEG; if (c + 32 > dq) p1[r] = NEG; }
        }
        if constexpr (KIND == 1) {
#pragma unroll
            for (int r = 0; r < 16; ++r) { p0[r] = blk_ok ? p0[r] : NEG; p1[r] = blk_ok ? p1[r] : NEG; }
        }
        float pmax = p0[0];
#pragma unroll
        for (int r = 1; r < 16; ++r) pmax = fmaxf(pmax, p0[r]);
#pragma unroll
        for (int r = 0; r < 16; ++r) pmax = fmaxf(pmax, p1[r]);
        pmax = swap_max(pmax);
        const float mn = fmaxf(m_reg, pmax), alpha = fast_exp2(m_reg - mn); m_reg = mn;
        float ps = 0.f;
#pragma unroll
        for (int r = 0; r < 16; ++r) { p0[r] = fast_exp2(p0[r] - mn); ps += p0[r]; }
#pragma unroll
        for (int r = 0; r < 16; ++r) { p1[r] = fast_exp2(p1[r] - mn); ps += p1[r]; }
        ps = swap_sum(ps);
        l_reg = l_reg * alpha + ps;
        if (__any(alpha < 1.0f)) {
#pragma unroll
            for (int d = 0; d < 4; ++d)
#pragma unroll
                for (int r = 0; r < 16; ++r) o[d][r] *= alpha;
        }
    } else {
        float x0[16], x1[16];
#pragma unroll
        for (int r = 0; r < 16; ++r) { const int c = (r & 3) + 8 * (r >> 2);
            const float za = p0[r], zb = p1[r];
            float la = -(fmaxf(za, 0.f) + fast_log2(1.0f + fast_exp2(-fabsf(za)))), lb = -(fmaxf(zb, 0.f) + fast_log2(1.0f + fast_exp2(-fabsf(zb))));
            if (bmask) { if (!(c < dq)) la = 0.f; if (!(c + 32 < dq)) lb = 0.f; }
            x0[r] = la; x1[r] = lb; }
#pragma unroll
        for (int j = 0; j < 4; ++j) { x0[4 * j + 2] += x0[4 * j + 3]; x0[4 * j + 1] += x0[4 * j + 2]; x0[4 * j] += x0[4 * j + 1];
                                      x1[4 * j + 2] += x1[4 * j + 3]; x1[4 * j + 1] += x1[4 * j + 2]; x1[4 * j] += x1[4 * j + 1]; }
        float pair[8], gpl[8];
#pragma unroll
        for (int k = 0; k < 8; ++k) { const float g = k < 4 ? x0[4 * k] : x1[4 * (k - 4)];
            auto rr = __builtin_amdgcn_permlane32_swap(__float_as_uint(g), __float_as_uint(g), false, false);
            const float glo = __uint_as_float(rr[0]), ghi = __uint_as_float(rr[1]);
            pair[k] = glo + ghi; gpl[k] = hi ? 0.f : ghi; }
        float off[8]; { float e = R;
#pragma unroll
            for (int k = 7; k >= 0; --k) { off[k] = e + gpl[k]; e += pair[k]; }
            R = e; }
#pragma unroll
        for (int r = 0; r < 16; ++r) { const int c = (r & 3) + 8 * (r >> 2);
            float ea = fast_exp2(p0[r] + (x0[r] + off[r >> 2])), eb = fast_exp2(p1[r] + (x1[r] + off[4 + (r >> 2)]));
            if (bmask) { if (!(c < dq)) ea = 0.f; if (!(c + 32 < dq)) eb = 0.f; }
            p0[r] = ea; p1[r] = eb; }
    }
    bf16x8 pa0, pa1, pa2, pa3;
    ATT_PK4(p0, 0, pa0); ATT_PK4(p0, 8, pa1); ATT_PK4(p1, 0, pa2); ATT_PK4(p1, 8, pa3);
#define ATT_TRRD(dst, off) asm volatile("ds_read_b64_tr_b16 %0, %1 offset:%2" : "=&v"(dst) : "v"(vaddr), "i"(off) : "memory")
#define ATT_PV(d0) do { s16x4 l0, l1, l2, l3, h0, h1, h2, h3; constexpr int b_ = (d0) * 512; \
        ATT_TRRD(l0, b_); ATT_TRRD(h0, b_ + 2048); ATT_TRRD(l1, b_ + 4096); ATT_TRRD(h1, b_ + 6144); ATT_TRRD(l2, b_ + 8192); ATT_TRRD(h2, b_ + 10240); ATT_TRRD(l3, b_ + 12288); ATT_TRRD(h3, b_ + 14336); \
        asm volatile("s_waitcnt lgkmcnt(0)" ::: "memory"); __builtin_amdgcn_sched_barrier(0); \
        o[d0] = __builtin_amdgcn_mfma_f32_32x32x16_bf16((bf16x8){l0[0], l0[1], l0[2], l0[3], h0[0], h0[1], h0[2], h0[3]}, pa0, o[d0], 0, 0, 0); \
        o[d0] = __builtin_amdgcn_mfma_f32_32x32x16_bf16((bf16x8){l1[0], l1[1], l1[2], l1[3], h1[0], h1[1], h1[2], h1[3]}, pa1, o[d0], 0, 0, 0); \
        o[d0] = __builtin_amdgcn_mfma_f32_32x32x16_bf16((bf16x8){l2[0], l2[1], l2[2], l2[3], h2[0], h2[1], h2[2], h2[3]}, pa2, o[d0], 0, 0, 0); \
        o[d0] = __builtin_amdgcn_mfma_f32_32x32x16_bf16((bf16x8){l3[0], l3[1], l3[2], l3[3], h3[0], h3[1], h3[2], h3[3]}, pa3, o[d0], 0, 0, 0); } while (0)
    ATT_PV(0); ATT_PV(1); ATT_PV(2); ATT_PV(3);
#undef ATT_PV
#undef ATT_TRRD
}

template <int KIND>
DI void attn_unit(LAS unsigned char* lds, const Src& s, const int qb, const float* ksum_bh) {
    constexpr int DK = KIND == 0 ? 192 : 128, ND = DK / 16, KROW = DK * 2, SHM_K = 64 * KROW, NKC = DK / 8, NST = 64 * NKC / 512;
    int tid_ = threadIdx.x; asm volatile("" : "+v"(tid_));
    const int tid = tid_, wid = __builtin_amdgcn_readfirstlane(tid >> 6), lane = tid & 63, r32 = lane & 31, hi = lane >> 5;
    const int P0 = qb * 256, qlo = P0 + wid * 32, qpos = qlo + r32, NT = 4 * (qb + 1);
    bf16x8 qr[ND];
#pragma unroll
    for (int d0 = 0; d0 < ND; ++d0) qr[d0] = *(const bf16x8*)(s.q + (size_t)qpos * s.ldq + d0 * 16 + hi * 8);
    unsigned allowed = 0xffffffffu;
    if constexpr (KIND == 1) {
        allowed = 1u << qb;
        float v0 = -__builtin_inff(), v1 = v0, v2 = v0; int i0 = -1, i1 = -1, i2 = -1;
        for (int n = 0; n < qb; ++n) {
            const float* kp = ksum_bh + (size_t)n * 640 + hi * 8; float g = 0.f;
#pragma unroll
            for (int d0 = 0; d0 < 8; ++d0) { const f32x4 k0 = *(const f32x4*)(kp + d0 * 16), k1 = *(const f32x4*)(kp + d0 * 16 + 4); const u32x4 qw = __builtin_bit_cast(u32x4, qr[d0]);
                g += bf_lo(qw[0]) * k0[0] + bf_hi(qw[0]) * k0[1] + bf_lo(qw[1]) * k0[2] + bf_hi(qw[1]) * k0[3] + bf_lo(qw[2]) * k1[0] + bf_hi(qw[2]) * k1[1] + bf_lo(qw[3]) * k1[2] + bf_hi(qw[3]) * k1[3]; }
            g = swap_sum(g);
            if (g > v0) { v2 = v1; i2 = i1; v1 = v0; i1 = i0; v0 = g; i0 = n; } else if (g > v1) { v2 = v1; i2 = i1; v1 = g; i1 = n; } else if (g > v2) { v2 = g; i2 = n; }
        }
        if (i0 >= 0) allowed |= 1u << i0; if (i1 >= 0) allowed |= 1u << i1; if (i2 >= 0) allowed |= 1u << i2;
    }
    f32x16 o[4];
#pragma unroll
    for (int d = 0; d < 4; ++d)
#pragma unroll
        for (int r = 0; r < 16; ++r) o[d][r] = 0.f;
    float m_reg = -1e30f, l_reg = 0.f, R = 0.f;
    LAS unsigned char* Vl = lds; LAS unsigned char* Kl = lds + 2 * SHM_V;
    const int sr = tid >> 4, sc = (tid & 15) * 8, vst0 = v_st(sr, sc), vst1 = v_st(32 + sr, sc);
    int kwo[NST]; const bf16_t* ksrc[NST]; int kstr[NST];
#pragma unroll
    for (int i = 0; i < NST; ++i) { const int ci = tid + 512 * i, row = ci / NKC, cc = ci - row * NKC; kwo[i] = row * KROW + ((cc * 16) ^ ((row & 7) << 4));
        if (KIND == 0 && cc >= 16) { ksrc[i] = s.k2 + (size_t)row * 64 + (cc - 16) * 8; kstr[i] = 64; } else { ksrc[i] = s.k + (size_t)row * s.ldk + cc * 8; kstr[i] = s.ldk; } }
    const unsigned vbase = (unsigned)(unsigned long long)Vl + (unsigned)v_rd_base(lane);
    const unsigned kbase = (unsigned)(unsigned long long)Kl + (unsigned)(r32 * KROW);
    int kx[4];
#pragma unroll
    for (int dd = 0; dd < 4; ++dd) kx[dd] = (dd * 32 + hi * 16) ^ ((r32 & 7) << 4);
    bf16x8 stK[NST], stV[2];
#define ATT_LOADT(t) do { const int kb_ = (t) * 64; stV[0] = *(const bf16x8*)(s.v + (size_t)(kb_ + sr) * s.ldv + sc); stV[1] = *(const bf16x8*)(s.v + (size_t)(kb_ + 32 + sr) * s.ldv + sc); \
        _Pragma("unroll") for (int i = 0; i < NST; ++i) stK[i] = *(const bf16x8*)(ksrc[i] + (size_t)kb_ * kstr[i]); } while (0)
#define ATT_WRITET(buf) do { *(LAS bf16x8*)(Vl + (buf) * SHM_V + vst0) = stV[0]; *(LAS bf16x8*)(Vl + (buf) * SHM_V + vst1) = stV[1]; \
        _Pragma("unroll") for (int i = 0; i < NST; ++i) *(LAS bf16x8*)(Kl + (buf) * SHM_K + kwo[i]) = stK[i]; } while (0)
#define ATT_TILE(i_) ((KIND == 2) ? (NT - 1 - (i_)) : (i_))
#define ATT_STEP(BUF, i_) do { const int t_ = ATT_TILE(i_), kb_ = t_ * 64; \
        if ((i_) + 1 < NT) ATT_LOADT(ATT_TILE((i_) + 1)); \
        if (kb_ <= qlo + 31) { const bool bm_ = (KIND == 2) ? (kb_ + 63 >= qlo) : (kb_ + 63 > qlo); \
            tile_compute<KIND, DK>(kbase + (BUF) * SHM_K, kx, vbase + (BUF) * SHM_V, qr, o, m_reg, l_reg, R, qpos - kb_ - 4 * hi, bm_, ((allowed >> (kb_ >> 8)) & 1u) != 0u, hi); } \
        if ((i_) + 1 < NT) { asm volatile("s_waitcnt vmcnt(0)" ::: "memory"); ATT_WRITET((BUF) ^ 1); } \
        __syncthreads(); } while (0)
    ATT_LOADT(ATT_TILE(0)); asm volatile("s_waitcnt vmcnt(0)" ::: "memory"); ATT_WRITET(0); __syncthreads();
    for (int i = 0; i < NT; i += 2) { ATT_STEP(0, i); ATT_STEP(1, i + 1); }
#undef ATT_STEP
#undef ATT_TILE
#undef ATT_WRITET
#undef ATT_LOADT
    const float inv = (KIND == 2) ? 1.0f : 1.0f / l_reg;
    bf16_t* orow = s.o + (size_t)qpos * D + 4 * hi;
#pragma unroll
    for (int d0 = 0; d0 < 4; ++d0)
#pragma unroll
        for (int g = 0; g < 4; ++g) { u32x2 w; w.x = cvt_pk_bf16(o[d0][4 * g] * inv, o[d0][4 * g + 1] * inv); w.y = cvt_pk_bf16(o[d0][4 * g + 2] * inv, o[d0][4 * g + 3] * inv);
            *(u32x2*)(orow + 32 * d0 + 8 * g) = w; }
}
}

namespace pg8 {
struct SchedMemKV {
    const char* MEMN; const char* WXK; const char* WXV; int G, c;
    DI bool next(int i, Unit& u) const {
        const long L = (long)i * G + c; if (L >= 128) return false;
        const int ll = (int)L >> 6, kind = ((int)L >> 5) & 1, r = (int)L & 31; u.aux = ll * 2 + kind; u.nt = 32;
        if (kind == 0) { u.pm = r >> 3; u.pn = r & 7; u.a = MEMN + (size_t)ll * 1024 * D * 2 + (size_t)u.pm * 256 * D * 2; u.b = WXK + (size_t)ll * SZ_SQ + (size_t)u.pn * 256 * D * 2; }
        else { u.pm = r >> 2; u.pn = r & 3; u.a = WXV + (size_t)ll * SZ_SQ + (size_t)u.pm * 256 * D * 2; u.b = MEMN + (size_t)ll * 1024 * D * 2 + (size_t)u.pn * 256 * D * 2; }
        return true;
    }
};
}
namespace epi {
struct EpiMemKV {
    bf16_t* KMEM; bf16_t* VMEMT;
    DI bool operator()(Acc& acc, const Unit& u, int wr, int wc, int fr, int fq) const {
        const int ll = u.aux >> 1, kind = u.aux & 1; const int ldo = kind ? 1024 : 2048;
        bf16_t* O = (kind ? VMEMT : KMEM) + (size_t)ll * 1024 * 2048;
        const int row0 = u.pm * 256 + wr * 64 + fr;
#pragma unroll
        for (int ai = 0; ai < 2; ++ai)
#pragma unroll
            for (int m = 0; m < 4; ++m) { const int row = row0 + ai * 128 + m * 16;
#pragma unroll
                for (int bj = 0; bj < 2; ++bj)
                    *(u32x4*)(O + (size_t)row * ldo + u.pn * 256 + bj * 128 + wc * 32 + 8 * fq) = pack8(acc[ai][bj][m][0], acc[ai][bj][m][1]); }
        return false;
    }
};
}

DI void attn_phase(const Frame& F, KPtr kp, const int l) {
    unsigned char* ws = kp->ws; unsigned* ctl = (unsigned*)(ws + WS_CTL);
    volatile LAS int* misc = (volatile LAS int*)(F.lds + LDS_MISC);
    const bf16_t* QA = (const bf16_t*)(ws + WS_R2 + R2_QA); const bf16_t* KVA = (const bf16_t*)(ws + WS_R2 + R2_KVA); const bf16_t* KPE = (const bf16_t*)(ws + WS_R1 + R1_KPE);
    const bf16_t* MQK = (const bf16_t*)(ws + WS_R1 + R1_MQK); const bf16_t* PL = (const bf16_t*)(ws + WS_R1 + R1_PL); bf16_t* OCAT = (bf16_t*)(ws + WS_R2 + R2_OCAT);
    const float* ksum = (const float*)(ws + WS_CTL) + CW_KSUM + l * KSUM_L;
#define ATT_QUEUE_LOOP(KIND, NH, BODY) for (;;) { if (F.tid == 0) misc[4] = (int)__hip_atomic_fetch_add(ctl + CW_QUEUE + (l * 3 + (KIND)) * 64, 1u, __ATOMIC_RELAXED, __HIP_MEMORY_SCOPE_AGENT); \
        __syncthreads(); const int it = __builtin_amdgcn_readfirstlane(misc[4]); __syncthreads(); if (it >= 16 * NB * (NH)) break; \
        const int qb = 15 - it / (NB * (NH)), r_ = it % (NB * (NH)), b = r_ / (NH), h = r_ % (NH); const size_t t0 = (size_t)b * SEQ; att::Src s; BODY }
#ifndef ATT_MASK
#define ATT_MASK 7
#endif
    if (ATT_MASK & 4) ATT_QUEUE_LOOP(2, 5, { s.q = PL + t0 * 2560 + 640 + h * 128; s.k = PL + t0 * 2560 + 1280 + h * 128; s.k2 = nullptr; s.v = PL + t0 * 2560 + 1920 + h * 128; s.o = OCAT + t0 * D + 1408 + h * 128;
        s.ldq = 2560; s.ldk = 2560; s.ldv = 2560; att::attn_unit<2>(F.lds, s, qb, nullptr); })
    if (ATT_MASK & 1) ATT_QUEUE_LOOP(0, 6, { s.q = QA + t0 * 1152 + h * 192; s.k = KVA + t0 * 1536 + h * 256; s.k2 = KPE + t0 * 64; s.v = KVA + t0 * 1536 + h * 256 + 128; s.o = OCAT + t0 * D + h * 128;
        s.ldq = 1152; s.ldk = 1536; s.ldv = 1536; att::attn_unit<0>(F.lds, s, qb, nullptr); })
    if (ATT_MASK & 2) ATT_QUEUE_LOOP(1, 5, { s.q = MQK + t0 * 1280 + h * 128; s.k = MQK + t0 * 1280 + (5 + h) * 128; s.k2 = nullptr; s.v = PL + t0 * 2560 + h * 128; s.o = OCAT + t0 * D + 768 + h * 128;
        s.ldq = 1280; s.ldk = 1280; s.ldv = 2560; att::attn_unit<1>(F.lds, s, qb, ksum + ((size_t)b * 16 * 5 + h) * 128); })
#undef ATT_QUEUE_LOOP
}

constexpr int NPH = 26;
__global__ void __launch_bounds__(NTHR, 2) fwd(Params P) {
    extern __shared__ __attribute__((aligned(16))) unsigned char lds_[];
    volatile LAS unsigned* MISC = (volatile LAS unsigned*)((LAS unsigned char*)lds_ + LDS_MISC);
    if (threadIdx.x < 32) MISC[threadIdx.x] = 0u;
    __syncthreads();
    const int lo = P.ph_lo, hi = P.ph_hi;
    XcdBarrier bar; bar.bar = (unsigned*)(P.ws + WS_CTL) + CW_BAR; bar.x = 0; bar.st = nullptr;
    if (hi - lo > 1) bar = xcd_barrier_post((unsigned*)(P.ws + WS_CTL) + CW_BAR, MISC + 8);
#ifndef PH_ONLY
#define PH_ONLY -1
#endif
#ifndef PH_MASK
#define PH_MASK 0xffffffffu
#endif
#define IN(k) ((PH_ONLY < 0 || PH_ONLY == (k)) && ((PH_MASK >> ((k) >= 12 ? (k) - 11 : (k))) & 1u) && lo <= (k) && (k) < hi)
#define SEAM(k) do { if (IN(k) && IN((k) + 1)) xcd_barrier(bar); } while (0)
#define OPQ KP_HERE FRAME_HERE unsigned char* ws = kp->ws; float* out = kp->out; unsigned* ctl = (unsigned*)(ws + WS_CTL); float* ctlf = (float*)(ws + WS_CTL); bf16_t* HB = (bf16_t*)(ws + WS_HB); \
        const int G = F.G, bid = F.bid; (void)ctl; (void)ctlf; (void)HB; (void)out; (void)G; (void)bid; \
        stat_t* stq = (stat_t*)(ctl + CW_STAT); stat_t* st_mix = stq + (ST_MIX * 2 + l) * T; stat_t* st_cq = stq + (ST_CQ * 2 + l) * T; stat_t* st_ckv = stq + (ST_CKV * 2 + l) * T; \
        stat_t* st_x = stq + (ST_X * 2 + l) * T; stat_t* st_ffn = stq + (ST_FFN * 2 + l) * T; (void)st_mix; (void)st_cq; (void)st_ckv; (void)st_x; (void)st_ffn;

    if (IN(0)) { KP_HERE FRAME_HERE prologue(F, kp); } SEAM(0);

    for (int l = 0; l < 2; ++l) {
        const int base = l ? 12 : 1;
        if (IN(base + 0)) {
            OPQ
#ifndef NO_MEMKV
            if (l == 0) { pg8::SchedMemKV S{(const char*)(ws + WS_MEMN), (const char*)(ws + WS_WXK), (const char*)(ws + WS_WXV), G, (bid + 128) % G};
                epi::EpiMemKV E{(bf16_t*)(ws + WS_KMEM), (bf16_t*)(ws + WS_VMEMT)};
                pg8::gemm_phase<epi::EpiMemKV, pg8::SchedMemKV>(F.lds, 4096, 4096, S, E); }
#endif
            { pg8::SchedGrid S{(const char*)HB, (const char*)(ws + WS_WIN + l * SZ_WIN), 4096, 4096, 64, 5, 32, G, bid, 0};
              epi::EpiIn<3> E{st_mix, (bf16_t*)(ws + WS_R1 + R1_ZC), (bf16_t*)(ws + WS_R1 + R1_KPE), (bf16_t*)(ws + WS_R1 + R1_MQK), (bf16_t*)(ws + WS_R1 + R1_PL), (bf16_t*)(ws + WS_R1 + R1_G),
                         st_cq, st_ckv, ctlf + CW_KSUM + l * KSUM_L, (const f32x2*)(ws + WS_CS128), (const f32x2*)(ws + WS_CS64)};
              pg8::gemm_phase<epi::EpiIn<3>, pg8::SchedGrid>(F.lds, 4096, 4096, S, E); }
            { pg8::SchedGrid S{(const char*)HB, (const char*)(ws + WS_WIN + l * SZ_WIN), 4096, 4096, 64, 39, 32, G, (bid + G - 64) % G, 5};
              epi::EpiIn<28> E{st_mix, (bf16_t*)(ws + WS_R1 + R1_ZC), (bf16_t*)(ws + WS_R1 + R1_KPE), (bf16_t*)(ws + WS_R1 + R1_MQK), (bf16_t*)(ws + WS_R1 + R1_PL), (bf16_t*)(ws + WS_R1 + R1_G),
                         st_cq, st_ckv, ctlf + CW_KSUM + l * KSUM_L, (const f32x2*)(ws + WS_CS128), (const f32x2*)(ws + WS_CS64)};
              pg8::gemm_phase<epi::EpiIn<28>, pg8::SchedGrid>(F.lds, 4096, 4096, S, E); }
        }
        SEAM(base + 0);
        if (IN(base + 1)) {
            OPQ
            { pg8::SchedGrid S{(const char*)(ws + WS_R1 + R1_ZC), (const char*)(ws + WS_WUQ + l * SZ_WUQ), 2048, 1024, 64, 5, 8, G, bid, 0};
              epi::EpiUQ E{(bf16_t*)(ws + WS_R2 + R2_QA), st_cq, (const f32x2*)(ws + WS_CS64)};
              pg8::gemm_phase<epi::EpiUQ, pg8::SchedGrid>(F.lds, 2048, 1024, S, E); }
            { pg8::SchedGrid S{(const char*)(ws + WS_R1 + R1_ZC) + 1024, (const char*)(ws + WS_WUKV + l * SZ_WUKV), 2048, 1024, 64, 6, 8, G, (bid + G - 64) % G, 0};
              epi::EpiPlain E{(bf16_t*)(ws + WS_R2 + R2_KVA), 1536, st_ckv, 1.0f / 512};
              pg8::gemm_phase<epi::EpiPlain, pg8::SchedGrid>(F.lds, 2048, 1024, S, E); }
        }
        SEAM(base + 1);
        if (IN(base + 2)) { KP_HERE FRAME_HERE attn_phase(F, kp, l); }
        SEAM(base + 2);
        if (IN(base + 3)) {
            OPQ
            pg8::SchedUp S{(const char*)(ws + WS_R2 + R2_OCAT), (const char*)(ws + WS_WUP + l * SZ_SQ), G, bid};
            epi::EpiUp E{(const bf16_t*)(ws + WS_R1 + R1_G), (bf16_t*)(ws + WS_R2 + R2_MERGED)};
            pg8::gemm_phase<epi::EpiUp, pg8::SchedUp>(F.lds, 4096, 4096, S, E);
        }
        SEAM(base + 3);
        if (IN(base + 4)) {
            OPQ
            pg8::SchedGrid S{(const char*)(ws + WS_R2 + R2_MERGED), (const char*)(ws + WS_WO + l * SZ_SQ), 4096, 4096, 64, 8, 32, G, bid, 0};
            epi::EpiRes E{out, HB, st_x};
            pg8::gemm_phase<epi::EpiRes, pg8::SchedGrid>(F.lds, 4096, 4096, S, E);
        }
        SEAM(base + 4);
        if (IN(base + 5)) {
            OPQ
            pg8::SchedGrid S{(const char*)HB, (const char*)(ws + WS_WXQ + l * SZ_SQ), 4096, 4096, 64, 8, 32, G, bid, 0};
            epi::EpiPlain E{(bf16_t*)(ws + WS_R2 + R2_QX), 2048, st_x, 1.0f / D};
            pg8::gemm_phase<epi::EpiPlain, pg8::SchedGrid>(F.lds, 4096, 4096, S, E);
        }
        SEAM(base + 5);
        if (IN(base + 6)) {
            OPQ
            pg8::SchedXS S{(const char*)(ws + WS_R2 + R2_QX), (const char*)(ws + WS_KMEM) + (size_t)l * 1024 * D * 2, G, bid};
            epi::EpiXS E{(bf16_t*)(ws + WS_R2 + R2_PX), (LAS float*)(F.lds + LDS_EPI)};
            pg8::gemm_phase<epi::EpiXS, pg8::SchedXS, true>(F.lds, 4096, 4096, S, E);
        }
        SEAM(base + 6);
        if (IN(base + 7)) {
            OPQ
            pg8::SchedXPV S{(const char*)(ws + WS_R2 + R2_PX), (const char*)(ws + WS_VMEMT) + (size_t)l * D * 1024 * 2, G, bid};
            epi::EpiPlain E{(bf16_t*)(ws + WS_R2 + R2_OX), 2048, nullptr, 0.f};
            pg8::gemm_phase<epi::EpiPlain, pg8::SchedXPV>(F.lds, 2048, 2048, S, E);
        }
        SEAM(base + 7);
        if (IN(base + 8)) {
            OPQ
            pg8::SchedGrid S{(const char*)(ws + WS_R2 + R2_OX), (const char*)(ws + WS_WXO + l * SZ_SQ), 4096, 4096, 64, 8, 32, G, bid, 0};
            epi::EpiRes E{out, HB, st_ffn};
            pg8::gemm_phase<epi::EpiRes, pg8::SchedGrid>(F.lds, 4096, 4096, S, E);
        }
        SEAM(base + 8);
        if (l == 0) {
            if (IN(10)) {
                OPQ
                pg8::SchedGrid S{(const char*)HB, (const char*)(ws + WS_WFF13), 4096, 4096, 64, 44, 32, G, bid, 0};
                epi::EpiSwiglu E{(bf16_t*)(ws + WS_R1 + R1_ACT), DFF, st_ffn};
                pg8::gemm_phase<epi::EpiSwiglu, pg8::SchedGrid>(F.lds, 4096, 4096, S, E);
            }
            SEAM(10);
            if (IN(11)) {
                OPQ
                pg8::SchedGrid S{(const char*)(ws + WS_R1 + R1_ACT), (const char*)(ws + WS_WFF2), DFF * 2, DFF * 2, 64, 8, DFF / 64, G, bid, 0};
                epi::EpiRes E{out, HB, stq + (ST_MIX * 2 + 1) * T};
                pg8::gemm_phase<epi::EpiRes, pg8::SchedGrid>(F.lds, DFF * 2, DFF * 2, S, E);
            }
            SEAM(11);
        } else {
            if (IN(21)) { KP_HERE FRAME_HERE moe_router(F, kp); }
            SEAM(21);
            if (IN(22)) { KP_HERE FRAME_HERE moe_assign_gather(F, kp); }
            SEAM(22);
            if (IN(23)) {
                OPQ
                pg8::SchedMoE S; S.A = (const char*)(ws + WS_R2 + R2_XS); S.Bt = (const char*)(ws + WS_WE13); S.lda = 4096; S.nN = 56; S.nt = 32; S.G = G; S.c = bid; S.wstride = SZ_WE13; S.init_counts(ctl + CW_MOE);
                epi::EpiSwiglu E{(bf16_t*)(ws + WS_R1 + R1_ACTE), DFE, nullptr};
                pg8::gemm_phase<epi::EpiSwiglu, pg8::SchedMoE>(F.lds, 4096, 4096, S, E);
            }
            SEAM(23);
            if (IN(24)) {
                OPQ
                pg8::SchedMoE S; S.A = (const char*)(ws + WS_R1 + R1_ACTE); S.Bt = (const char*)(ws + WS_WE2); S.lda = DFE * 2; S.nN = 8; S.nt = DFE / 64; S.G = G; S.c = bid; S.wstride = SZ_WE2; S.init_counts(ctl + CW_MOE);
                epi::EpiPlain E{(bf16_t*)(ws + WS_R2 + R2_YS), 2048, nullptr, 0.f};
                pg8::gemm_phase<epi::EpiPlain, pg8::SchedMoE>(F.lds, DFE * 2, DFE * 2, S, E);
            }
            SEAM(24);
            if (IN(25)) { KP_HERE FRAME_HERE moe_combine_final(F, kp); }
        }
    }
#undef IN
#undef SEAM
#undef OPQ
}

extern "C" void kernel_launch(void* const* d_in, const int* in_sizes, int n_in, void* d_out, int out_size, void* d_ws, size_t ws_size, hipStream_t stream) {
    static int grid = 0;
    if (grid == 0) {
        if (n_in != 28 || out_size != T * D || ws_size < WS_END) { fprintf(stderr, "kernel_launch: unexpected shapes (n_in %d, out %d, ws %zu, need %zu)\n", n_in, out_size, ws_size, (size_t)WS_END); grid = -1; return; }
        int dev = 0, cus = 0, per_cu = 0;
        if (hipGetDevice(&dev) != hipSuccess || hipDeviceGetAttribute(&cus, hipDeviceAttributeMultiprocessorCount, dev) != hipSuccess) { grid = -1; return; }
        if (hipFuncSetAttribute((const void*)fwd, hipFuncAttributeMaxDynamicSharedMemorySize, LDS_BYTES) != hipSuccess) { fprintf(stderr, "kernel_launch: hipFuncSetAttribute failed\n"); grid = -1; return; }
        if (hipOccupancyMaxActiveBlocksPerMultiprocessor(&per_cu, (const void*)fwd, NTHR, LDS_BYTES) != hipSuccess || per_cu < 1) { fprintf(stderr, "kernel_launch: occupancy query says %d\n", per_cu); grid = -1; (void)hipGetLastError(); return; }
        grid = cus;
    }
    if (grid < 0) return;
    (void)hipMemsetAsync((char*)d_ws + WS_CTL, 0, CTL_BYTES, stream);
    Params p{};
    p.x = (const float*)d_in[0]; p.mem = (const float*)d_in[1]; p.positions = (const int*)d_in[2];
    p.g_mix = (const float*)d_in[3]; p.w_in = (const float*)d_in[4]; p.g_cq = (const float*)d_in[5]; p.g_ckv = (const float*)d_in[6]; p.w_uq = (const float*)d_in[7]; p.w_ukv = (const float*)d_in[8];
    p.w_up_a = (const float*)d_in[9]; p.w_up_b = (const float*)d_in[10]; p.w_up_c = (const float*)d_in[11]; p.w_o = (const float*)d_in[12]; p.g_x = (const float*)d_in[13]; p.g_mem = (const float*)d_in[14];
    p.w_xq = (const float*)d_in[15]; p.w_xk = (const float*)d_in[16]; p.w_xv = (const float*)d_in[17]; p.w_xo = (const float*)d_in[18]; p.g_ffn = (const float*)d_in[19];
    p.w_ff1 = (const float*)d_in[20]; p.w_ff3 = (const float*)d_in[21]; p.w_ff2 = (const float*)d_in[22]; p.w_router = (const float*)d_in[23]; p.w_e1 = (const float*)d_in[24]; p.w_e3 = (const float*)d_in[25];
    p.w_e2 = (const float*)d_in[26]; p.g_final = (const float*)d_in[27];
    p.out = (float*)d_out; p.ws = (unsigned char*)d_ws;
#if N_LAUNCH_MODE == 1
    p.ph_lo = 0; p.ph_hi = NPH;
    hipLaunchKernelGGL(fwd, dim3(grid), dim3(NTHR), LDS_BYTES, stream, p);
#else
    for (int ph = 0; ph < NPH; ++ph) { p.ph_lo = ph; p.ph_hi = ph + 1; hipLaunchKernelGGL(fwd, dim3(grid), dim3(NTHR), LDS_BYTES, stream, p); }
#endif
}
```

```cpp
#include <hip/hip_runtime.h>
#include <cstdio>
#include <cstdint>

#define LAS __attribute__((address_space(3)))
#define DI __device__ __forceinline__
typedef unsigned short bf16_t;
typedef short bf16x8 __attribute__((ext_vector_type(8)));
typedef short s16x4 __attribute__((ext_vector_type(4)));
typedef float f32x2 __attribute__((ext_vector_type(2)));
typedef float f32x4 __attribute__((ext_vector_type(4)));
typedef float f32x16 __attribute__((ext_vector_type(16)));
typedef unsigned u32x2 __attribute__((ext_vector_type(2)));
typedef unsigned u32x4 __attribute__((ext_vector_type(4)));
typedef __bf16 bf16x2_t __attribute__((ext_vector_type(2)));

#ifndef SIMPLE_GEMM
#define SIMPLE_GEMM 0
#endif
#ifndef N_LAUNCH_MODE
#define N_LAUNCH_MODE 1
#endif

constexpr int NB = 4, SEQ = 4096, T = NB * SEQ, D = 2048;
constexpr int IN_COLS = 11072, NIN = 11264;
constexpr int DFF = 5632, NEXP = 8, DFE = 7168;
constexpr int NSLOT_BLK = 136, NSLOT = NSLOT_BLK * 256;
constexpr float EPS = 1e-6f;
constexpr float LOG2E = 1.4426950408889634f;
constexpr int NWAVES = 8, NTHR = 512;

constexpr size_t MiB = 1u << 20;
constexpr size_t WS_CTL = 0, CTL_BYTES = 4 * MiB;
constexpr size_t WS_WIN = 4 * MiB;
constexpr size_t SZ_WIN = (size_t)NIN * D * 2;
constexpr size_t WS_WUQ = WS_WIN + 2 * SZ_WIN;
constexpr size_t SZ_WUQ = (size_t)1280 * 512 * 2;
constexpr size_t WS_WUKV = WS_WUQ + 2 * SZ_WUQ;
constexpr size_t SZ_WUKV = (size_t)1536 * 512 * 2;
constexpr size_t SZ_SQ = (size_t)D * D * 2;
constexpr size_t WS_WUP = WS_WUKV + 2 * SZ_WUKV;
constexpr size_t WS_WO = WS_WUP + 2 * SZ_SQ;
constexpr size_t WS_WXQ = WS_WO + 2 * SZ_SQ;
constexpr size_t WS_WXK = WS_WXQ + 2 * SZ_SQ;
constexpr size_t WS_WXV = WS_WXK + 2 * SZ_SQ;
constexpr size_t WS_WXO = WS_WXV + 2 * SZ_SQ;
constexpr size_t WS_WFF13 = WS_WXO + 2 * SZ_SQ;
constexpr size_t WS_WFF2 = WS_WFF13 + SZ_WIN;
constexpr size_t SZ_WFF2 = (size_t)D * DFF * 2;
constexpr size_t WS_WE13 = WS_WFF2 + SZ_WFF2;
constexpr size_t SZ_WE13 = (size_t)2 * DFE * D * 2;
constexpr size_t WS_WE2 = WS_WE13 + NEXP * SZ_WE13;
constexpr size_t SZ_WE2 = (size_t)D * DFE * 2;
constexpr size_t WS_HB = WS_WE2 + NEXP * SZ_WE2;
constexpr size_t WS_CS128 = WS_HB + (size_t)T * D * 2;
constexpr size_t WS_CS64 = WS_CS128 + (size_t)T * 64 * 8;
constexpr size_t WS_MEMN = WS_CS64 + (size_t)T * 32 * 8;
constexpr size_t WS_KMEM = WS_MEMN + 8 * MiB;
constexpr size_t WS_VMEMT = WS_KMEM + 8 * MiB;
constexpr size_t WS_TOK = WS_VMEMT + 8 * MiB;
constexpr size_t WS_R1 = WS_TOK + 1 * MiB;
constexpr size_t WS_R2 = WS_R1 + 512 * MiB;
constexpr size_t WS_HB8 = WS_R2 + 288 * MiB;
constexpr size_t WS_MT = WS_HB8 + 32 * MiB;
constexpr size_t WS_NT = WS_MT + 32 * MiB;
constexpr size_t WS_WING8 = WS_NT + 32 * MiB;
constexpr size_t WS_END = WS_WING8 + 24 * MiB;
constexpr size_t WS_WIN8X = WS_WE13 + SZ_WE13 / 2;
constexpr size_t R1_ZC = 0, R1_KPE = 32 * MiB, R1_MQK = 34 * MiB, R1_PL = 74 * MiB, R1_G = 154 * MiB;
constexpr size_t R1_ACT = 0;
constexpr size_t R1_ACTE = 0;
static_assert((size_t)NSLOT * DFE * 2 <= 512 * MiB && R1_G + (size_t)T * 6144 * 2 <= 512 * MiB, "R1");
constexpr size_t R2_QA = 0, R2_KVA = 36 * MiB, R2_OCAT = 84 * MiB, R2_MERGED = 148 * MiB;
constexpr size_t R2_QX = 0, R2_PX = 64 * MiB, R2_OX = 96 * MiB;
constexpr size_t R2_XS = 0, R2_YS = 136 * MiB;
static_assert(R2_YS + (size_t)NSLOT * D * 2 <= 288 * MiB, "R2");
constexpr size_t R2_YP = 72 * MiB;

constexpr int CW_BAR = 4096;
constexpr int CW_QUEUE = 8192;
constexpr int CW_TS = 10240;
constexpr int CW_MOE = 9216;
constexpr int CW_STAT = 16384;
constexpr int CW_KSUM = CW_STAT + 20 * T;
constexpr int KSUM_L = NB * 16 * 5 * 128;
static_assert((size_t)(CW_KSUM + 2 * KSUM_L) * 4 <= CTL_BYTES, "ctl");
enum { ST_MIX = 0, ST_CQ = 1, ST_CKV = 2, ST_X = 3, ST_FFN = 4 };

constexpr int LDS_STAGE = 131072;
constexpr int LDS_EPI = LDS_STAGE;
constexpr int LDS_MISC = LDS_STAGE + 8192;
constexpr int LDS_STATP = LDS_MISC + 1024;
constexpr int LDS_BYTES = 147456;

DI unsigned cvt_pk_bf16(float lo, float hi) { f32x2 v = {lo, hi}; bf16x2_t b = __builtin_convertvector(v, bf16x2_t); return __builtin_bit_cast(unsigned, b); }
DI u32x4 pack8(f32x4 a, f32x4 b) { u32x4 w; w.x = cvt_pk_bf16(a[0], a[1]); w.y = cvt_pk_bf16(a[2], a[3]); w.z = cvt_pk_bf16(b[0], b[1]); w.w = cvt_pk_bf16(b[2], b[3]); return w; }
typedef int i32x4 __attribute__((ext_vector_type(4)));
typedef int i32x8 __attribute__((ext_vector_type(8)));
DI unsigned pk_fp8x4(float a, float b, float c, float d) {
    a = __builtin_amdgcn_fmed3f(a, -448.f, 448.f); b = __builtin_amdgcn_fmed3f(b, -448.f, 448.f); c = __builtin_amdgcn_fmed3f(c, -448.f, 448.f); d = __builtin_amdgcn_fmed3f(d, -448.f, 448.f);
    int w = 0; w = __builtin_amdgcn_cvt_pk_fp8_f32(a, b, w, false); w = __builtin_amdgcn_cvt_pk_fp8_f32(c, d, w, true); return (unsigned)w; }
DI u32x2 pack8_fp8(f32x4 a, f32x4 b) { u32x2 w; w.x = pk_fp8x4(a[0], a[1], a[2], a[3]); w.y = pk_fp8x4(b[0], b[1], b[2], b[3]); return w; }
constexpr bool F8_XATTN = true;
constexpr float F8_SM = 512.0f, F8_SN = 64.0f, F8_SP = 256.0f;
#ifndef F8_B_
#define F8_B_ true
#endif
#ifndef F8_XPRE_
#define F8_XPRE_ true
#endif
#ifndef F8_DUP_
#define F8_DUP_ true
#endif
constexpr bool F8_DUP = F8_DUP_;
constexpr float F8_SO = 64.0f;
#ifndef MOE_TAIL_
#define MOE_TAIL_ true
#endif
constexpr bool MOE_TAIL = MOE_TAIL_;
constexpr bool F8_B = F8_B_;
constexpr bool F8_XPRE = F8_XPRE_;
constexpr float F8_SZ = 32.0f, F8_SWQ = 4096.0f;
#ifndef A8_TILES
#define A8_TILES 16
#endif
constexpr bool F8_AMM = true;
constexpr bool F8_GATES = true;
constexpr bool F8_DENSE = false, F8_MOE = true, F8_DDOWN = false;
constexpr float F8_SW = 512.0f, F8_SA = 8.0f, F8_SX = 16.0f;
DI i32x8 cat8(bf16x8 lo, bf16x8 hi) { const i32x4 a = __builtin_bit_cast(i32x4, lo), b = __builtin_bit_cast(i32x4, hi); return (i32x8){a[0], a[1], a[2], a[3], b[0], b[1], b[2], b[3]}; }
template <int N> DI float ubf(unsigned w) { return (float)((w >> (8 * N)) & 0xffu); }
DI float bf_lo(unsigned w) { return __uint_as_float(w << 16); }
DI float bf_hi(unsigned w) { return __uint_as_float(w & 0xffff0000u); }
typedef unsigned long long stat_t;
constexpr float STAT_SCALE = 16777216.0f, STAT_INV = 1.0f / 16777216.0f;
DI void atomic_adds(stat_t* p, float v) { __hip_atomic_fetch_add(p, (stat_t)(v * STAT_SCALE), __ATOMIC_RELAXED, __HIP_MEMORY_SCOPE_AGENT); }
DI void atomic_addf(float* p, float v) { __hip_atomic_fetch_add(p, v, __ATOMIC_RELAXED, __HIP_MEMORY_SCOPE_AGENT); }
template <int M> DI float swz_xor(float v) { return __int_as_float(__builtin_amdgcn_ds_swizzle(__float_as_int(v), 0x1f | (M << 10))); }
DI float half_sum(float v) { auto rr = __builtin_amdgcn_permlane32_swap(__float_as_uint(v), __float_as_uint(v), false, false); return __uint_as_float(rr[0]) + __uint_as_float(rr[1]); }
DI float half_max(float v) { auto rr = __builtin_amdgcn_permlane32_swap(__float_as_uint(v), __float_as_uint(v), false, false); return fmaxf(__uint_as_float(rr[0]), __uint_as_float(rr[1])); }
DI float wave_sum(float v) { v += swz_xor<1>(v); v += swz_xor<2>(v); v += swz_xor<4>(v); v += swz_xor<8>(v); v += swz_xor<16>(v); return half_sum(v); }
DI int lane_id_now() { int l; asm volatile("v_mbcnt_lo_u32_b32 %0, -1, 0\n\tv_mbcnt_hi_u32_b32 %0, -1, %0" : "=v"(l)); return l; }
DI float fast_exp2(float x) { return __builtin_amdgcn_exp2f(x); }
DI float fast_log2(float x) { return __builtin_amdgcn_logf(x); }
DI float fast_rcp(float x) { return __builtin_amdgcn_rcpf(x); }
DI float sigmoidf_(float x) { return fast_rcp(1.0f + fast_exp2(-x * LOG2E)); }

#define XB_TMO      128
#define XB_XCNT(j)  (256  + 64 * (j))
#define XB_XSUB(j)  (1280 + 64 * (j))
#define XB_XGEN(j)  (2304 + 64 * (j))
#define XB_TOP      3328
#define XB_TOPGEN   3392
#define XCD_BAR_WORDS 3456
#define XB_SPIN_CAP (1u << 18)

__device__ __forceinline__ unsigned xb_ld(unsigned* p)              { return __hip_atomic_load(p, __ATOMIC_RELAXED, __HIP_MEMORY_SCOPE_AGENT); }
__device__ __forceinline__ unsigned xb_add(unsigned* p, unsigned v) { return __hip_atomic_fetch_add(p, v, __ATOMIC_RELAXED, __HIP_MEMORY_SCOPE_AGENT); }
__device__ __forceinline__ unsigned xb_xcc_id() { return (unsigned)__builtin_amdgcn_s_getreg((3 << 11) | 20) & 0xFu; }
#define XB_SPIN(cond, bar) do { unsigned _sp = 0; while (cond) { __builtin_amdgcn_s_sleep(1); \
    if ((++_sp & 255u) == 0u) { if (xb_ld(&(bar)[XB_TMO])) break; if (_sp > XB_SPIN_CAP) { atomicAdd(&(bar)[XB_TMO], 1u); break; } } } } while (0)

struct XcdBarrier { unsigned* bar; unsigned x; volatile LAS unsigned* st; };

__device__ __forceinline__ XcdBarrier xcd_barrier_post(unsigned* bar, volatile LAS unsigned* st) {
    XcdBarrier b; b.bar = bar; b.x = xb_xcc_id(); b.st = st;
    if (threadIdx.x == 0) (void)xb_add(&bar[XB_XCNT(b.x)], 1u);
    return b;
}
__device__ __forceinline__ void xcd_barrier_complete(unsigned* bar, unsigned x, unsigned& nloc, unsigned& nx) {
    const unsigned G = gridDim.x * gridDim.y * gridDim.z;
    unsigned sum, cnt, mine, sp = 0u;
    for (;;) {
        sum = 0u; cnt = 0u; mine = 0u;
#pragma unroll
        for (unsigned j = 0; j < 16; ++j) { const unsigned c = xb_ld(&bar[XB_XCNT(j)]); sum += c; cnt += (c > 0u) ? 1u : 0u; mine = (j == x) ? c : mine; }
        if (sum == G) break;
        __builtin_amdgcn_s_sleep(1);
        if ((++sp & 255u) == 0u) { if (xb_ld(&bar[XB_TMO])) break; if (sp > XB_SPIN_CAP) { atomicAdd(&bar[XB_TMO], 1u); break; } }
    }
    nloc = mine > 0u ? mine : 1u; nx = cnt > 0u ? cnt : 1u;
}
__device__ __forceinline__ void xcd_barrier(const XcdBarrier& b, const bool thread0  ) {
    asm volatile("s_waitcnt vmcnt(0)" ::: "memory");
    __syncthreads();
    unsigned bx = b.x; asm volatile("" : "+s"(bx));
    if (thread0) {
        unsigned* bar = b.bar; asm volatile("" : "+s"(bar));
        __builtin_amdgcn_s_waitcnt(0);
        unsigned nloc = b.st[0], nx = b.st[1];
        if (nloc == 0u) { xcd_barrier_complete(bar, bx, nloc, nx); b.st[0] = nloc; b.st[1] = nx; }
        const unsigned old = xb_add(&bar[XB_XSUB(bx)], 1u);
        const unsigned gen = old / nloc;
        if (old + 1u == (gen + 1u) * nloc) {
            __builtin_amdgcn_fence(__ATOMIC_RELEASE, "agent");
            asm volatile("s_waitcnt vmcnt(0)" ::: "memory");
            const unsigned og = xb_add(&bar[XB_TOP], 1u);
            const unsigned tg = og / nx;
            if (og + 1u == (tg + 1u) * nx) xb_add(&bar[XB_TOPGEN], 1u);
            else XB_SPIN(xb_ld(&bar[XB_TOPGEN]) == tg, bar);
            __builtin_amdgcn_fence(__ATOMIC_ACQUIRE, "agent");
            xb_add(&bar[XB_XGEN(bx)], 1u);
            asm volatile("s_waitcnt vmcnt(0)" ::: "memory");
        } else {
            XB_SPIN(xb_ld(&bar[XB_XGEN(bx)]) == gen, bar);
            __builtin_amdgcn_fence(__ATOMIC_ACQUIRE, "agent");
            asm volatile("s_waitcnt vmcnt(0)" ::: "memory");
        }
    }
    __syncthreads();
}

namespace pg8 {
constexpr int BM = 256, BK = 64, HALF = 128, HTB = HALF * BK * 2, STAGE_BYTES = 8 * HTB, NXCD = 8, WGM = 8;
DI int lds_byte(int r, int c) { const int st = (r >> 4) * 2 + (c >> 5), rr = r & 15, cc = c & 31, ob = rr * 64 + cc * 2; return st * 1024 + (ob ^ (((ob >> 9) & 1) << 5)); }
DI void stage_rc(int b, int& R, int& C) { const int st = b / 1024, sb = b % 1024, swz = sb ^ (((sb >> 9) & 1) << 5); R = (st >> 1) * 16 + swz / 64; C = (st & 1) * 32 + (swz % 64) / 2; }
DI int perm32(int rho) { const int n = rho >> 4, i = rho & 15; return 8 * (i >> 2) + 4 * n + (i & 3); }

struct Unit { int pm, pn, aux, nt; const char* a; const char* b; int sp, bar; };

DI void tile_order(int L, int nM, int nN, int& pm, int& pn) {
    const int nwg = nM * nN; int wgid = L;
    { const int q = nwg / NXCD, r = nwg % NXCD, xcd = wgid % NXCD, off = wgid / NXCD; wgid = (xcd < r ? xcd * (q + 1) : r * (q + 1) + (xcd - r) * q) + off; }
    const int nig = WGM * nN, gid = wgid / nig, fm = gid * WGM, gsz = (nM - fm) < WGM ? (nM - fm) : WGM;
    pm = fm + ((wgid % nig) % gsz); pn = (wgid % nig) / gsz;
}

typedef f32x4 Acc[2][2][4][2];

#if !SIMPLE_GEMM
#ifndef ALIGN_DEFAULT
#define ALIGN_DEFAULT true
#endif
template <class Epi, class Sched, bool ALIGN_EPI_ = false, bool FP8 = false, bool NOALIGN = false, bool MIX = false>
DI void gemm_phase(LAS unsigned char* lds, const int tid_in, const int lda, const int ldb, const Sched& S, const Epi& E) {
    constexpr bool ALIGN_EPI = ALIGN_EPI_ || (ALIGN_DEFAULT && !NOALIGN); constexpr bool F8L = FP8 || MIX;
    int tid_ = tid_in; asm volatile("" : "+v"(tid_));
    const int tid = tid_, wid = __builtin_amdgcn_readfirstlane(tid >> 6), lane = tid & 63, wr = wid >> 2, wc = wid & 3, fr = lane & 15, fq = lane >> 4;
    unsigned voffA[2], voffB[2], voffAh[2], voffBh[2];
#pragma unroll
    for (int i = 0; i < 2; ++i) { int R, C; stage_rc(tid * 16 + i * 8192, R, C); const int Rb = (R & ~31) + perm32(R & 31);
        voffA[i] = (unsigned)(R * lda + C * 2); voffB[i] = (unsigned)(Rb * ldb + C * 2); voffAh[i] = voffA[i] + (unsigned)(HALF * lda); voffBh[i] = voffB[i] + (unsigned)(HALF * ldb); }
    const size_t kstep = (size_t)(BK * 2);
    const unsigned ldsw = (unsigned)wid * 1024u;
    const int aoff = lds_byte(wr * 64 + fr, fq * 8), boff = lds_byte(wc * 32 + fr, fq * 8);
#define PG8_SA(b, h) (((b) * 2 + (h)) * HTB)
#define PG8_SB(b, h) ((4 + (b) * 2 + (h)) * HTB)
#define PG8_STAGE(bufoff, gbase, voff) do { _Pragma("unroll") for (int _i = 0; _i < 2; ++_i) \
        __builtin_amdgcn_global_load_lds((const unsigned*)((const char*)(gbase) + (voff)[_i]), (LAS unsigned*)(lds + (bufoff) + ldsw + _i * 8192), 16, 0, 0); } while (0)
#define PG8_STAGE_AH(bufoff, gbase) do { if constexpr (MIX) PG8_STAGE(bufoff, (gbase) + (size_t)HALF * lda, voffA); else PG8_STAGE(bufoff, gbase, voffAh); } while (0)
#define PG8_STAGE_BH(bufoff, gbase) do { if constexpr (MIX) PG8_STAGE(bufoff, (gbase) + (size_t)HALF * ldb, voffB); else PG8_STAGE(bufoff, gbase, voffBh); } while (0)
#define PG8_LD8(p) ({ const i32x4 lo_ = *(const LAS i32x4*)(p), hi_ = *(const LAS i32x4*)((p) + 1024); (i32x8){lo_[0], lo_[1], lo_[2], lo_[3], hi_[0], hi_[1], hi_[2], hi_[3]}; })
#define PG8_LDA(dst, b, h) do { _Pragma("unroll") for (int m = 0; m < 4; ++m) { if constexpr (F8L) dst##8[m] = PG8_LD8(lds + PG8_SA(b, h) + aoff + m * 2048); \
        else { _Pragma("unroll") for (int k = 0; k < 2; ++k) dst[m][k] = *(const LAS bf16x8*)(lds + PG8_SA(b, h) + aoff + m * 2048 + k * 1024); } } } while (0)
#define PG8_LDB(dst, b, h) do { _Pragma("unroll") for (int n = 0; n < 2; ++n) { if constexpr (F8L) dst##8[n] = PG8_LD8(lds + PG8_SB(b, h) + boff + n * 2048); \
        else { _Pragma("unroll") for (int k = 0; k < 2; ++k) dst[n][k] = *(const LAS bf16x8*)(lds + PG8_SB(b, h) + boff + n * 2048 + k * 1024); } } } while (0)
#define PG8_H0(x) __builtin_bit_cast(bf16x8, __builtin_shufflevector(x, x, 0, 1, 2, 3))
#define PG8_H1(x) __builtin_bit_cast(bf16x8, __builtin_shufflevector(x, x, 4, 5, 6, 7))
#define PG8_MMA(MODE, ai, bj, At, Bt) do { __builtin_amdgcn_s_setprio(1);   \
        if constexpr ((MODE) == 1) { _Pragma("unroll") for (int m = 0; m < 4; ++m) _Pragma("unroll") for (int n = 0; n < 2; ++n) \
            asm volatile("v_mfma_scale_f32_16x16x128_f8f6f4 %0, %1, %2, %0, %3, %3 op_sel_hi:[0,0,0]" : "+v"(acc[ai][bj][m][n]) : "v"(Bt##8[n]), "v"(At##8[m]), "v"(f8one)); } \
        else if constexpr ((MODE) == 2) {   \
            _Pragma("unroll") for (int m = 0; m < 4; ++m) _Pragma("unroll") for (int n = 0; n < 2; ++n) \
                asm volatile("v_mfma_f32_16x16x32_bf16 %0, %1, %2, %0" : "+v"(acc[ai][bj][m][n]) : "v"(PG8_H0(Bt##8[n])), "v"(PG8_H0(At##8[m]))); \
            _Pragma("unroll") for (int m = 0; m < 4; ++m) _Pragma("unroll") for (int n = 0; n < 2; ++n) \
                asm volatile("v_mfma_f32_16x16x32_bf16 %0, %1, %2, %0" : "+v"(acc[ai][bj][m][n]) : "v"(PG8_H1(Bt##8[n])), "v"(PG8_H1(At##8[m]))); } \
        else { _Pragma("unroll") for (int m = 0; m < 4; ++m) _Pragma("unroll") for (int n = 0; n < 2; ++n) _Pragma("unroll") for (int k = 0; k < 2; ++k) \
            acc[ai][bj][m][n] = __builtin_amdgcn_mfma_f32_16x16x32_bf16(Bt[n][k], At[m][k], acc[ai][bj][m][n], 0, 0, 0); } \
        __builtin_amdgcn_s_setprio(0); } while (0)
#define PG8_WAIT_V(n) asm volatile("s_waitcnt vmcnt(" #n ")" ::: "memory")
#define PG8_WAIT_L(n) asm volatile("s_waitcnt lgkmcnt(" #n ")" ::: "memory")
#define PG8_BAR __builtin_amdgcn_s_barrier()
#define PG8_SCHED __builtin_amdgcn_sched_barrier(0)
#define PG8_KLOOP(MODE) \
        for (int t = 0; t < nt; t += 2) { \
            const bool last = (t == nt - 2); \
            const char* a1 = cA + (size_t)(t + 1) * kstep; \
            const char* a2 = last ? nA : cA + (size_t)(t + 2) * kstep; const char* b2 = last ? nB : cB + (size_t)(t + 2) * kstep; \
            const char* a3 = a2 + kstep; const char* b3 = b2 + kstep; \
            PG8_LDB(B0, 0, 0); PG8_LDB(B1, 0, 1); PG8_SCHED; PG8_LDA(At, 0, 0); PG8_STAGE_AH(PG8_SA(1, 1), a1); \
            PG8_WAIT_V(8); PG8_WAIT_L(0); PG8_BAR; PG8_MMA(MODE, 0, 0, At, B0); PG8_MMA(MODE, 0, 1, At, B1); PG8_BAR; PG8_SCHED; \
            PG8_LDA(At, 0, 1); PG8_STAGE(PG8_SB(0, 0), b2, voffB); PG8_STAGE_BH(PG8_SB(0, 1), b2); PG8_STAGE(PG8_SA(0, 0), a2, voffA); \
            PG8_WAIT_V(8); PG8_WAIT_L(0); PG8_BAR; PG8_MMA(MODE, 1, 0, At, B0); PG8_MMA(MODE, 1, 1, At, B1); PG8_BAR; PG8_SCHED; \
            PG8_LDB(B0, 1, 0); PG8_LDB(B1, 1, 1); PG8_SCHED; PG8_LDA(At, 1, 0); PG8_STAGE_AH(PG8_SA(0, 1), a2); \
            PG8_WAIT_V(8); PG8_WAIT_L(0); PG8_BAR; PG8_MMA(MODE, 0, 0, At, B0); PG8_MMA(MODE, 0, 1, At, B1); PG8_BAR; PG8_SCHED; \
            PG8_LDA(At, 1, 1); PG8_STAGE(PG8_SB(1, 0), b3, voffB); PG8_STAGE_BH(PG8_SB(1, 1), b3); PG8_STAGE(PG8_SA(1, 0), a3, voffA); \
            PG8_WAIT_V(8); PG8_WAIT_L(0); PG8_BAR; PG8_MMA(MODE, 1, 0, At, B0); PG8_MMA(MODE, 1, 1, At, B1); PG8_BAR; PG8_SCHED; \
        }
    const stat_t* const sp_src = E.stat_src();
#define PG8_STATDMA(unit, par, ln) do { if (sp_src && wid < 2) __builtin_amdgcn_global_load_lds((const unsigned*)((const char*)(sp_src + (size_t)(unit).pm * 256) + (wid * 64 + (ln)) * 16), \
        (LAS unsigned*)(lds + LDS_STATP + (par) * 2048 + wid * 1024), 16, 0, 0); } while (0)
    Unit cur, nxt; int ui = 0;
    if (!S.next(0, cur)) return;
    PG8_STATDMA(cur, 0, lane);
    Acc acc;
#pragma unroll
    for (int a = 0; a < 2; ++a)
#pragma unroll
        for (int b = 0; b < 2; ++b)
#pragma unroll
            for (int m = 0; m < 4; ++m)
#pragma unroll
                for (int n = 0; n < 2; ++n) acc[a][b][m][n] = (f32x4){0.f, 0.f, 0.f, 0.f};
    bf16x8 At[4][2], B0[2][2], B1[2][2]; i32x8 At8[4], B08[2], B18[2];
    int f8one = 0x7f7f7f7f; asm volatile("" : "+v"(f8one));
    const char* cA = cur.a; const char* cB = cur.b;
    PG8_STAGE(PG8_SB(0, 0), cB, voffB); PG8_STAGE_BH(PG8_SB(0, 1), cB); PG8_STAGE(PG8_SA(0, 0), cA, voffA); PG8_STAGE_AH(PG8_SA(0, 1), cA);
    if (wr == 1) PG8_BAR;
    PG8_WAIT_V(2); PG8_BAR;
    PG8_STAGE(PG8_SB(1, 0), cB + kstep, voffB); PG8_STAGE(PG8_SA(1, 0), cA + kstep, voffA); PG8_STAGE_BH(PG8_SB(1, 1), cB + kstep);
    PG8_WAIT_V(6); PG8_BAR;
#define PG8_UNIT(MODE) { \
        const bool has_next = S.next(ui + 1, nxt); \
        const char* nA = has_next ? nxt.a : cA; const char* nB = has_next ? nxt.b : cB; \
        const int nt = cur.nt; \
        PG8_KLOOP(MODE) \
        if constexpr ((MODE) != 0) asm volatile("s_nop 15\n\ts_nop 15" ::: "memory");     \
        if constexpr (ALIGN_EPI && !Epi::BAR_INSIDE) { if (wr == 0) PG8_BAR; } \
        cur.bar = (ALIGN_EPI && Epi::BAR_INSIDE && wr == 0) ? 1 : 0; \
        const int le_ = lane_id_now();                                 \
        if (has_next) PG8_STATDMA(nxt, (ui + 1) & 1, le_); \
        cur.sp = (int)(unsigned)(unsigned long long)(lds + LDS_STATP + (ui & 1) * 2048); \
        const bool keep = E(acc, cur, wr, wc, le_ & 15, le_ >> 4); \
        if (!has_next) break; \
        if (!keep) { \
            _Pragma("unroll") for (int a = 0; a < 2; ++a) _Pragma("unroll") for (int b = 0; b < 2; ++b) _Pragma("unroll") for (int m = 0; m < 4; ++m) _Pragma("unroll") for (int n = 0; n < 2; ++n) acc[a][b][m][n] = (f32x4){0.f, 0.f, 0.f, 0.f}; \
        } \
        cur = nxt; cA = nA; cB = nB; ++ui; \
        if constexpr (ALIGN_EPI) { if (wr == 1) PG8_BAR; } }
    for (;;) {
        if constexpr (MIX) { PG8_UNIT(1) PG8_UNIT(1) PG8_UNIT(2) }
        else if constexpr (FP8) { PG8_UNIT(1) } else { PG8_UNIT(0) }
    }
    PG8_WAIT_V(0);
    if constexpr (!ALIGN_EPI) { if (wr == 0) PG8_BAR; }
    PG8_BAR;
#undef PG8_SA
#undef PG8_SB
#undef PG8_STAGE
#undef PG8_STAGE_AH
#undef PG8_STAGE_BH
#undef PG8_LDA
#undef PG8_LD8
#undef PG8_LDB
#undef PG8_MMA
#undef PG8_KLOOP
#undef PG8_STATDMA
#undef PG8_UNIT
#undef PG8_H0
#undef PG8_H1
#undef PG8_WAIT_V
#undef PG8_WAIT_L
#undef PG8_BAR
#undef PG8_SCHED
}
#else
template <class Epi, class Sched, bool ALIGN_EPI = false, bool FP8 = false>
DI void gemm_phase(LAS unsigned char* lds, const int tid_in, const int lda, const int ldb, const Sched& S, const Epi& E) {
    static_assert(!FP8, "the debug fallback is bf16 only");
    const int tid = tid_in, wid = __builtin_amdgcn_readfirstlane(tid >> 6), lane = tid & 63, wr = wid >> 2, wc = wid & 3, fr = lane & 15, fq = lane >> 4;
    Unit cur; Acc acc; bool keep = false;
    for (int ui = 0; S.next(ui, cur); ++ui) {
        if (!keep) {
#pragma unroll
            for (int a = 0; a < 2; ++a)
#pragma unroll
                for (int b = 0; b < 2; ++b)
#pragma unroll
                    for (int m = 0; m < 4; ++m)
#pragma unroll
                        for (int n = 0; n < 2; ++n) acc[a][b][m][n] = (f32x4){0.f, 0.f, 0.f, 0.f};
        }
        for (int k0 = 0; k0 < cur.nt * 64; k0 += 32) {
            bf16x8 Af[2][4], Bf[2][2];
#pragma unroll
            for (int ai = 0; ai < 2; ++ai)
#pragma unroll
                for (int m = 0; m < 4; ++m) Af[ai][m] = *(const bf16x8*)(cur.a + (size_t)(ai * 128 + wr * 64 + m * 16 + fr) * lda + (size_t)(k0 + fq * 8) * 2);
#pragma unroll
            for (int bj = 0; bj < 2; ++bj)
#pragma unroll
                for (int n = 0; n < 2; ++n) Bf[bj][n] = *(const bf16x8*)(cur.b + (size_t)(bj * 128 + wc * 32 + perm32(n * 16 + fr)) * ldb + (size_t)(k0 + fq * 8) * 2);
#pragma unroll
            for (int ai = 0; ai < 2; ++ai)
#pragma unroll
                for (int bj = 0; bj < 2; ++bj)
#pragma unroll
                    for (int m = 0; m < 4; ++m)
#pragma unroll
                        for (int n = 0; n < 2; ++n) acc[ai][bj][m][n] = __builtin_amdgcn_mfma_f32_16x16x32_bf16(Bf[bj][n], Af[ai][m], acc[ai][bj][m][n], 0, 0, 0);
        }
        if constexpr (ALIGN_EPI) __syncthreads();
        keep = E(acc, cur, wr, wc, fr, fq);
        if constexpr (ALIGN_EPI) __syncthreads();
    }
    __syncthreads();
}
#endif

struct SchedGrid {
    const char* A; const char* Bt; int lda, ldb, nM, nN, nt, G, c, pn0;
    DI bool next(int i, Unit& u) const {
        const long L = (long)i * G + c; if (L >= (long)nM * nN) return false;
        tile_order((int)L, nM, nN, u.pm, u.pn); u.pn += pn0; u.aux = 0; u.nt = nt;
        u.a = A + (size_t)u.pm * 256 * lda; u.b = Bt + (size_t)u.pn * 256 * ldb; return true;
    }
};
}

namespace epi {
using pg8::Acc; using pg8::Unit;
DI float row_rs(const stat_t* stat, int row, float inv_n) { return __builtin_amdgcn_rsqf((float)stat[row] * STAT_INV * inv_n + EPS); }

DI void load_rs(const stat_t* stat, int row0, float inv_n, float mul, float (&rs)[2][4]) {
    stat_t v[2][4];
#pragma unroll
    for (int ai = 0; ai < 2; ++ai)
#pragma unroll
        for (int m = 0; m < 4; ++m) v[ai][m] = stat ? stat[row0 + ai * 128 + m * 16] : (stat_t)0;
#pragma unroll
    for (int ai = 0; ai < 2; ++ai)
#pragma unroll
        for (int m = 0; m < 4; ++m) rs[ai][m] = stat ? mul * __builtin_amdgcn_rsqf((float)v[ai][m] * STAT_INV * inv_n + EPS) : mul;
}
DI void load_rs_lds(bool has, int sp, int rl0, float inv_n, float mul, float (&rs)[2][4]) {
    const LAS stat_t* sb = (const LAS stat_t*)(size_t)(unsigned)sp; stat_t v[2][4];
#pragma unroll
    for (int ai = 0; ai < 2; ++ai)
#pragma unroll
        for (int m = 0; m < 4; ++m) v[ai][m] = has ? sb[rl0 + ai * 128 + m * 16] : (stat_t)0;
#pragma unroll
    for (int ai = 0; ai < 2; ++ai)
#pragma unroll
        for (int m = 0; m < 4; ++m) rs[ai][m] = has ? mul * __builtin_amdgcn_rsqf((float)v[ai][m] * STAT_INV * inv_n + EPS) : mul;
}
DI void stat_atomics(const float (&ss)[2][4], stat_t* stat, int row0, int fq) {
#pragma unroll
    for (int ai = 0; ai < 2; ++ai)
#pragma unroll
        for (int m = 0; m < 4; ++m) { float s = ss[ai][m]; s += swz_xor<16>(s); s = half_sum(s);
            if (fq == 0) atomic_adds(stat + row0 + ai * 128 + m * 16, s); }
}

template <int EMASK> struct EpiIn {
    const stat_t* stat_in; bf16_t* ZC; bf16_t* KPE; bf16_t* MQK; bf16_t* PL; bf16_t* G;
    stat_t* stat_cq; stat_t* stat_ckv; float* ksum; const f32x2* cs128; const f32x2* cs64; float dsc;
    static constexpr bool BAR_INSIDE = false;
    DI const stat_t* stat_src() const { return stat_in; }
    DI bool operator()(Acc& acc, const Unit& u, int wr, int wc, int fr, int fq) const {
        asm volatile("" : "+v"(fr), "+v"(fq));
        const int row0 = u.pm * 256 + wr * 64 + fr, tile = u.pn;
        float rs[2][4]; load_rs_lds(stat_in != nullptr, u.sp, wr * 64 + fr, 1.0f / D, dsc, rs);
        if ((EMASK & 1) && tile < 4) {
            float ss[2][4];
#pragma unroll
            for (int ai = 0; ai < 2; ++ai)
#pragma unroll
                for (int m = 0; m < 4; ++m) { const int row = row0 + ai * 128 + m * 16; const float rsv = rs[ai][m]; float s = 0.f;
#pragma unroll
                    for (int bj = 0; bj < 2; ++bj) { const f32x4 v0 = acc[ai][bj][m][0] * rsv, v1 = acc[ai][bj][m][1] * rsv;
                        s += (v0[0] * v0[0] + v0[1] * v0[1]) + (v0[2] * v0[2] + v0[3] * v0[3]) + (v1[0] * v1[0] + v1[1] * v1[1]) + (v1[2] * v1[2] + v1[3] * v1[3]);
                        if constexpr (F8_B) *(u32x2*)((unsigned char*)ZC + (size_t)row * 1024 + tile * 256 + bj * 128 + wc * 32 + 8 * fq) = pack8_fp8(v0 * F8_SZ, v1 * F8_SZ);
                        else *(u32x4*)(ZC + (size_t)row * 1024 + tile * 256 + bj * 128 + wc * 32 + 8 * fq) = pack8(v0, v1); }
                    ss[ai][m] = s; }
            stat_atomics(ss, tile < 2 ? stat_cq : stat_ckv, row0, fq);
        } else if ((EMASK & 2) && tile == 4) {
            if (wc == 0) {
#pragma unroll
                for (int ai = 0; ai < 2; ++ai)
#pragma unroll
                    for (int m = 0; m < 4; ++m) { const int row = row0 + ai * 128 + m * 16; const float rsv = rs[ai][m]; const f32x2* cs = cs64 + (size_t)row * 32 + 8 * fq;
                        f32x4 o1[2], o2[2];
#pragma unroll
                        for (int n = 0; n < 2; ++n)
#pragma unroll
                            for (int e = 0; e < 4; ++e) { const f32x2 c = cs[4 * n + e]; const float x1 = acc[ai][0][m][n][e] * rsv, x2 = acc[ai][1][m][n][e] * rsv;
                                o1[n][e] = x1 * c.x - x2 * c.y; o2[n][e] = x2 * c.x + x1 * c.y; }
                        *(u32x4*)(KPE + (size_t)row * 64 + 8 * fq) = pack8(o1[0], o1[1]);
                        *(u32x4*)(KPE + (size_t)row * 64 + 32 + 8 * fq) = pack8(o2[0], o2[1]); }
            }
        } else if ((EMASK & 4) && tile < 10) {
            const int tt = tile - 5, hd = 2 * tt + (wc >> 1), dl0 = (32 * wc + 8 * fq) & 63;
            f32x4 cs1[2], cs2[2];
#pragma unroll
            for (int n = 0; n < 2; ++n) { cs1[n] = (f32x4){0.f, 0.f, 0.f, 0.f}; cs2[n] = (f32x4){0.f, 0.f, 0.f, 0.f}; }
#pragma unroll
            for (int ai = 0; ai < 2; ++ai)
#pragma unroll
                for (int m = 0; m < 4; ++m) { const int row = row0 + ai * 128 + m * 16; const float rsv = rs[ai][m]; const f32x2* cs = cs128 + (size_t)row * 64 + dl0;
                    f32x4 o1[2], o2[2];
#pragma unroll
                    for (int n = 0; n < 2; ++n)
#pragma unroll
                        for (int e = 0; e < 4; ++e) { const f32x2 c = cs[4 * n + e]; const float x1 = acc[ai][0][m][n][e] * rsv, x2 = acc[ai][1][m][n][e] * rsv;
                            o1[n][e] = x1 * c.x - x2 * c.y; o2[n][e] = x2 * c.x + x1 * c.y; }
                    *(u32x4*)(MQK + (size_t)row * 1280 + hd * 128 + dl0) = pack8(o1[0], o1[1]);
                    *(u32x4*)(MQK + (size_t)row * 1280 + hd * 128 + 64 + dl0) = pack8(o2[0], o2[1]);
                    cs1[0] += o1[0]; cs1[1] += o1[1]; cs2[0] += o2[0]; cs2[1] += o2[1]; }
            if (hd >= 5) {
                float* kd = ksum + ((size_t)u.pm * 5 + (hd - 5)) * 128 + dl0;
#pragma unroll
                for (int n = 0; n < 2; ++n)
#pragma unroll
                    for (int e = 0; e < 4; ++e) { float a = cs1[n][e], b = cs2[n][e];
                        a += swz_xor<1>(a); b += swz_xor<1>(b); a += swz_xor<2>(a); b += swz_xor<2>(b); a += swz_xor<4>(a); b += swz_xor<4>(b); a += swz_xor<8>(a); b += swz_xor<8>(b);
                        if (fr == 0) { atomic_addf(kd + 4 * n + e, a); atomic_addf(kd + 64 + 4 * n + e, b); } }
            }
        } else if ((EMASK & 8) && tile < 20) {
#pragma unroll
            for (int ai = 0; ai < 2; ++ai)
#pragma unroll
                for (int m = 0; m < 4; ++m) { const int row = row0 + ai * 128 + m * 16; const float rsv = rs[ai][m];
#pragma unroll
                    for (int bj = 0; bj < 2; ++bj)
                        *(u32x4*)(PL + (size_t)row * 2560 + (tile - 10) * 256 + bj * 128 + wc * 32 + 8 * fq) = pack8(acc[ai][bj][m][0] * rsv, acc[ai][bj][m][1] * rsv); }
        } else if (EMASK & 16) {
            unsigned char* G8 = (unsigned char*)G;
#pragma unroll
            for (int ai = 0; ai < 2; ++ai)
#pragma unroll
                for (int m = 0; m < 4; ++m) { const int row = row0 + ai * 128 + m * 16; const float rsn = rs[ai][m] * -LOG2E;
#pragma unroll
                    for (int bj = 0; bj < 2; ++bj) { unsigned q[8];
#pragma unroll
                        for (int e = 0; e < 8; ++e) { const float t = acc[ai][bj][m][e >> 2][e & 3] * rsn;
                            q[e] = __float_as_uint(fmaxf(__builtin_fmaf(fast_rcp(1.0f + fast_exp2(t)), 255.0f, 8388608.0f), 8388609.0f)); }
                        u32x2 w; w.x = __builtin_amdgcn_perm(__builtin_amdgcn_perm(q[3], q[2], 0x0c0c0400u), __builtin_amdgcn_perm(q[1], q[0], 0x0c0c0400u), 0x05040100u);
                        w.y = __builtin_amdgcn_perm(__builtin_amdgcn_perm(q[7], q[6], 0x0c0c0400u), __builtin_amdgcn_perm(q[5], q[4], 0x0c0c0400u), 0x05040100u);
                        *(u32x2*)(G8 + (size_t)row * 6144 + (tile - 20) * 256 + bj * 128 + wc * 32 + 8 * fq) = w; } }
        }
        return false;
    }
};

struct EpiPlain {
    bf16_t* O; int ldo; const stat_t* stat; float inv_n; float osc;
    static constexpr bool BAR_INSIDE = false;
    DI const stat_t* stat_src() const { return stat; }
    DI bool operator()(Acc& acc, const Unit& u, int wr, int wc, int fr, int fq) const {
        asm volatile("" : "+v"(fr), "+v"(fq));
        const int row0 = u.pm * 256 + wr * 64 + fr;
        float rs[2][4]; load_rs_lds(stat != nullptr, u.sp, wr * 64 + fr, inv_n, osc, rs);
#pragma unroll
        for (int ai = 0; ai < 2; ++ai)
#pragma unroll
            for (int m = 0; m < 4; ++m) { const int row = row0 + ai * 128 + m * 16; const float r = rs[ai][m];
#pragma unroll
                for (int bj = 0; bj < 2; ++bj)
                    *(u32x4*)(O + (size_t)row * ldo + u.pn * 256 + bj * 128 + wc * 32 + 8 * fq) = pack8(acc[ai][bj][m][0] * r, acc[ai][bj][m][1] * r); }
        return false;
    }
};

struct EpiMoeDown {
    bf16_t* YS; bf16_t* YP; int tail_row0; size_t slab; float osc;
    static constexpr bool BAR_INSIDE = false;
    DI const stat_t* stat_src() const { return nullptr; }
    DI bool operator()(Acc& acc, const Unit& u, int wr, int wc, int fr, int fq) const {
        asm volatile("" : "+v"(fr), "+v"(fq));
        const int row0 = u.pm * 256 + wr * 64 + fr;
        bf16_t* O = u.aux ? YP + (size_t)(u.aux - 1) * slab - (size_t)tail_row0 * D : YS;
#pragma unroll
        for (int ai = 0; ai < 2; ++ai)
#pragma unroll
            for (int m = 0; m < 4; ++m) { const int row = row0 + ai * 128 + m * 16;
#pragma unroll
                for (int bj = 0; bj < 2; ++bj)
                    *(u32x4*)(O + (size_t)row * D + u.pn * 256 + bj * 128 + wc * 32 + 8 * fq) = pack8(acc[ai][bj][m][0] * osc, acc[ai][bj][m][1] * osc); }
        return false;
    }
};

struct EpiUQ {
    bf16_t* QA; const stat_t* stat; const f32x2* cs64; float dsc;
    static constexpr bool BAR_INSIDE = false;
    DI const stat_t* stat_src() const { return stat; }
    DI bool operator()(Acc& acc, const Unit& u, int wr, int wc, int fr, int fq) const {
        asm volatile("" : "+v"(fr), "+v"(fq));
        const int row0 = u.pm * 256 + wr * 64 + fr, tile = u.pn;
        float rs[2][4]; load_rs_lds(stat != nullptr, u.sp, wr * 64 + fr, 1.0f / 512, dsc, rs);
        if (tile < 3) {
#pragma unroll
            for (int ai = 0; ai < 2; ++ai)
#pragma unroll
                for (int m = 0; m < 4; ++m) { const int row = row0 + ai * 128 + m * 16; const float r = rs[ai][m];
#pragma unroll
                    for (int bj = 0; bj < 2; ++bj) { const int h = tile * 2 + bj;
                        *(u32x4*)(QA + (size_t)row * 1152 + h * 192 + wc * 32 + 8 * fq) = pack8(acc[ai][bj][m][0] * r, acc[ai][bj][m][1] * r); } }
        } else { const int h = (tile - 3) * 4 + wc;
            if (h < 6) {
#pragma unroll
                for (int g = 0; g < 4; ++g) { const int ai = g >> 1, mb = (g & 1) * 2;
                    f32x4 cs[2][4];
#pragma unroll
                    for (int mm = 0; mm < 2; ++mm) { const f32x4* cp = (const f32x4*)(cs64 + (size_t)(row0 + ai * 128 + (mb + mm) * 16) * 32 + 8 * fq);
#pragma unroll
                        for (int q = 0; q < 4; ++q) cs[mm][q] = cp[q]; }
#pragma unroll
                    for (int mm = 0; mm < 2; ++mm) { const int m = mb + mm; const int row = row0 + ai * 128 + m * 16; const float r = rs[ai][m]; f32x4 o1[2], o2[2];
#pragma unroll
                        for (int n = 0; n < 2; ++n)
#pragma unroll
                            for (int e = 0; e < 4; ++e) { const f32x4 cc = cs[mm][2 * n + (e >> 1)]; const float c = cc[2 * (e & 1)], sn = cc[2 * (e & 1) + 1];
                                const float x1 = acc[ai][0][m][n][e] * r, x2 = acc[ai][1][m][n][e] * r; o1[n][e] = x1 * c - x2 * sn; o2[n][e] = x2 * c + x1 * sn; }
                        *(u32x4*)(QA + (size_t)row * 1152 + h * 192 + 128 + 8 * fq) = pack8(o1[0], o1[1]);
                        *(u32x4*)(QA + (size_t)row * 1152 + h * 192 + 160 + 8 * fq) = pack8(o2[0], o2[1]); }
                    asm volatile("" ::: "memory"); } } }
        return false;
    }
};

struct EpiUp {
    const unsigned char* G; bf16_t* MERGED;
    static constexpr bool BAR_INSIDE = true;
    DI const stat_t* stat_src() const { return nullptr; }
    DI bool operator()(Acc& acc, const Unit& u, int wr, int wc, int fr, int fq) const {
        asm volatile("" : "+v"(fr), "+v"(fq));
        const int row0 = u.pm * 256 + wr * 64 + fr, br = u.aux; const int col0 = u.pn * 256 + wc * 32 + 8 * fq;
        const bool fin = br == 2; const int gboff = fin ? 0 : 2048; const float bs = (F8_DUP && br == 1) ? F8_SO * F8_SW : 1.0f;
        u32x2 ga[2][4][2], gb[2][4][2];
#pragma unroll
        for (int ai = 0; ai < 2; ++ai)
#pragma unroll
            for (int m = 0; m < 4; ++m)
#pragma unroll
                for (int bj = 0; bj < 2; ++bj) { const unsigned char* gp = G + (size_t)(row0 + ai * 128 + m * 16) * 6144 + br * 2048 + col0 + bj * 128; ga[ai][m][bj] = *(const u32x2*)gp; gb[ai][m][bj] = *(const u32x2*)(gp + gboff); }
        if (u.bar) { asm volatile("" ::: "memory"); __builtin_amdgcn_s_barrier(); asm volatile("" ::: "memory"); }
#pragma unroll
        for (int ai = 0; ai < 2; ++ai)
#pragma unroll
            for (int m = 0; m < 4; ++m)
#pragma unroll
                for (int bj = 0; bj < 2; ++bj) {
#pragma unroll
                    for (int q = 0; q < 2; ++q) { const unsigned a = ga[ai][m][bj][q], b = gb[ai][m][bj][q];
                        const float d0 = fin ? (1.0f / 255.0f) : fast_rcp(ubf<0>(b) * bs), d1 = fin ? (1.0f / 255.0f) : fast_rcp(ubf<1>(b) * bs),
                                    d2 = fin ? (1.0f / 255.0f) : fast_rcp(ubf<2>(b) * bs), d3 = fin ? (1.0f / 255.0f) : fast_rcp(ubf<3>(b) * bs);
                        acc[ai][bj][m][q][0] *= ubf<0>(a) * d0; acc[ai][bj][m][q][1] *= ubf<1>(a) * d1;
                        acc[ai][bj][m][q][2] *= ubf<2>(a) * d2; acc[ai][bj][m][q][3] *= ubf<3>(a) * d3; }
                    if (fin) *(u32x4*)(MERGED + (size_t)(row0 + ai * 128 + m * 16) * D + col0 + bj * 128) = pack8(acc[ai][bj][m][0], acc[ai][bj][m][1]); }
        return !fin;
    }
};

struct EpiRes {
    bf16_t* HB; stat_t* stat; unsigned char* HB8; float dsc;
    static constexpr bool BAR_INSIDE = true;
    DI const stat_t* stat_src() const { return nullptr; }
    DI bool operator()(Acc& acc, const Unit& u, int wr, int wc, int fr, int fq) const {
        asm volatile("" : "+v"(fr), "+v"(fq));
        const int row0 = u.pm * 256 + wr * 64 + fr; float ss[2][4]; const int col0 = u.pn * 256 + wc * 32 + 8 * fq;
#pragma unroll
        for (int ai = 0; ai < 2; ++ai) {
            u32x4 h[4][2];
#pragma unroll
            for (int m = 0; m < 4; ++m)
#pragma unroll
                for (int bj = 0; bj < 2; ++bj) h[m][bj] = *(const u32x4*)(HB + (size_t)(row0 + ai * 128 + m * 16) * D + col0 + bj * 128);
            if (ai == 0 && u.bar) { asm volatile("" ::: "memory"); __builtin_amdgcn_s_barrier(); asm volatile("" ::: "memory"); }
#pragma unroll
            for (int m = 0; m < 4; ++m) { float s = 0.f;
#pragma unroll
                for (int bj = 0; bj < 2; ++bj) { const size_t off = (size_t)(row0 + ai * 128 + m * 16) * D + col0 + bj * 128; const u32x4 hw = h[m][bj];
                    const f32x4 v0 = (f32x4){bf_lo(hw[0]), bf_hi(hw[0]), bf_lo(hw[1]), bf_hi(hw[1])} + acc[ai][bj][m][0] * dsc, v1 = (f32x4){bf_lo(hw[2]), bf_hi(hw[2]), bf_lo(hw[3]), bf_hi(hw[3])} + acc[ai][bj][m][1] * dsc;
                    *(u32x4*)(HB + off) = pack8(v0, v1);
                    if (HB8) *(u32x2*)(HB8 + off) = pack8_fp8(v0 * F8_SA, v1 * F8_SA);
                    s += (v0[0] * v0[0] + v0[1] * v0[1]) + (v0[2] * v0[2] + v0[3] * v0[3]) + (v1[0] * v1[0] + v1[1] * v1[1]) + (v1[2] * v1[2] + v1[3] * v1[3]); }
                ss[ai][m] = s; }
            asm volatile("" ::: "memory"); }
        stat_atomics(ss, stat, row0, fq);
        return false;
    }
};

template <bool F8> struct EpiSwiglu {
    void* Ov; int ldo; const stat_t* stat; float dsc;
    static constexpr bool BAR_INSIDE = false;
    DI const stat_t* stat_src() const { return stat; }
    DI bool operator()(Acc& acc, const Unit& u, int wr, int wc, int fr, int fq) const {
        asm volatile("" : "+v"(fr), "+v"(fq));
        const int row0 = u.pm * 256 + wr * 64 + fr;
        float rs[2][4]; load_rs_lds(stat != nullptr, u.sp, wr * 64 + fr, 1.0f / D, dsc, rs);
#pragma unroll
        for (int ai = 0; ai < 2; ++ai)
#pragma unroll
            for (int m = 0; m < 4; ++m) { const int row = row0 + ai * 128 + m * 16; const float r = rs[ai][m];
                f32x4 o[2]; const float rn = r * -LOG2E, rb = r * (F8 ? F8_SA : 1.0f);
#pragma unroll
                for (int n = 0; n < 2; ++n) { const f32x4 a = acc[ai][0][m][n] * r, t = acc[ai][0][m][n] * rn, b = acc[ai][1][m][n] * rb; f32x4 sg;
#pragma unroll
                    for (int e = 0; e < 4; ++e) sg[e] = fast_rcp(1.0f + fast_exp2(t[e]));
                    o[n] = (a * sg) * b; }
                if constexpr (F8) *(u32x2*)((unsigned char*)Ov + (size_t)row * ldo + u.pn * 128 + wc * 32 + 8 * fq) = pack8_fp8(o[0], o[1]);
                else *(u32x4*)((bf16_t*)Ov + (size_t)row * ldo + u.pn * 128 + wc * 32 + 8 * fq) = pack8(o[0], o[1]); }
        return false;
    }
};

struct EpiXS {
    bf16_t* PX; LAS float* scr; const stat_t* stat; float dsc; float p8;
    static constexpr bool BAR_INSIDE = false;
    DI const stat_t* stat_src() const { return stat; }
    DI bool operator()(Acc& acc, const Unit& u, int wr, int wc, int fr, int fq) const {
        asm volatile("" : "+v"(fr), "+v"(fq));
        const int row0 = u.pm * 256 + wr * 64 + fr;
        { float rs[2][4]; load_rs_lds(stat != nullptr, u.sp, wr * 64 + fr, 1.0f / D, dsc, rs);
#pragma unroll
        for (int ai = 0; ai < 2; ++ai)
#pragma unroll
            for (int m = 0; m < 4; ++m)
#pragma unroll
                for (int bj = 0; bj < 2; ++bj) { acc[ai][bj][m][0] *= rs[ai][m]; acc[ai][bj][m][1] *= rs[ai][m]; } }
        asm volatile("" ::: "memory");
#pragma unroll
        for (int ai = 0; ai < 2; ++ai)
#pragma unroll
            for (int m = 0; m < 4; ++m) { float v = -3.0e38f;
#pragma unroll
                for (int bj = 0; bj < 2; ++bj)
#pragma unroll
                    for (int n = 0; n < 2; ++n)
#pragma unroll
                        for (int e = 0; e < 4; ++e) v = fmaxf(v, acc[ai][bj][m][n][e]);
                v = fmaxf(v, swz_xor<16>(v)); v = half_max(v);
                if (fq == 0) scr[(ai * 128 + wr * 64 + m * 16 + fr) * 4 + wc] = v; }
        asm volatile("s_waitcnt lgkmcnt(0)" ::: "memory"); __builtin_amdgcn_s_barrier(); asm volatile("" ::: "memory");
#pragma unroll
        for (int ai = 0; ai < 2; ++ai)
#pragma unroll
            for (int m = 0; m < 4; ++m) { const f32x4 q = *(const LAS f32x4*)(scr + (ai * 128 + wr * 64 + m * 16 + fr) * 4);
                const float mxr = fmaxf(fmaxf(q[0], q[1]), fmaxf(q[2], q[3])); float s = 0.f;
#pragma unroll
                for (int bj = 0; bj < 2; ++bj)
#pragma unroll
                    for (int n = 0; n < 2; ++n)
#pragma unroll
                        for (int e = 0; e < 4; ++e) { const float p = fast_exp2(acc[ai][bj][m][n][e] - mxr); acc[ai][bj][m][n][e] = p; s += p; }
                s += swz_xor<16>(s); s = half_sum(s);
                if (fq == 0) scr[1024 + (ai * 128 + wr * 64 + m * 16 + fr) * 4 + wc] = s; }
        asm volatile("s_waitcnt lgkmcnt(0)" ::: "memory"); __builtin_amdgcn_s_barrier(); asm volatile("" ::: "memory");
#pragma unroll
        for (int ai = 0; ai < 2; ++ai)
#pragma unroll
            for (int m = 0; m < 4; ++m) { const int row = row0 + ai * 128 + m * 16; const f32x4 q = *(const LAS f32x4*)(scr + 1024 + (ai * 128 + wr * 64 + m * 16 + fr) * 4);
                const float inv = (p8 > 0.f ? p8 : 1.0f) / ((q[0] + q[1]) + (q[2] + q[3]));
#pragma unroll
                for (int bj = 0; bj < 2; ++bj) {
                    if (p8 > 0.f) *(u32x2*)((unsigned char*)PX + (size_t)row * 1024 + u.pn * 256 + bj * 128 + wc * 32 + 8 * fq) = pack8_fp8(acc[ai][bj][m][0] * inv, acc[ai][bj][m][1] * inv);
                    else *(u32x4*)(PX + (size_t)row * 1024 + u.pn * 256 + bj * 128 + wc * 32 + 8 * fq) = pack8(acc[ai][bj][m][0] * inv, acc[ai][bj][m][1] * inv); } }
        return false;
    }
};
}

namespace pg8 {
struct SchedUp {
    const char* A; const char* Bt; int G, c;
    DI bool next(int i, Unit& u) const {
        const int tr = i / 3, br = i - 3 * tr; const long L = (long)tr * G + c; if (L >= 64 * 8) return false;
        tile_order((int)L, 64, 8, u.pm, u.pn); u.aux = br;
        if (F8_DUP) { u.nt = br == 2 ? 10 : 6; const int kb = br == 0 ? 0 : (br == 1 ? 768 : 2816);
            u.a = A + (size_t)u.pm * 256 * D * 2 + kb; u.b = Bt + (size_t)u.pn * 256 * D * 2 + kb; return true; }
        u.nt = br == 0 ? 12 : 10;
        const int koff = br == 0 ? 0 : (br == 1 ? 768 : 1408);
        u.a = A + ((size_t)u.pm * 256 * D + koff) * 2; u.b = Bt + ((size_t)u.pn * 256 * D + koff) * 2; return true;
    }
};
struct SchedXS {
    const char* QX; const char* KM; int G, c;
    DI bool next(int i, Unit& u) const {
        const long L = (long)i * G + c; if (L >= 256) return false;
        const int hd = (int)L & 3, rt = (int)L >> 2;
        u.pm = rt; u.pn = hd; u.aux = 0; u.nt = 8;
        u.a = QX + ((size_t)rt * 256 * D + hd * 512) * 2; u.b = KM + ((size_t)(rt >> 4) * 256 * D + hd * 512) * 2; return true;
    }
};
struct SchedXPV {
    const char* PX; const char* VT; int G, c;
    DI bool next(int i, Unit& u) const {
        const long L = (long)i * G + c; if (L >= 512) return false;
        const int pn = (int)L & 7, rt = (int)L >> 3;
        u.pm = rt; u.pn = pn; u.aux = 0; u.nt = 4;
        u.a = PX + ((size_t)rt * 256 * 1024 + (pn >> 1) * 256) * 2; u.b = VT + ((size_t)pn * 256 * 1024 + (rt >> 4) * 256) * 2; return true;
    }
};
struct MoeTail { int nused, nb_main, f; };
DI MoeTail moe_tail_plan(const unsigned* counts, int G) {
    int b = 0;
#pragma unroll
    for (int e = 0; e < 8; ++e) { const unsigned cnt = __hip_atomic_load(counts + 64 * e, __ATOMIC_RELAXED, __HIP_MEMORY_SCOPE_AGENT); b += (int)((cnt + 255u) >> 8); }
    MoeTail p; p.nused = b; p.nb_main = b; p.f = 1;
    if (MOE_TAIL && F8_MOE && (G & 7) == 0) { const int total = b * 8, nfull = (total / G) * G, R = total - nfull;
        const int f = R == 0 ? 1 : (R * 14 <= G ? 14 : (R * 7 <= G ? 7 : (R * 4 <= G ? 4 : (R * 2 <= G ? 2 : 1))));
        if (f > 1) { p.f = f; p.nb_main = nfull / 8; } }
    return p;
}
struct SchedMoE {
    const char* A; const char* Bt; int lda, nN, nt, G, c; size_t wstride; int nused; int bend[8];
    DI void init_counts(const unsigned* counts) { int b = 0;
#pragma unroll
        for (int e = 0; e < 8; ++e) { const unsigned cnt = __hip_atomic_load(counts + 64 * e, __ATOMIC_RELAXED, __HIP_MEMORY_SCOPE_AGENT); b += (int)((cnt + 255u) >> 8); bend[e] = b; }
        nused = b; }
    DI bool next(int i, Unit& u) const {
        const long L = (long)i * G + c; if (L >= (long)nused * nN) return false;
        tile_order((int)L, nused, nN, u.pm, u.pn); u.aux = 0; u.nt = nt;
        int e = 0;
#pragma unroll
        for (int q = 0; q < 7; ++q) e += (u.pm >= bend[q]) ? 1 : 0;
        u.a = A + (size_t)u.pm * 256 * lda; u.b = Bt + (size_t)e * wstride + (size_t)u.pn * 256 * (size_t)(nt * 128); return true;
    }
};
struct SchedMoEDown {
    const char* A; const char* Bt; int lda, G, c; size_t wstride; int nused, nb_main, f; int bend[8];
    DI void init_counts(const unsigned* counts) { int b = 0;
#pragma unroll
        for (int e = 0; e < 8; ++e) { const unsigned cnt = __hip_atomic_load(counts + 64 * e, __ATOMIC_RELAXED, __HIP_MEMORY_SCOPE_AGENT); b += (int)((cnt + 255u) >> 8); bend[e] = b; }
        const MoeTail p = moe_tail_plan(counts, G); nused = p.nused; nb_main = p.nb_main; f = p.f; }
    DI bool next(int i, Unit& u) const {
        const long L = (long)i * G + c; const int nmain = nb_main * 8; int koff = 0;
        if (L < nmain) { tile_order((int)L, nb_main, 8, u.pm, u.pn); u.aux = 0; u.nt = 56; }
        else { const int s_ = (int)(L - nmain), R = (nused - nb_main) * 8; if (s_ >= R * f) return false;
            const int j = s_ / R, t = s_ - j * R; u.pm = nb_main + (t >> 3); u.pn = t & 7; u.aux = j; u.nt = 56 / f; koff = j * u.nt * 128; }
        int e = 0;
#pragma unroll
        for (int q = 0; q < 7; ++q) e += (u.pm >= bend[q]) ? 1 : 0;
        u.a = A + (size_t)u.pm * 256 * lda + koff; u.b = Bt + (size_t)e * wstride + (size_t)u.pn * 256 * (size_t)lda + koff; return true;
    }
};
}

struct Params {
    const float* x; const float* mem; const int* positions;
    const float *g_mix, *w_in, *g_cq, *g_ckv, *w_uq, *w_ukv, *w_up_a, *w_up_b, *w_up_c, *w_o, *g_x, *g_mem, *w_xq, *w_xk, *w_xv, *w_xo, *g_ffn, *w_ff1, *w_ff3, *w_ff2, *w_router, *w_e1, *w_e3, *w_e2, *g_final;
    float* out; unsigned char* ws; int ph_lo, ph_hi;
};
struct Frame { LAS unsigned char* lds; int tid, lane, wave, G, bid; };
typedef const __attribute__((address_space(4))) Params* KPtr;
#define KP_HERE KPtr kp = (KPtr)__builtin_amdgcn_kernarg_segment_ptr(); asm volatile("" : "+s"(kp));
#define FRAME_HERE Frame F; { int w_ = wave_id_; asm volatile("" : "+s"(w_)); int t_ = w_ * 64 + lane_id_now(), b_ = blockIdx.x, g_ = gridDim.x; asm volatile("" : "+v"(t_)); asm volatile("" : "+s"(b_), "+s"(g_)); \
        F.lds = (LAS unsigned char*)lds_; F.tid = t_; F.lane = t_ & 63; F.wave = __builtin_amdgcn_readfirstlane(t_ >> 6); F.G = g_; F.bid = b_; }


template <bool F8, class Map>
DI void transpose_cvt(const Frame& F, const float* __restrict__ W, int ldw, int K, void* __restrict__ dstv, int ldd, int koff, int ngroups, const float* __restrict__ gain, Map map, int& rot) {
    bf16_t* dst = (bf16_t*)dstv; unsigned char* dst8 = (unsigned char*)dstv;
    LAS float* scr = (LAS float*)(F.lds + F.wave * 17408);
    const int NGW = F.G * NWAVES, gw = F.bid * NWAVES + F.wave, lane = F.lane;
    if (F8 && (K & 127) == 0) {
        const int items8 = (K / 128) * ngroups, c8 = lane & 7, nl = lane >> 3;
        int it8 = gw - rot; if (it8 < 0) it8 += NGW;
        for (; it8 < items8; it8 += NGW) {
            const int kb = it8 / ngroups, ng = it8 - kb * ngroups, k0 = kb * 128;
            int src; float sc; map(ng, src, sc);
            if (src == -2) continue;
            if (src < 0) {
#pragma unroll
                for (int j = 0; j < 4; ++j) *(u32x4*)(dst8 + (size_t)(ng * 32 + nl + 8 * j) * ldd + koff + k0 + 16 * c8) = (u32x4){0u, 0u, 0u, 0u};
                continue;
            }
            f32x4 v[16];
#pragma unroll
            for (int i = 0; i < 16; ++i) v[i] = *(const f32x4*)(W + (size_t)(k0 + 8 * i + nl) * ldw + src + 4 * c8);
#pragma unroll
            for (int i = 0; i < 16; ++i) { const float g = (gain ? gain[k0 + 8 * i + nl] : 1.0f) * sc;
                LAS float* sp = scr + (8 * (i >> 1) + nl + 64 * (i & 1)) * 33 + 4 * c8; sp[0] = v[i][0] * g; sp[1] = v[i][1] * g; sp[2] = v[i][2] * g; sp[3] = v[i][3] * g; }
            asm volatile("s_waitcnt lgkmcnt(0)" ::: "memory");
#pragma unroll
            for (int j = 0; j < 4; ++j) { const int n = nl + 8 * j; const LAS float* sp = scr + (8 * c8) * 33 + n; const LAS float* sq = sp + 64 * 33; u32x4 o;
                o.x = pk_fp8x4(sp[0 * 33], sp[1 * 33], sp[2 * 33], sp[3 * 33]); o.y = pk_fp8x4(sp[4 * 33], sp[5 * 33], sp[6 * 33], sp[7 * 33]);
                o.z = pk_fp8x4(sq[0 * 33], sq[1 * 33], sq[2 * 33], sq[3 * 33]); o.w = pk_fp8x4(sq[4 * 33], sq[5 * 33], sq[6 * 33], sq[7 * 33]);
                *(u32x4*)(dst8 + (size_t)(ng * 32 + n) * ldd + koff + k0 + 16 * c8) = o; }
            asm volatile("s_waitcnt lgkmcnt(0)" ::: "memory");
        }
        rot = (rot + items8) % NGW;
        return;
    }
    const int items = (K / 64) * ngroups;
    int it = gw - rot; if (it < 0) it += NGW;
    for (; it < items; it += NGW) {
        int kb, ng; if (F8 && !((K / 64) & 1) && !(rot & 1)) { const int pi = it >> 1, kp = pi / ngroups; ng = pi - kp * ngroups; kb = 2 * kp + (it & 1); } else { kb = it / ngroups; ng = it - kb * ngroups; }
        const int k0 = kb * 64;
        int src; float sc; map(ng, src, sc);
        const int c8 = lane & 7;
        if (src == -2) continue;
        if (src < 0) {
#pragma unroll
            for (int j = 0; j < 4; ++j) { const int n = (lane >> 3) + 8 * j; if constexpr (F8) *(u32x2*)(dst8 + (size_t)(ng * 32 + n) * ldd + koff + k0 + 8 * c8) = (u32x2){0u, 0u}; else *(u32x4*)(dst + (size_t)(ng * 32 + n) * ldd + koff + k0 + 8 * c8) = (u32x4){0u, 0u, 0u, 0u}; }
            continue;
        }
        f32x4 v[8];
#pragma unroll
        for (int i = 0; i < 8; ++i) { const int kk = 8 * i + (lane >> 3); v[i] = *(const f32x4*)(W + (size_t)(k0 + kk) * ldw + src + 4 * c8); }
#pragma unroll
        for (int i = 0; i < 8; ++i) { const int kk = 8 * i + (lane >> 3); const float g = (gain ? gain[k0 + kk] : 1.0f) * sc;
            LAS float* s = scr + kk * 33 + 4 * c8; s[0] = v[i][0] * g; s[1] = v[i][1] * g; s[2] = v[i][2] * g; s[3] = v[i][3] * g; }
        asm volatile("s_waitcnt lgkmcnt(0)" ::: "memory");
#pragma unroll
        for (int j = 0; j < 4; ++j) { const int n = (lane >> 3) + 8 * j; const LAS float* s = scr + (8 * c8) * 33 + n;
            if constexpr (F8) { u32x2 o; o.x = pk_fp8x4(s[0 * 33], s[1 * 33], s[2 * 33], s[3 * 33]); o.y = pk_fp8x4(s[4 * 33], s[5 * 33], s[6 * 33], s[7 * 33]);
                *(u32x2*)(dst8 + (size_t)(ng * 32 + n) * ldd + koff + k0 + 8 * c8) = o; }
            else { u32x4 o; o.x = cvt_pk_bf16(s[0 * 33], s[1 * 33]); o.y = cvt_pk_bf16(s[2 * 33], s[3 * 33]); o.z = cvt_pk_bf16(s[4 * 33], s[5 * 33]); o.w = cvt_pk_bf16(s[6 * 33], s[7 * 33]);
                *(u32x4*)(dst + (size_t)(ng * 32 + n) * ldd + koff + k0 + 8 * c8) = o; } }
        asm volatile("s_waitcnt lgkmcnt(0)" ::: "memory");
    }
    rot = (rot + items) % NGW;
}

DI void prologue(const Frame& F, KPtr kp) {
    unsigned char* ws = kp->ws; int rot = 0;
    const float QS128 = 0.08838834764831845f * LOG2E, QS192 = 0.07216878364870322f * LOG2E, QS512 = 0.04419417382415922f * LOG2E;
    for (int l = 0; l < 2; ++l) {
        if (F8_GATES) transpose_cvt<true>(F, kp->w_in + (size_t)l * D * IN_COLS, IN_COLS, D, ws + WS_WING8 + (size_t)l * 6144 * D, D, 0, 6144 / 32, kp->g_mix + l * D,
            [=](int ng, int& src, float& sc) { sc = F8_SW; src = 4928 + ng * 32; }, rot);
        auto win_map = [=](int ng, int& src, float& sc) { sc = 1.0f; const int n = ng * 32;
                if (n < 1024) { src = n; }
                else if (n < 1280) { const int p = n - 1024; src = (p == 0) ? 1024 : (p == 128 ? 1056 : -1); }
                else if (n < 2560) { const int tt = (n - 1280) >> 8, p = (n - 1280) & 255, bj = p >> 7, pp = p & 127, hd = 2 * tt + (pp >> 6), d = (pp & 63) + 64 * bj; src = 1088 + hd * 128 + d; if (hd < 5) sc = QS128; }
                else if (n < 5120) { src = 2368 + (n - 2560); if (src >= 3008 && src < 3648) sc = QS128; }
                else { src = 4928 + (n - 5120); } };
        constexpr int NG8 = (F8_AMM && F8_GATES) ? A8_TILES * 256 / 32 : 0;
        if (NG8) transpose_cvt<true>(F, kp->w_in + (size_t)l * D * IN_COLS, IN_COLS, D, ws + WS_WIN8X + l * SZ_WE13, D, 0, NG8, kp->g_mix + l * D,
            [=](int ng, int& src, float& sc) { win_map(ng, src, sc); sc *= F8_SW; }, rot);
        transpose_cvt<false>(F, kp->w_in + (size_t)l * D * IN_COLS, IN_COLS, D, (bf16_t*)(ws + WS_WIN + l * SZ_WIN) + (size_t)NG8 * 32 * D, D, 0, (F8_GATES ? 5120 : NIN) / 32 - NG8, kp->g_mix + l * D,
            [=](int ng, int& src, float& sc) { win_map(ng + NG8, src, sc); }, rot);
        transpose_cvt<F8_B>(F, kp->w_uq + (size_t)l * 512 * 1152, 1152, 512, ws + WS_WUQ + l * SZ_WUQ, 512, 0, 1280 / 32, kp->g_cq + l * 512,
            [=](int ng, int& src, float& sc) { sc = F8_B ? QS192 * F8_SW : QS192; const int n = ng * 32;
                if (n < 768) { src = (n >> 7) * 192 + (n & 127); }
                else { const int rt = (n - 768) >> 8, p = (n - 768) & 255, bj = p >> 7, hh = (p & 127) >> 5, h = 4 * rt + hh; src = h < 6 ? h * 192 + 128 + 32 * bj : -1; } }, rot);
        transpose_cvt<F8_B>(F, kp->w_ukv + (size_t)l * 512 * 1536, 1536, 512, ws + WS_WUKV + l * SZ_WUKV, 512, 0, 1536 / 32, kp->g_ckv + l * 512,
            [=](int ng, int& src, float& sc) { sc = F8_B ? F8_SW : 1.0f; src = ng * 32; }, rot);
        bf16_t* wup = (bf16_t*)(ws + WS_WUP + l * SZ_SQ);
        if (F8_DUP) {
            transpose_cvt<true>(F, kp->w_up_a + (size_t)l * 768 * D, D, 768, wup, 2 * D, 0, D / 32, nullptr, [=](int ng, int& src, float& sc) { sc = F8_SW; src = ng * 32; }, rot);
            transpose_cvt<true>(F, kp->w_up_b + (size_t)l * 640 * D, D, 640, wup, 2 * D, 768, D / 32, nullptr, [=](int ng, int& src, float& sc) { sc = F8_SW; src = ng * 32; }, rot);
            transpose_cvt<true>(F, kp->w_up_b + (size_t)l * 640 * D, D, 128, wup, 2 * D, 1408, D / 32, nullptr, [=](int ng, int& src, float& sc) { sc = 1.0f; src = -1; }, rot);
        } else {
        transpose_cvt<false>(F, kp->w_up_a + (size_t)l * 768 * D, D, 768, wup, D, 0, D / 32, nullptr, [=](int ng, int& src, float& sc) { sc = 1.0f; src = ng * 32; }, rot);
        transpose_cvt<false>(F, kp->w_up_b + (size_t)l * 640 * D, D, 640, wup, D, 768, D / 32, nullptr, [=](int ng, int& src, float& sc) { sc = 1.0f; src = ng * 32; }, rot); }
        transpose_cvt<false>(F, kp->w_up_c + (size_t)l * 640 * D, D, 640, wup, D, 1408, D / 32, nullptr, [=](int ng, int& src, float& sc) { sc = 1.0f; src = ng * 32; }, rot);
        transpose_cvt<false>(F, kp->w_o + (size_t)l * D * D, D, D, (bf16_t*)(ws + WS_WO + l * SZ_SQ), D, 0, D / 32, nullptr, [=](int ng, int& src, float& sc) { sc = 1.0f; src = ng * 32; }, rot);
        {
          const float* W = kp->w_xq + (size_t)l * D * D; bf16_t* O = (bf16_t*)(ws + WS_WXQ + l * SZ_SQ); const float* gx = kp->g_x + l * D;
          for (int c = F.bid * NTHR + F.tid; c < D * D / 8; c += F.G * NTHR) { const float g = gx[c >> 8] * (F8_XPRE ? QS512 * F8_SWQ : QS512);
              const f32x4 a = __builtin_nontemporal_load((const f32x4*)(W + (size_t)c * 8)), b = __builtin_nontemporal_load((const f32x4*)(W + (size_t)c * 8 + 4));
              if constexpr (F8_XPRE) *(u32x2*)((unsigned char*)O + (size_t)c * 8) = pack8_fp8(a * g, b * g);
              else *(u32x4*)(O + (size_t)c * 8) = pack8(a * g, b * g); } }
        transpose_cvt<F8_XPRE>(F, kp->w_xk + (size_t)l * D * D, D, D, ws + WS_WXK + l * SZ_SQ, D, 0, D / 32, nullptr, [=](int ng, int& src, float& sc) { sc = F8_XPRE ? F8_SW : 1.0f; src = ng * 32; }, rot);
        transpose_cvt<F8_XPRE>(F, kp->w_xv + (size_t)l * D * D, D, D, ws + WS_WXV + l * SZ_SQ, D, 0, D / 32, nullptr, [=](int ng, int& src, float& sc) { sc = F8_XPRE ? F8_SW : 1.0f; src = ng * 32; }, rot);
        transpose_cvt<F8_XPRE>(F, kp->w_xo + (size_t)l * D * D, D, D, ws + WS_WXO + l * SZ_SQ, D, 0, D / 32, nullptr, [=](int ng, int& src, float& sc) { sc = F8_XPRE ? F8_SW : 1.0f; src = ng * 32; }, rot);
    }
    { unsigned char* w13 = ws + WS_WFF13;
      for (int half = 0; half < 2; ++half) { const float* W = half ? kp->w_ff3 : kp->w_ff1;
        transpose_cvt<F8_DENSE>(F, W, DFF, D, w13, D, 0, NIN / 32, kp->g_ffn,
            [=](int ng, int& src, float& sc) { sc = F8_DENSE ? F8_SW : 1.0f; const int t = ng >> 3, bj = (ng >> 2) & 1, q = ng & 3; src = (bj == half) ? t * 128 + q * 32 : -2; }, rot); }
      transpose_cvt<(F8_DENSE || F8_DDOWN)>(F, kp->w_ff2, D, DFF, ws + WS_WFF2, DFF, 0, D / 32, nullptr, [=](int ng, int& src, float& sc) { sc = (F8_DENSE || F8_DDOWN) ? F8_SW : 1.0f; src = ng * 32; }, rot); }
    for (int e = 0; e < NEXP; ++e) {
        unsigned char* w13 = ws + WS_WE13 + e * SZ_WE13;
        for (int half = 0; half < 2; ++half) { const float* W = (half ? kp->w_e3 : kp->w_e1) + (size_t)e * D * DFE;
            transpose_cvt<F8_MOE>(F, W, DFE, D, w13, D, 0, 2 * DFE / 32, kp->g_ffn + D,
                [=](int ng, int& src, float& sc) { sc = F8_MOE ? F8_SW : 1.0f; const int t = ng >> 3, bj = (ng >> 2) & 1, q = ng & 3; src = (bj == half) ? t * 128 + q * 32 : -2; }, rot); }
        transpose_cvt<F8_MOE>(F, kp->w_e2 + (size_t)e * DFE * D, D, DFE, ws + WS_WE2 + e * SZ_WE2, DFE, 0, D / 32, nullptr, [=](int ng, int& src, float& sc) { sc = F8_MOE ? F8_SW : 1.0f; src = ng * 32; }, rot);
    }
    { f32x2* cs128 = (f32x2*)(ws + WS_CS128); f32x2* cs64 = (f32x2*)(ws + WS_CS64);
      const int gt = F.bid * NTHR + F.tid, NT_ = F.G * NTHR;
      for (int idx = gt; idx < T * 96; idx += NT_) { const int t = idx / 96, q = idx - t * 96;
          const float inv = q < 64 ? powf(10000.0f, -(float)q / 64.0f) : powf(10000.0f, -(float)(q - 64) / 32.0f);
          const float ang = (float)kp->positions[t] * inv;
          const double rev = (double)ang * 0.15915494309189535; const float fr = (float)(rev - floor(rev));
          const f32x2 v = {__builtin_amdgcn_cosf(fr), __builtin_amdgcn_sinf(fr)};
          if (q < 64) cs128[(size_t)t * 64 + q] = v; else cs64[(size_t)t * 32 + (q - 64)] = v; } }
    { const int gw = F.bid * NWAVES + F.wave, NGW = F.G * NWAVES, lane = F.lane;
      stat_t* stat = (stat_t*)((unsigned*)(ws + WS_CTL) + CW_STAT) + (ST_MIX * 2 + 0) * T;
      for (int r = gw; r < T + 1024; r += NGW) {
          const bool is_mem = r >= T; const float* src = is_mem ? kp->mem + (size_t)(r - T) * D : kp->x + (size_t)r * D;
          f32x4 v[8]; float s = 0.f;
#pragma unroll
          for (int j = 0; j < 8; ++j) { v[j] = *(const f32x4*)(src + 4 * lane + 256 * j); s += (v[j][0] * v[j][0] + v[j][1] * v[j][1]) + (v[j][2] * v[j][2] + v[j][3] * v[j][3]); }
          s = wave_sum(s);
          if (!is_mem) { if (lane == 0) stat[r] = (stat_t)(s * STAT_SCALE);
#pragma unroll
              for (int j = 0; j < 8; ++j) {
                  u32x2 w; w.x = cvt_pk_bf16(v[j][0], v[j][1]); w.y = cvt_pk_bf16(v[j][2], v[j][3]); *(u32x2*)((bf16_t*)(ws + WS_HB) + (size_t)r * D + 4 * lane + 256 * j) = w;
                  if (F8_GATES) *(unsigned*)(ws + WS_HB8 + (size_t)r * D + 4 * lane + 256 * j) = pk_fp8x4(v[j][0] * F8_SA, v[j][1] * F8_SA, v[j][2] * F8_SA, v[j][3] * F8_SA); }
          } else { const float rs = 1.0f / sqrtf(s * (1.0f / D) + EPS);
              for (int l = 0; l < 2; ++l) {
#pragma unroll
                  for (int j = 0; j < 8; ++j) { const f32x4 g = *(const f32x4*)(kp->g_mem + l * D + 4 * lane + 256 * j); const f32x4 o = v[j] * rs * g;
                      if constexpr (F8_XPRE) *(unsigned*)(ws + WS_MEMN + ((size_t)l * 1024 + (r - T)) * D + 4 * lane + 256 * j) = pk_fp8x4(o[0] * F8_SX, o[1] * F8_SX, o[2] * F8_SX, o[3] * F8_SX);
                      else { u32x2 w; w.x = cvt_pk_bf16(o[0], o[1]); w.y = cvt_pk_bf16(o[2], o[3]); *(u32x2*)((bf16_t*)(ws + WS_MEMN) + ((size_t)l * 1024 + (r - T)) * D + 4 * lane + 256 * j) = w; } } } }
      } }
}

DI void moe_router(const Frame& F, KPtr kp, const int dummy = 0) {
    unsigned char* ws = kp->ws;
    LAS float* gwt = (LAS float*)F.lds;
    LAS int* cnt = (LAS int*)(F.lds + 65536);
    for (int j = F.tid; j < D * 8; j += NTHR) { const int e = j >> 11, c = j & (D - 1); gwt[j] = kp->g_ffn[D + c] * kp->w_router[c * 8 + e]; }
    if (F.tid < 8) cnt[F.tid] = 0;
    __syncthreads();
    unsigned* tokE = (unsigned*)(ws + WS_TOK); f32x2* tokG = (f32x2*)(ws + WS_TOK + 65536); float* tokR = (float*)(ws + WS_TOK + 3 * 65536);
    const int lane = F.lane; const bf16_t* HBp = (const bf16_t*)(ws + WS_HB);
    for (int row0 = (F.bid * NWAVES + F.wave) * 2; row0 < T; row0 += F.G * NWAVES * 2) {
        u32x2 hw[2][8];
#pragma unroll
        for (int q = 0; q < 2; ++q)
#pragma unroll
            for (int j = 0; j < 8; ++j) hw[q][j] = *(const u32x2*)(HBp + (size_t)(row0 + q) * D + 4 * lane + 256 * j);
#pragma unroll
        for (int q = 0; q < 2; ++q) { const int row = row0 + q;
            float lg[8] = {0.f, 0.f, 0.f, 0.f, 0.f, 0.f, 0.f, 0.f}; float ss = 0.f;
#pragma unroll
            for (int j = 0; j < 8; ++j) { const f32x4 v = {bf_lo(hw[q][j].x), bf_hi(hw[q][j].x), bf_lo(hw[q][j].y), bf_hi(hw[q][j].y)};
                ss += (v[0] * v[0] + v[1] * v[1]) + (v[2] * v[2] + v[3] * v[3]);
#pragma unroll
                for (int e = 0; e < 8; ++e) { const f32x4 w = *(const LAS f32x4*)(gwt + e * D + 4 * lane + 256 * j); lg[e] += (v[0] * w[0] + v[1] * w[1]) + (v[2] * w[2] + v[3] * w[3]); } }
            ss = wave_sum(ss);
#pragma unroll
            for (int e = 0; e < 8; ++e) lg[e] = wave_sum(lg[e]);
            const float r = __builtin_amdgcn_rsqf(ss * (1.0f / D) + EPS);
            int i0 = 0; float v0 = lg[0];
#pragma unroll
            for (int e = 1; e < 8; ++e) if (lg[e] > v0) { v0 = lg[e]; i0 = e; }
            int i1 = -1; float v1 = -3.0e38f;
#pragma unroll
            for (int e = 0; e < 8; ++e) if (e != i0 && lg[e] > v1) { v1 = lg[e]; i1 = e; }
            const float g0 = 1.0f / (1.0f + expf((v1 - v0) * r)), g1 = 1.0f - g0;
            if (lane == 0) { tokE[row] = (unsigned)i0 | ((unsigned)i1 << 8); tokG[row] = (f32x2){g0, g1}; tokR[row] = r;
                __hip_atomic_fetch_add(cnt + i0, 1, __ATOMIC_RELAXED, __HIP_MEMORY_SCOPE_WORKGROUP); __hip_atomic_fetch_add(cnt + i1, 1, __ATOMIC_RELAXED, __HIP_MEMORY_SCOPE_WORKGROUP); } }
    }
    __syncthreads();
    if (F.tid < 8) { const int c = cnt[F.tid]; if (c) __hip_atomic_fetch_add((unsigned*)(ws + WS_CTL) + (dummy ? 700000 : CW_MOE) + 64 * F.tid, (unsigned)c, __ATOMIC_RELAXED, __HIP_MEMORY_SCOPE_AGENT); }
}
DI void moe_assign_gather(const Frame& F, KPtr kp) {
    unsigned char* ws = kp->ws;
    unsigned* ctl = (unsigned*)(ws + WS_CTL);
    const unsigned* tokE = (const unsigned*)(ws + WS_TOK); const float* tokR = (const float*)(ws + WS_TOK + 3 * 65536); int* slot = (int*)(ws + WS_TOK + 4 * 65536);
    unsigned char* XS = ws + WS_R2 + R2_XS;
    LAS int* sl = (LAS int*)F.lds;
    int pstart[8]; { int b = 0;
#pragma unroll
        for (int e = 0; e < 8; ++e) { pstart[e] = b * 256; const unsigned c = __hip_atomic_load(ctl + CW_MOE + 64 * e, __ATOMIC_RELAXED, __HIP_MEMORY_SCOPE_AGENT); b += (int)((c + 255u) >> 8); } }
    const int lane = F.lane; const bf16_t* HBp = (const bf16_t*)(ws + WS_HB);
    for (int batch = F.bid; batch < T / 64; batch += F.G) {
        if (F.wave == 0) { const int t = batch * 64 + lane; const unsigned ee = tokE[t];
#pragma unroll
            for (int k = 0; k < 2; ++k) { const int ek = (int)((ee >> (8 * k)) & 0xffu);
                unsigned long long mk[8]; int mycnt = 0;
#pragma unroll
                for (int e = 0; e < 8; ++e) { mk[e] = __ballot(ek == e); if (lane == e) mycnt = __popcll(mk[e]); }
                unsigned base = 0; if (lane < 8 && mycnt) base = __hip_atomic_fetch_add(ctl + CW_MOE + 512 + 64 * lane, (unsigned)mycnt, __ATOMIC_RELAXED, __HIP_MEMORY_SCOPE_AGENT);
                int myslot = 0;
#pragma unroll
                for (int e = 0; e < 8; ++e) { const unsigned be = (unsigned)__builtin_amdgcn_readlane((int)base, e); if (ek == e) myslot = pstart[e] + (int)be + __popcll(mk[e] & ((1ull << lane) - 1ull)); }
                sl[lane * 2 + k] = myslot; slot[t * 2 + k] = myslot; } }
        __syncthreads();
        for (int j = 0; j < 8; j += 2) {
            u32x2 hw[2][8]; int s0[2], s1[2]; float r[2];
#pragma unroll
            for (int q = 0; q < 2; ++q) { const int tl = F.wave * 8 + j + q, t = batch * 64 + tl; s0[q] = sl[tl * 2]; s1[q] = sl[tl * 2 + 1]; r[q] = tokR[t];
#pragma unroll
                for (int c = 0; c < 8; ++c) hw[q][c] = *(const u32x2*)(HBp + (size_t)t * D + 4 * lane + 256 * c); }
#pragma unroll
            for (int q = 0; q < 2; ++q)
#pragma unroll
                for (int c = 0; c < 8; ++c) { const f32x4 v = (f32x4){bf_lo(hw[q][c].x), bf_hi(hw[q][c].x), bf_lo(hw[q][c].y), bf_hi(hw[q][c].y)} * (F8_MOE ? r[q] * F8_SX : r[q]);
                    if constexpr (F8_MOE) { const unsigned w = pk_fp8x4(v[0], v[1], v[2], v[3]);
                        *(unsigned*)(XS + (size_t)s0[q] * D + 4 * lane + 256 * c) = w; *(unsigned*)(XS + (size_t)s1[q] * D + 4 * lane + 256 * c) = w; }
                    else { u32x2 w; w.x = cvt_pk_bf16(v[0], v[1]); w.y = cvt_pk_bf16(v[2], v[3]);
                        *(u32x2*)((bf16_t*)XS + (size_t)s0[q] * D + 4 * lane + 256 * c) = w; *(u32x2*)((bf16_t*)XS + (size_t)s1[q] * D + 4 * lane + 256 * c) = w; } } }
        __syncthreads();
    }
}
DI void moe_combine_final(const Frame& F, KPtr kp) {
    unsigned char* ws = kp->ws;
    const f32x2* tokG = (const f32x2*)(ws + WS_TOK + 65536); const int* slot = (const int*)(ws + WS_TOK + 4 * 65536);
    const bf16_t* YS = (const bf16_t*)(ws + WS_R2 + R2_YS); const bf16_t* HBp = (const bf16_t*)(ws + WS_HB); const int lane = F.lane;
    const pg8::MoeTail tp = pg8::moe_tail_plan((const unsigned*)(ws + WS_CTL) + CW_MOE, F.G); const int tail0 = tp.nb_main * 256; const size_t tslab = (size_t)(tp.nused - tp.nb_main) * 256 * D;
    const bf16_t* YP = (const bf16_t*)(ws + WS_R2 + R2_YP);
    for (int row0 = (F.bid * NWAVES + F.wave) * 2; row0 < T; row0 += F.G * NWAVES * 2) {
        int s0[2], s1[2]; f32x2 g[2]; u32x2 hw[2][8], ya[2][8], yb[2][8];
#pragma unroll
        for (int q = 0; q < 2; ++q) { s0[q] = slot[(row0 + q) * 2]; s1[q] = slot[(row0 + q) * 2 + 1]; g[q] = tokG[row0 + q]; }
#pragma unroll
        for (int q = 0; q < 2; ++q)
#pragma unroll
            for (int j = 0; j < 8; ++j) { const int c = 4 * lane + 256 * j; hw[q][j] = *(const u32x2*)(HBp + (size_t)(row0 + q) * D + c);
                ya[q][j] = *(const u32x2*)(YS + (size_t)s0[q] * D + c); yb[q][j] = *(const u32x2*)(YS + (size_t)s1[q] * D + c); }
        if (tp.f > 1) {
#pragma unroll
            for (int q = 0; q < 2; ++q)
#pragma unroll
                for (int w = 0; w < 2; ++w) { const int sl = w ? s1[q] : s0[q]; if (sl < tail0) continue;
                    for (int k = 1; k < tp.f; ++k) { const bf16_t* pr = YP + (size_t)(k - 1) * tslab + (size_t)(sl - tail0) * D; u32x2 pv[8];
#pragma unroll
                        for (int j = 0; j < 8; ++j) pv[j] = *(const u32x2*)(pr + 4 * lane + 256 * j);
#pragma unroll
                        for (int j = 0; j < 8; ++j) { u32x2& y = w ? yb[q][j] : ya[q][j];
                            y.x = cvt_pk_bf16(bf_lo(y.x) + bf_lo(pv[j].x), bf_hi(y.x) + bf_hi(pv[j].x)); y.y = cvt_pk_bf16(bf_lo(y.y) + bf_lo(pv[j].y), bf_hi(y.y) + bf_hi(pv[j].y)); } } }
        }
#pragma unroll
        for (int q = 0; q < 2; ++q) { f32x4 v[8]; float ss = 0.f;
#pragma unroll
            for (int j = 0; j < 8; ++j) { const u32x2 h = hw[q][j], a = ya[q][j], b = yb[q][j]; f32x4 o;
                o[0] = bf_lo(h.x) + (g[q].x * bf_lo(a.x) + g[q].y * bf_lo(b.x)); o[1] = bf_hi(h.x) + (g[q].x * bf_hi(a.x) + g[q].y * bf_hi(b.x));
                o[2] = bf_lo(h.y) + (g[q].x * bf_lo(a.y) + g[q].y * bf_lo(b.y)); o[3] = bf_hi(h.y) + (g[q].x * bf_hi(a.y) + g[q].y * bf_hi(b.y));
                v[j] = o; ss += (o[0] * o[0] + o[1] * o[1]) + (o[2] * o[2] + o[3] * o[3]); }
            ss = wave_sum(ss); const float r = __builtin_amdgcn_rsqf(ss * (1.0f / D) + EPS);
#pragma unroll
            for (int j = 0; j < 8; ++j) { const int c = 4 * lane + 256 * j; __builtin_nontemporal_store(v[j] * r * *(const f32x4*)(kp->g_final + c), (f32x4*)(kp->out + (size_t)(row0 + q) * D + c)); } }
    }
}
namespace att {
constexpr int SHM_V = 16384, NW_ATT = 8;
DI int v_st(int k, int c) { const int kk = (k & ~0xC) | ((k & 4) << 1) | ((k & 8) >> 1); return ((kk >> 3) * 4 + (c >> 5)) * 512 + ((kk & 7) * 32 + (c & 31)) * 2; }
DI int v_rd_base(int lane) { return ((lane & 3) << 3) | (((lane >> 2) & 3) << 6) | (((lane >> 4) & 1) << 5) | (((lane >> 5) & 1) << 8); }
struct Src { const bf16_t* q; const bf16_t* k; const bf16_t* k2; const bf16_t* v; bf16_t* o; int ldq, ldk, ldv; };
DI float swap_max(float x) { auto rr = __builtin_amdgcn_permlane32_swap(__float_as_uint(x), __float_as_uint(x), false, false); return fmaxf(__uint_as_float(rr[0]), __uint_as_float(rr[1])); }
DI float swap_sum(float x) { auto rr = __builtin_amdgcn_permlane32_swap(__float_as_uint(x), __float_as_uint(x), false, false); return __uint_as_float(rr[0]) + __uint_as_float(rr[1]); }
#define ATT_PK4(P, B_, OUT) do { unsigned a0 = cvt_pk_bf16(P[B_+0], P[B_+1]), a1 = cvt_pk_bf16(P[B_+2], P[B_+3]);                          \
        unsigned b0 = cvt_pk_bf16(P[B_+4], P[B_+5]), b1 = cvt_pk_bf16(P[B_+6], P[B_+7]);                                             \
        auto r0 = __builtin_amdgcn_permlane32_swap(a0, b0, false, false); auto r1 = __builtin_amdgcn_permlane32_swap(a1, b1, false, false); \
        u32x4 w = {r0[0], r1[0], r0[1], r1[1]}; OUT = __builtin_bit_cast(bf16x8, w); } while (0)

template <int KIND, int DK, int DBG = 0>
DI void tile_compute(const unsigned kaddr  , const int (&kx)[4], const unsigned vaddr  ,
                     const bf16x8 (&qr)[DK / 16], f32x16 (&o)[4], float& m_reg, float& l_reg, float& R, const int dq, const bool bmask, const bool blk_ok, const int hi) {
    constexpr int ND = DK / 16, KROW = DK * 2;
    f32x16 p0, p1;
    const bool mvalid = m_reg > -1e29f; const float base = mvalid ? m_reg : 0.f;
    const float pinit = (KIND == 2) ? 0.f : ((KIND == 1 && !blk_ok) ? -__builtin_inff() : -base);
#pragma unroll
    for (int r = 0; r < 16; ++r) { p0[r] = pinit; p1[r] = pinit; }
    constexpr int KG = ND > 8 ? 4 : ND;
    if constexpr (DBG & 1) { p0[0] = __int_as_float(kaddr & 3); }
    else
#pragma unroll
    for (int g0 = 0; g0 < ND; g0 += KG) {
        bf16x8 kf[KG][2];
#pragma unroll
        for (int d = 0; d < KG; ++d) { const int d0 = g0 + d; const LAS unsigned char* a = (const LAS unsigned char*)(size_t)(kaddr + kx[d0 & 3] + (d0 >> 2) * 128);
            if constexpr (DBG & 16) { kf[d][0] = qr[d0]; kf[d][1] = qr[(d0 + 1) % ND]; (void)a; } else { kf[d][0] = *(const LAS bf16x8*)a; kf[d][1] = *(const LAS bf16x8*)(a + 32 * KROW); } }
        __builtin_amdgcn_sched_barrier(0);
#pragma unroll
        for (int d = 0; d < KG; ++d) { p0 = __builtin_amdgcn_mfma_f32_32x32x16_bf16(kf[d][0], qr[g0 + d], p0, 0, 0, 0); p1 = __builtin_amdgcn_mfma_f32_32x32x16_bf16(kf[d][1], qr[g0 + d], p1, 0, 0, 0); }
    }
    const float NEG = -__builtin_inff();
    if constexpr (DBG & 2) { (void)NEG; }
    else if constexpr (KIND != 2) {
        if (bmask) {
#pragma unroll
            for (int r = 0; r < 16; ++r) { const int c = (r & 3) + 8 * (r >> 2); if (c > dq) p0[r] = NEG; if (c + 32 > dq) p1[r] = NEG; }
        }
        float pmax = p0[0];
#pragma unroll
        for (int r = 1; r < 16; ++r) pmax = fmaxf(pmax, p0[r]);
#pragma unroll
        for (int r = 0; r < 16; ++r) pmax = fmaxf(pmax, p1[r]);
        pmax = swap_max(pmax);
        float alpha = 1.0f, ps = 0.f;
        if (__all(mvalid && pmax <= 8.0f)) {
#pragma unroll
            for (int r = 0; r < 16; ++r) { p0[r] = fast_exp2(p0[r]); ps += p0[r]; }
#pragma unroll
            for (int r = 0; r < 16; ++r) { p1[r] = fast_exp2(p1[r]); ps += p1[r]; }
        } else {
            const float mnew = fmaxf(m_reg, base + pmax), delta = mnew - base;
            alpha = fast_exp2(m_reg - mnew); m_reg = mnew;
#pragma unroll
            for (int r = 0; r < 16; ++r) { p0[r] = fast_exp2(p0[r] - delta); ps += p0[r]; }
#pragma unroll
            for (int r = 0; r < 16; ++r) { p1[r] = fast_exp2(p1[r] - delta); ps += p1[r]; }
        }
        ps = swap_sum(ps);
        l_reg = l_reg * alpha + ps;
        if (__any(alpha < 1.0f)) {
#pragma unroll
            for (int d = 0; d < 4; ++d)
#pragma unroll
                for (int r = 0; r < 16; ++r) o[d][r] *= alpha;
        }
    } else {
        float y0[16], y1[16];
#pragma unroll
        for (int r = 0; r < 16; ++r) { const int c = (r & 3) + 8 * (r >> 2);
            const float ua = fast_exp2(fminf(p0[r], 100.f)), ub = fast_exp2(fminf(p1[r], 100.f));
            float ra = fast_rcp(1.0f + ua), rb = fast_rcp(1.0f + ub), ba = ua * ra, bb = ub * rb;
            if (bmask) { if (!(c < dq)) { ra = 1.f; ba = 0.f; } if (!(c + 32 < dq)) { rb = 1.f; bb = 0.f; } }
            y0[r] = ra; y1[r] = rb; p0[r] = ba; p1[r] = bb; }
        float pair[8], gpl[8];
#pragma unroll
        for (int k = 0; k < 8; ++k) { const float g = k < 4 ? (y0[4 * k] * y0[4 * k + 1]) * (y0[4 * k + 2] * y0[4 * k + 3]) : (y1[4 * (k - 4)] * y1[4 * (k - 4) + 1]) * (y1[4 * (k - 4) + 2] * y1[4 * (k - 4) + 3]);
            auto rr = __builtin_amdgcn_permlane32_swap(__float_as_uint(g), __float_as_uint(g), false, false);
            const float glo = __uint_as_float(rr[0]), ghi = __uint_as_float(rr[1]);
            pair[k] = glo * ghi; gpl[k] = hi ? 1.0f : ghi; }
        float off[8]; { float e = R;
#pragma unroll
            for (int k = 7; k >= 0; --k) { off[k] = e * gpl[k]; e *= pair[k]; }
            R = e; }
#pragma unroll
        for (int j = 0; j < 4; ++j) {
            { const float e3 = off[j], e2 = y0[4 * j + 3] * e3, e1 = y0[4 * j + 2] * e2, e0 = y0[4 * j + 1] * e1;
              p0[4 * j + 3] *= e3; p0[4 * j + 2] *= e2; p0[4 * j + 1] *= e1; p0[4 * j] *= e0; }
            { const float e3 = off[4 + j], e2 = y1[4 * j + 3] * e3, e1 = y1[4 * j + 2] * e2, e0 = y1[4 * j + 1] * e1;
              p1[4 * j + 3] *= e3; p1[4 * j + 2] *= e2; p1[4 * j + 1] *= e1; p1[4 * j] *= e0; } }
    }
    bf16x8 pa0, pa1, pa2, pa3;
    ATT_PK4(p0, 0, pa0); ATT_PK4(p0, 8, pa1); ATT_PK4(p1, 0, pa2); ATT_PK4(p1, 8, pa3);
#define ATT_TRRD(dst, off) asm volatile("ds_read_b64_tr_b16 %0, %1 offset:%2" : "=&v"(dst) : "v"(vaddr), "i"(off) : "memory")
#define ATT_VRD(V, d0) do { if constexpr (DBG & 32) { _Pragma("unroll") for (int q_ = 0; q_ < 8; ++q_) V[q_] = (s16x4){pa0[q_ & 7], pa1[q_ & 7], pa2[q_ & 7], pa3[q_ & 7]}; break; } constexpr int b_ = (d0) * 512; ATT_TRRD(V[0], b_); ATT_TRRD(V[1], b_ + 2048); ATT_TRRD(V[2], b_ + 4096); ATT_TRRD(V[3], b_ + 6144); ATT_TRRD(V[4], b_ + 8192); ATT_TRRD(V[5], b_ + 10240); ATT_TRRD(V[6], b_ + 12288); ATT_TRRD(V[7], b_ + 14336); } while (0)
#define ATT_VF(V, k) ((bf16x8){V[2 * (k)][0], V[2 * (k)][1], V[2 * (k)][2], V[2 * (k)][3], V[2 * (k) + 1][0], V[2 * (k) + 1][1], V[2 * (k) + 1][2], V[2 * (k) + 1][3]})
#define ATT_PVM(V, d0) do { o[d0] = __builtin_amdgcn_mfma_f32_32x32x16_bf16(ATT_VF(V, 0), pa0, o[d0], 0, 0, 0); o[d0] = __builtin_amdgcn_mfma_f32_32x32x16_bf16(ATT_VF(V, 1), pa1, o[d0], 0, 0, 0); \
        o[d0] = __builtin_amdgcn_mfma_f32_32x32x16_bf16(ATT_VF(V, 2), pa2, o[d0], 0, 0, 0); o[d0] = __builtin_amdgcn_mfma_f32_32x32x16_bf16(ATT_VF(V, 3), pa3, o[d0], 0, 0, 0); } while (0)
#define ATT_LW(n) do { asm volatile("s_waitcnt lgkmcnt(" #n ")" ::: "memory"); __builtin_amdgcn_sched_barrier(0); } while (0)
    if constexpr (DBG & 4) { o[0][0] += __builtin_bit_cast(f32x4, __builtin_bit_cast(u32x4, pa0) ^ __builtin_bit_cast(u32x4, pa1) ^ __builtin_bit_cast(u32x4, pa2) ^ __builtin_bit_cast(u32x4, pa3))[0]; }
    else { s16x4 va[8], vb[8];
      __builtin_amdgcn_sched_barrier(0);
      ATT_VRD(va, 0); ATT_VRD(vb, 1);
      ATT_LW(8); ATT_PVM(va, 0); __builtin_amdgcn_sched_barrier(0);
      ATT_VRD(va, 2);
      ATT_LW(8); ATT_PVM(vb, 1); __builtin_amdgcn_sched_barrier(0);
      ATT_VRD(vb, 3);
      ATT_LW(8); ATT_PVM(va, 2); __builtin_amdgcn_sched_barrier(0);
      ATT_LW(0); ATT_PVM(vb, 3); }
#undef ATT_LW
#undef ATT_PVM
#undef ATT_VF
#undef ATT_VRD
#undef ATT_TRRD
}

template <int KIND, int DBG = 0>
DI void attn_unit(LAS unsigned char* lds, const int tid_in, const Src& s, const int qb, const float* ksum_bh) {
    constexpr int DK = KIND == 0 ? 192 : 128, ND = DK / 16, KROW = DK * 2, SHM_K = 64 * KROW, NKC = DK / 8, NST = 64 * NKC / 512;
    int tid_ = tid_in; asm volatile("" : "+v"(tid_));
    const int tid = tid_, wid = __builtin_amdgcn_readfirstlane(tid >> 6), lane = tid & 63, r32 = lane & 31, hi = lane >> 5;
    const int P0 = qb * 256, qlo = P0 + wid * 32, qpos = qlo + r32, NT = 4 * (qb + 1);
    bf16x8 qr[ND];
#pragma unroll
    for (int d0 = 0; d0 < ND; ++d0) qr[d0] = *(const bf16x8*)(s.q + (size_t)qpos * s.ldq + d0 * 16 + hi * 8);
    unsigned allowed = 0xffffffffu;
    LAS float* ksl = (LAS float*)(lds + 98304);
    f32x4 ksv = {0.f, 0.f, 0.f, 0.f};
    if constexpr (KIND == 1) { if (tid < qb * 32) ksv = *(const f32x4*)(ksum_bh + (size_t)(tid >> 5) * 640 + (tid & 31) * 4); }
    f32x16 o[4];
#pragma unroll
    for (int d = 0; d < 4; ++d)
#pragma unroll
        for (int r = 0; r < 16; ++r) o[d][r] = 0.f;
    float m_reg = -1e30f, l_reg = 0.f, R = (KIND == 2) ? 1.0f : 0.f;
    LAS unsigned char* Vl = lds; LAS unsigned char* Kl = lds + 3 * SHM_V;
    const bf16_t* ksrc[NST]; int kstr[NST];
#pragma unroll
    for (int i = 0; i < NST; ++i) { const int ci = tid + 512 * i, row = ci / NKC, ccp = ci - row * NKC, cc = ccp ^ (row & 7);
        if (KIND == 0 && cc >= 16) { ksrc[i] = s.k2 + (size_t)row * 64 + (cc - 16) * 8; kstr[i] = 64; } else { ksrc[i] = s.k + (size_t)row * s.ldk + cc * 8; kstr[i] = s.ldk; } }
    unsigned vsrc[2];
#pragma unroll
    for (int i = 0; i < 2; ++i) { const int j = tid + 512 * i, st = j >> 5, sl = j & 31, kk = (st >> 2) * 8 + (sl >> 2), c = (st & 3) * 32 + 8 * (sl & 3);
        const int k = (kk & ~0xC) | ((kk & 4) << 1) | ((kk & 8) >> 1); vsrc[i] = (unsigned)((k * s.ldv + c) * 2); }
    const unsigned vbase = (unsigned)(unsigned long long)Vl + (unsigned)v_rd_base(lane);
    const unsigned kbase = (unsigned)(unsigned long long)Kl + (unsigned)(r32 * KROW);
    int kx[4];
#pragma unroll
    for (int dd = 0; dd < 4; ++dd) kx[dd] = (dd * 32 + hi * 16) ^ ((r32 & 7) << 4);
    constexpr int NDMA = NST + 2;
#define ATT_DMA(t, slot) do { const int kb_ = (t) * 64; const char* vb_ = (const char*)(s.v + (size_t)kb_ * s.ldv); \
        _Pragma("unroll") for (int i_ = 0; i_ < 2; ++i_) __builtin_amdgcn_global_load_lds((const unsigned*)(vb_ + vsrc[i_]), (LAS unsigned*)(Vl + (slot) * SHM_V + (wid * 64 + 512 * i_) * 16), 16, 0, 0); \
        _Pragma("unroll") for (int i_ = 0; i_ < NST; ++i_) __builtin_amdgcn_global_load_lds((const unsigned*)(ksrc[i_] + (size_t)kb_ * kstr[i_]), (LAS unsigned*)(Kl + (slot) * SHM_K + (wid * 64 + 512 * i_) * 16), 16, 0, 0); } while (0)
#define ATT_TILE(i_) ((KIND == 2) ? (NT - 1 - (i_)) : (i_))
#define ATT_WAITV(n) asm volatile("s_waitcnt vmcnt(%0)" :: "i"(n) : "memory")
#define ATT_BARRIER() do { asm volatile("s_waitcnt lgkmcnt(0)" ::: "memory"); __builtin_amdgcn_s_barrier(); asm volatile("" ::: "memory"); } while (0)
    volatile LAS int* wdone_cnt = (volatile LAS int*)(lds + LDS_MISC) + 5;
    bool wdone = false;
    if (KIND == 2 && tid == 0) *wdone_cnt = 0;
    ATT_DMA(ATT_TILE(0), 0); ATT_DMA(ATT_TILE(1), 1);
    if constexpr (KIND == 1) {
        if (tid < qb * 32) *(LAS f32x4*)(ksl + tid * 4) = ksv;
        ATT_BARRIER();
        allowed = 1u << qb;
        float v0 = -__builtin_inff(), v1 = v0, v2 = v0; int i0 = -1, i1 = -1, i2 = -1;
        for (int n = 0; n < qb; ++n) {
            const LAS float* kp = ksl + n * 128 + hi * 8; float g = 0.f;
#pragma unroll
            for (int d0 = 0; d0 < 8; ++d0) { const f32x4 k0 = *(const LAS f32x4*)(kp + d0 * 16), k1 = *(const LAS f32x4*)(kp + d0 * 16 + 4); const u32x4 qw = __builtin_bit_cast(u32x4, qr[d0]);
                g += bf_lo(qw[0]) * k0[0] + bf_hi(qw[0]) * k0[1] + bf_lo(qw[1]) * k0[2] + bf_hi(qw[1]) * k0[3] + bf_lo(qw[2]) * k1[0] + bf_hi(qw[2]) * k1[1] + bf_lo(qw[3]) * k1[2] + bf_hi(qw[3]) * k1[3]; }
            g = swap_sum(g);
            if (g > v0) { v2 = v1; i2 = i1; v1 = v0; i1 = i0; v0 = g; i0 = n; } else if (g > v1) { v2 = v1; i2 = i1; v1 = g; i1 = n; } else if (g > v2) { v2 = g; i2 = n; }
        }
        if (i0 >= 0) allowed |= 1u << i0; if (i1 >= 0) allowed |= 1u << i1; if (i2 >= 0) allowed |= 1u << i2;
    }
    ATT_WAITV(NDMA); ATT_BARRIER();
    int slot = 0;
    for (int i = 0; i < NT; ++i) {
        const int t_ = ATT_TILE(i), kb_ = t_ * 64; const int s2 = slot == 0 ? 2 : slot - 1;
        const bool more = !(DBG & 8) && (i + 2 < NT);
        if (more) ATT_DMA(ATT_TILE(i + 2), s2);
        if (kb_ <= qlo + 31 && !wdone) { const bool bm_ = (KIND == 2) ? (kb_ + 63 >= qlo) : (kb_ + 63 > qlo);
            tile_compute<KIND, DK, DBG>(kbase + slot * SHM_K, kx, vbase + slot * SHM_V, qr, o, m_reg, l_reg, R, qpos - kb_ - 4 * hi, bm_, ((allowed >> (kb_ >> 8)) & 1u) != 0u, hi);
            if (KIND == 2 && !(DBG & 64) && __all(R == 0.0f)) { wdone = true; if (lane == 0) __hip_atomic_fetch_add((LAS int*)wdone_cnt, 1, __ATOMIC_RELAXED, __HIP_MEMORY_SCOPE_WORKGROUP); } }
        if (more) ATT_WAITV(NDMA); else ATT_WAITV(0);
        ATT_BARRIER();
        slot = slot == 2 ? 0 : slot + 1;
        if (KIND == 2) {
            const int c_ = __builtin_amdgcn_readfirstlane(*wdone_cnt); ATT_BARRIER();
            if (c_ == NW_ATT) { ATT_WAITV(0); ATT_BARRIER(); break; } }
    }
#undef ATT_BARRIER
#undef ATT_WAITV
#undef ATT_TILE
#undef ATT_DMA
    const float inv = (KIND == 2) ? 1.0f : 1.0f / l_reg;
    if constexpr (F8_DUP && KIND != 2) {
        unsigned char* ob = (unsigned char*)s.o + (size_t)qpos * (2 * D) + 8 * hi; const float i8 = inv * F8_SO;
#pragma unroll
        for (int d0 = 0; d0 < 4; ++d0)
#pragma unroll
            for (int g = 0; g < 4; g += 2) {
                const unsigned a = pk_fp8x4(o[d0][4 * g] * i8, o[d0][4 * g + 1] * i8, o[d0][4 * g + 2] * i8, o[d0][4 * g + 3] * i8), b = pk_fp8x4(o[d0][4 * g + 4] * i8, o[d0][4 * g + 5] * i8, o[d0][4 * g + 6] * i8, o[d0][4 * g + 7] * i8);
                auto r = __builtin_amdgcn_permlane32_swap(a, b, false, false);
                *(u32x2*)(ob + 32 * d0 + 8 * g) = (u32x2){r[0], r[1]}; }
        return; }
    bf16_t* orow = s.o + (size_t)qpos * D + 8 * hi;
#pragma unroll
    for (int d0 = 0; d0 < 4; ++d0)
#pragma unroll
        for (int g = 0; g < 4; g += 2) {
            const unsigned a0 = cvt_pk_bf16(o[d0][4 * g] * inv, o[d0][4 * g + 1] * inv), a1 = cvt_pk_bf16(o[d0][4 * g + 2] * inv, o[d0][4 * g + 3] * inv);
            const unsigned b0 = cvt_pk_bf16(o[d0][4 * g + 4] * inv, o[d0][4 * g + 5] * inv), b1 = cvt_pk_bf16(o[d0][4 * g + 6] * inv, o[d0][4 * g + 7] * inv);
            auto r0 = __builtin_amdgcn_permlane32_swap(a0, b0, false, false); auto r1 = __builtin_amdgcn_permlane32_swap(a1, b1, false, false);
            const u32x4 w = {r0[0], r1[0], r0[1], r1[1]};
            *(u32x4*)(orow + 32 * d0 + 8 * g) = w; }
}
}

namespace pg8 {
struct SchedMemKV {
    const char* MEMN; const char* WXK; const char* WXV; int G, c, eb;
    DI bool next(int i, Unit& u) const {
        const long L = (long)i * G + c; if (L >= 128) return false;
        const int ll = (int)L >> 6, kind = ((int)L >> 5) & 1, r = (int)L & 31; u.aux = ll * 2 + kind; u.nt = 16 * eb;
        u.pm = r >> 3; u.pn = r & 7; u.a = MEMN + (size_t)ll * 1024 * D * eb + (size_t)u.pm * 256 * D * eb; u.b = (kind ? WXV : WXK) + (size_t)ll * SZ_SQ + (size_t)u.pn * 256 * D * eb;
        return true;
    }
};
struct SchedXPre {
    const char* KMEM; const char* VMEM; const char* WXQN; const char* WXO; int G, c, eb;
    DI bool next(int i, Unit& u) const {
        const long L = (long)i * G + c; if (L >= 512) return false;
        const int kind = (int)L >> 8, r = (int)L & 255, ll = r >> 7, bh = (r >> 3) & 15, b = bh >> 2, h = bh & 3, p = r & 7; u.aux = kind; u.nt = 4 * eb;
        const size_t mem = ((size_t)(ll * 1024 + b * 256) * D + h * 512) * eb, wgt = (size_t)ll * SZ_SQ + ((size_t)p * 256 * D + h * 512) * eb;
        if (kind == 0) { u.a = KMEM + mem; u.b = WXQN + wgt; u.pm = (ll * 4 + b) * 4 + h; u.pn = p; }
        else { u.a = WXO + wgt; u.b = VMEM + mem; u.pm = (ll * 4 + b) * 8 + p; u.pn = h; }
        return true;
    }
};
struct SchedXS2 {
    const char* HBp; const char* MT; int l, G, c, eb;
    DI bool next(int i, Unit& u) const {
        const long L = (long)i * G + c; if (L >= 256) return false;
        const int hd = (int)L & 3, rt = (int)L >> 2; u.pm = rt; u.pn = hd; u.aux = 0; u.nt = 16 * eb;
        u.a = HBp + (size_t)rt * 256 * D * eb; u.b = MT + ((size_t)((l * 4 + (rt >> 4)) * 1024 + hd * 256) * D) * eb; return true;
    }
};
struct SchedXO {
    const char* PX; const char* NT; int l, G, c, eb;
    DI bool next(int i, Unit& u) const {
        const long L = (long)i * G + c; if (L >= 512) return false;
        tile_order((int)L, 64, 8, u.pm, u.pn); u.aux = 0; u.nt = 8 * eb;
        u.a = PX + (size_t)u.pm * 256 * 1024 * eb; u.b = NT + ((size_t)((l * 4 + (u.pm >> 4)) * 2048 + u.pn * 256) * 1024) * eb; return true;
    }
};
}
namespace epi {
struct EpiTwo {
    bf16_t* O0; bf16_t* O1; int ld0, ld1; size_t slab; float sc0 = 0.f, sc1 = 0.f;
    static constexpr bool BAR_INSIDE = false;
    DI const stat_t* stat_src() const { return nullptr; }
    DI bool operator()(Acc& acc, const Unit& u, int wr, int wc, int fr, int fq) const {
        asm volatile("" : "+v"(fr), "+v"(fq));
        const int kind = u.aux & 1; const int ldo = kind ? ld1 : ld0; const float sc = kind ? sc1 : sc0;
        const int row0 = u.pm * 256 + wr * 64 + fr;
        if (sc > 0.f) { unsigned char* O = (unsigned char*)(kind ? O1 : O0) + (size_t)(u.aux >> 1) * slab;
#pragma unroll
            for (int ai = 0; ai < 2; ++ai)
#pragma unroll
                for (int m = 0; m < 4; ++m) { const int row = row0 + ai * 128 + m * 16;
#pragma unroll
                    for (int bj = 0; bj < 2; ++bj)
                        *(u32x2*)(O + (size_t)row * ldo + u.pn * 256 + bj * 128 + wc * 32 + 8 * fq) = pack8_fp8(acc[ai][bj][m][0] * sc, acc[ai][bj][m][1] * sc); }
            return false; }
        bf16_t* O = (kind ? O1 : O0) + (size_t)(u.aux >> 1) * slab;
#pragma unroll
        for (int ai = 0; ai < 2; ++ai)
#pragma unroll
            for (int m = 0; m < 4; ++m) { const int row = row0 + ai * 128 + m * 16;
#pragma unroll
                for (int bj = 0; bj < 2; ++bj)
                    *(u32x4*)(O + (size_t)row * ldo + u.pn * 256 + bj * 128 + wc * 32 + 8 * fq) = pack8(acc[ai][bj][m][0], acc[ai][bj][m][1]); }
        return false;
    }
};
}

#ifndef ATT_DBG
#define ATT_DBG 0
#endif
template <int DBG = 0>
DI void attn_phase(const Frame& F, KPtr kp, const int l, const int qoff = 0, const int kmask = 7) {
    unsigned char* ws = kp->ws; unsigned* ctl = (unsigned*)(ws + WS_CTL);
    volatile LAS int* misc = (volatile LAS int*)(F.lds + LDS_MISC);
    const bf16_t* QA = (const bf16_t*)(ws + WS_R2 + R2_QA); const bf16_t* KVA = (const bf16_t*)(ws + WS_R2 + R2_KVA); const bf16_t* KPE = (const bf16_t*)(ws + WS_R1 + R1_KPE);
    const bf16_t* MQK = (const bf16_t*)(ws + WS_R1 + R1_MQK); const bf16_t* PL = (const bf16_t*)(ws + WS_R1 + R1_PL); bf16_t* OCAT = qoff ? (bf16_t*)(ws + WS_R1 + 352 * MiB) : (bf16_t*)(ws + WS_R2 + R2_OCAT);
    const float* ksum = (const float*)(ws + WS_CTL) + CW_KSUM + l * KSUM_L;
#define ATT_U0 att::attn_unit<0, DBG>
#define ATT_U1 att::attn_unit<1, DBG>
#define ATT_U2 att::attn_unit<2, DBG>
#define ATT_QUEUE_LOOP(KIND, NH, BODY) for (;;) { if (F.tid == 0) misc[4] = (int)__hip_atomic_fetch_add(ctl + CW_QUEUE + (qoff * 6 + l * 3 + (KIND)) * 64, 1u, __ATOMIC_RELAXED, __HIP_MEMORY_SCOPE_AGENT); \
        __syncthreads(); const int it = __builtin_amdgcn_readfirstlane(misc[4]); __syncthreads(); if (it >= 16 * NB * (NH)) break; \
        const int qb = 15 - it / (NB * (NH)), r_ = it % (NB * (NH)), b = r_ / (NH), h = r_ % (NH); const size_t t0 = (size_t)b * SEQ; att::Src s; BODY }
#ifndef ATT_MASK
#define ATT_MASK 7
#endif
    if ((ATT_MASK & 4) && (kmask & 4)) ATT_QUEUE_LOOP(2, 5, { s.q = PL + t0 * 2560 + 640 + h * 128; s.k = PL + t0 * 2560 + 1280 + h * 128; s.k2 = nullptr; s.v = PL + t0 * 2560 + 1920 + h * 128; s.o = OCAT + t0 * D + 1408 + h * 128;
        s.ldq = 2560; s.ldk = 2560; s.ldv = 2560; ATT_U2(F.lds, F.tid, s, qb, nullptr); })
    if ((ATT_MASK & 1) && (kmask & 1)) ATT_QUEUE_LOOP(0, 6, { s.q = QA + t0 * 1152 + h * 192; s.k = KVA + t0 * 1536 + h * 256; s.k2 = KPE + t0 * 64; s.v = KVA + t0 * 1536 + h * 256 + 128; s.o = F8_DUP ? (bf16_t*)((unsigned char*)(OCAT + t0 * D) + h * 128) : OCAT + t0 * D + h * 128;
        s.ldq = 1152; s.ldk = 1536; s.ldv = 1536; ATT_U0(F.lds, F.tid, s, qb, nullptr); })
    if ((ATT_MASK & 2) && (kmask & 2)) ATT_QUEUE_LOOP(1, 5, { s.q = MQK + t0 * 1280 + h * 128; s.k = MQK + t0 * 1280 + (5 + h) * 128; s.k2 = nullptr; s.v = PL + t0 * 2560 + h * 128; s.o = F8_DUP ? (bf16_t*)((unsigned char*)(OCAT + t0 * D) + 768 + h * 128) : OCAT + t0 * D + 768 + h * 128;
        s.ldq = 1280; s.ldk = 1280; s.ldv = 2560; ATT_U1(F.lds, F.tid, s, qb, ksum + ((size_t)b * 16 * 5 + h) * 128); })
#undef ATT_QUEUE_LOOP
}

constexpr int NPH = 26;
__global__ void __launch_bounds__(NTHR, 2) fwd(Params P) {
    extern __shared__ __attribute__((aligned(16))) unsigned char lds_[];
    int wave_id_ = __builtin_amdgcn_readfirstlane(threadIdx.x >> 6); asm volatile("" : "+s"(wave_id_));
    volatile LAS unsigned* MISC = (volatile LAS unsigned*)((LAS unsigned char*)lds_ + LDS_MISC);
    if (threadIdx.x < 32) MISC[threadIdx.x] = 0u;
    __syncthreads();
#if N_LAUNCH_MODE == 1
    constexpr int lo = 0, hi = 26;
#else
    const int lo = P.ph_lo, hi = P.ph_hi;
#endif
    XcdBarrier bar; bar.bar = (unsigned*)(P.ws + WS_CTL) + CW_BAR; bar.x = 0; bar.st = nullptr;
    if (hi - lo > 1) bar = xcd_barrier_post((unsigned*)(P.ws + WS_CTL) + CW_BAR, MISC + 8);
#ifndef PH_ONLY
#define PH_ONLY -1
#endif
#ifndef DUPMASK
#define DUPMASK 0
#endif
#ifndef PH_MASK
#define PH_MASK 0xffffffffu
#endif
#define IN(k) ((PH_ONLY < 0 || PH_ONLY == (k)) && ((PH_MASK >> ((k) >= 12 ? (k) - 11 : (k))) & 1u) && lo <= (k) && (k) < hi)
#ifdef TPROBE_A
#define STAMP(k) do { if (blockIdx.x == 0 && threadIdx.x == 0) ((unsigned long long*)((unsigned*)(P.ws + WS_CTL) + CW_TS))[(k)] = __builtin_amdgcn_s_memrealtime(); } while (0)
#else
#define STAMP(k) do { } while (0)
#endif
#define T0_HERE (wave_id_ == 0 && lane_id_now() == 0)
#ifndef DUP_BAR
#define DUP_BAR 0
#endif
#define SEAM(k) do { if (IN(k) && IN((k) + 1)) { xcd_barrier(bar, T0_HERE); if (DUP_BAR) xcd_barrier(bar, T0_HERE); } STAMP((k) + 1); } while (0)
#define OPQ KP_HERE FRAME_HERE unsigned char* ws = kp->ws; float* out = kp->out; unsigned* ctl = (unsigned*)(ws + WS_CTL); float* ctlf = (float*)(ws + WS_CTL); bf16_t* HB = (bf16_t*)(ws + WS_HB); \
        const int G = F.G, bid = F.bid; (void)ctl; (void)ctlf; (void)HB; (void)out; (void)G; (void)bid; \
        stat_t* stq = (stat_t*)(ctl + CW_STAT); stat_t* st_mix = stq + (ST_MIX * 2 + l) * T; stat_t* st_cq = stq + (ST_CQ * 2 + l) * T; stat_t* st_ckv = stq + (ST_CKV * 2 + l) * T; \
        stat_t* st_x = stq + (ST_X * 2 + l) * T; stat_t* st_ffn = stq + (ST_FFN * 2 + l) * T; stat_t* stq_dummy = (stat_t*)(ctl + 600000); bf16_t* hdummy = (bf16_t*)(ws + WS_R1 + 352 * MiB); (void)stq_dummy; (void)hdummy; (void)st_mix; (void)st_cq; (void)st_ckv; (void)st_x; (void)st_ffn;

    STAMP(0);
    if (IN(0)) { KP_HERE FRAME_HERE prologue(F, kp); } SEAM(0);
#ifdef DUP_PROLOGUE
    if (IN(0)) { KP_HERE FRAME_HERE prologue(F, kp); } SEAM(0);
#endif

    for (int l = 0; l < 2; ++l) {
        const int base = l ? 12 : 1;
        for (int rep_ = 0; rep_ < (((DUPMASK >> 1) & 1) ? 2 : 1); ++rep_) {
        if (IN(base + 0)) {
#ifndef NO_MEMKV
            if (l == 0) { OPQ constexpr bool XP = F8_XPRE && F8_XATTN; constexpr int EB = XP ? 1 : 2;
                pg8::SchedMemKV S{(const char*)(ws + WS_MEMN), (const char*)(ws + WS_WXK), (const char*)(ws + WS_WXV), G, (bid + 128) % G, EB};
                epi::EpiTwo E{(bf16_t*)(ws + WS_KMEM), (bf16_t*)(ws + WS_VMEMT), 2048, 2048, (size_t)1024 * D, XP ? 1.0f / F8_SW : 0.f, XP ? 1.0f / F8_SW : 0.f};
                pg8::gemm_phase<epi::EpiTwo, pg8::SchedMemKV, false, XP>(F.lds, F.tid, D * EB, D * EB, S, E); }
#endif
            constexpr bool AMM = F8_AMM && F8_GATES;
            { OPQ constexpr int EB = AMM ? 1 : 2;
              pg8::SchedGrid S{(const char*)(AMM ? ws + WS_HB8 : (unsigned char*)HB), (const char*)(AMM ? ws + WS_WIN8X + l * SZ_WE13 : ws + WS_WIN + l * SZ_WIN), D * EB, D * EB, 64, 5, 16 * EB, G, bid, 0};
              if (rep_) { st_cq = stq_dummy; st_ckv = stq_dummy + T; }
              epi::EpiIn<3> E{st_mix, (bf16_t*)(ws + WS_R1 + R1_ZC), (bf16_t*)(ws + WS_R1 + R1_KPE), (bf16_t*)(ws + WS_R1 + R1_MQK), (bf16_t*)(ws + WS_R1 + R1_PL), (bf16_t*)(ws + WS_R1 + R1_G),
                         st_cq, st_ckv, ctlf + CW_KSUM + l * KSUM_L, (const f32x2*)(ws + WS_CS128), (const f32x2*)(ws + WS_CS64), AMM ? 1.0f / (F8_SA * F8_SW) : 1.0f};
              pg8::gemm_phase<epi::EpiIn<3>, pg8::SchedGrid, false, AMM>(F.lds, F.tid, D * EB, D * EB, S, E); }
            if (AMM) {
            { OPQ pg8::SchedGrid S{(const char*)(ws + WS_HB8), (const char*)(ws + WS_WIN8X + l * SZ_WE13), D, D, 64, A8_TILES - 5, 16, G, (bid + G - 64) % G, 5};
              float* ksum_ = rep_ ? (float*)(stq_dummy + 2 * T) : ctlf + CW_KSUM + l * KSUM_L;
              epi::EpiIn<12> E{st_mix, (bf16_t*)(ws + WS_R1 + R1_ZC), (bf16_t*)(ws + WS_R1 + R1_KPE), (bf16_t*)(ws + WS_R1 + R1_MQK), (bf16_t*)(ws + WS_R1 + R1_PL), (bf16_t*)(ws + WS_R1 + R1_G),
                         st_cq, st_ckv, ksum_, (const f32x2*)(ws + WS_CS128), (const f32x2*)(ws + WS_CS64), 1.0f / (F8_SA * F8_SW)};
              pg8::gemm_phase<epi::EpiIn<12>, pg8::SchedGrid, false, true>(F.lds, F.tid, D, D, S, E); }
            { OPQ pg8::SchedGrid S{(const char*)HB, (const char*)(ws + WS_WIN + l * SZ_WIN), 4096, 4096, 64, 20 - A8_TILES, 32, G, (A8_TILES == 12) ? bid : (bid + G - 64) % G, A8_TILES};
              epi::EpiIn<8> E{st_mix, (bf16_t*)(ws + WS_R1 + R1_ZC), (bf16_t*)(ws + WS_R1 + R1_KPE), (bf16_t*)(ws + WS_R1 + R1_MQK), (bf16_t*)(ws + WS_R1 + R1_PL), (bf16_t*)(ws + WS_R1 + R1_G),
                         st_cq, st_ckv, nullptr, (const f32x2*)(ws + WS_CS128), (const f32x2*)(ws + WS_CS64), 1.0f};
              pg8::gemm_phase<epi::EpiIn<8>, pg8::SchedGrid>(F.lds, F.tid, 4096, 4096, S, E); }
            { OPQ pg8::SchedGrid S{(const char*)(ws + WS_HB8), (const char*)(ws + WS_WING8 + (size_t)l * 6144 * D) - (size_t)20 * 256 * D, 2048, 2048, 64, 24, 16, G, bid, 20};
              epi::EpiIn<16> E{st_mix, (bf16_t*)(ws + WS_R1 + R1_ZC), (bf16_t*)(ws + WS_R1 + R1_KPE), (bf16_t*)(ws + WS_R1 + R1_MQK), (bf16_t*)(ws + WS_R1 + R1_PL), (bf16_t*)(ws + WS_R1 + R1_G),
                         st_cq, st_ckv, nullptr, (const f32x2*)(ws + WS_CS128), (const f32x2*)(ws + WS_CS64), 1.0f / (F8_SA * F8_SW)};
              pg8::gemm_phase<epi::EpiIn<16>, pg8::SchedGrid, false, true>(F.lds, F.tid, 2048, 2048, S, E); }
            } else if (F8_GATES) {
            { OPQ pg8::SchedGrid S{(const char*)HB, (const char*)(ws + WS_WIN + l * SZ_WIN), 4096, 4096, 64, 15, 32, G, (bid + G - 64) % G, 5};
              float* ksum_ = rep_ ? (float*)(stq_dummy + 2 * T) : ctlf + CW_KSUM + l * KSUM_L;
              epi::EpiIn<12> E{st_mix, (bf16_t*)(ws + WS_R1 + R1_ZC), (bf16_t*)(ws + WS_R1 + R1_KPE), (bf16_t*)(ws + WS_R1 + R1_MQK), (bf16_t*)(ws + WS_R1 + R1_PL), (bf16_t*)(ws + WS_R1 + R1_G),
                         st_cq, st_ckv, ksum_, (const f32x2*)(ws + WS_CS128), (const f32x2*)(ws + WS_CS64), 1.0f};
              pg8::gemm_phase<epi::EpiIn<12>, pg8::SchedGrid>(F.lds, F.tid, 4096, 4096, S, E); }
            { OPQ pg8::SchedGrid S{(const char*)(ws + WS_HB8), (const char*)(ws + WS_WING8 + (size_t)l * 6144 * D) - (size_t)20 * 256 * D, 2048, 2048, 64, 24, 16, G, bid, 20};
              epi::EpiIn<16> E{st_mix, (bf16_t*)(ws + WS_R1 + R1_ZC), (bf16_t*)(ws + WS_R1 + R1_KPE), (bf16_t*)(ws + WS_R1 + R1_MQK), (bf16_t*)(ws + WS_R1 + R1_PL), (bf16_t*)(ws + WS_R1 + R1_G),
                         st_cq, st_ckv, nullptr, (const f32x2*)(ws + WS_CS128), (const f32x2*)(ws + WS_CS64), 1.0f / (F8_SA * F8_SW)};
              pg8::gemm_phase<epi::EpiIn<16>, pg8::SchedGrid, false, true>(F.lds, F.tid, 2048, 2048, S, E); }
            } else {
            { OPQ pg8::SchedGrid S{(const char*)HB, (const char*)(ws + WS_WIN + l * SZ_WIN), 4096, 4096, 64, 39, 32, G, (bid + G - 64) % G, 5};
              float* ksum_ = rep_ ? (float*)(stq_dummy + 2 * T) : ctlf + CW_KSUM + l * KSUM_L;
              epi::EpiIn<28> E{st_mix, (bf16_t*)(ws + WS_R1 + R1_ZC), (bf16_t*)(ws + WS_R1 + R1_KPE), (bf16_t*)(ws + WS_R1 + R1_MQK), (bf16_t*)(ws + WS_R1 + R1_PL), (bf16_t*)(ws + WS_R1 + R1_G),
                         st_cq, st_ckv, ksum_, (const f32x2*)(ws + WS_CS128), (const f32x2*)(ws + WS_CS64), 1.0f};
              pg8::gemm_phase<epi::EpiIn<28>, pg8::SchedGrid>(F.lds, F.tid, 4096, 4096, S, E); }
            }
        }
        SEAM(base + 0);
        }
        for (int rep_ = 0; rep_ < (((DUPMASK >> 2) & 1) ? 2 : 1); ++rep_) {
        if (IN(base + 1)) {
            if (l == 0) { OPQ constexpr bool XP = F8_XPRE && F8_XATTN; constexpr int EB = XP ? 1 : 2;
                pg8::SchedXPre S{(const char*)(ws + WS_KMEM), (const char*)(ws + WS_VMEMT), (const char*)(ws + WS_WXQ), (const char*)(ws + WS_WXO), G, bid, EB};
                epi::EpiTwo E{(bf16_t*)(ws + WS_MT), (bf16_t*)(ws + WS_NT), 2048, 1024, 0, XP ? F8_SM / (F8_SX * F8_SWQ) : (F8_XATTN ? F8_SM : 0.f), XP ? F8_SN / (F8_SW * F8_SX) : (F8_XATTN ? F8_SN : 0.f)};
                pg8::gemm_phase<epi::EpiTwo, pg8::SchedXPre, false, XP>(F.lds, F.tid, D * EB, D * EB, S, E); }
            if (F8_DUP && !rep_) { OPQ
              unsigned z_ = 0u; asm volatile("" : "+v"(z_));
              for (int j = bid * NTHR + F.tid; j < T * 8; j += G * NTHR) *(u32x4*)(ws + WS_R2 + R2_OCAT + (size_t)(j >> 3) * (2 * D) + 1408 + 16 * (j & 7)) = (u32x4){z_, z_, z_, z_}; }
            { OPQ constexpr int EB = F8_B ? 1 : 2;
              pg8::SchedGrid S{(const char*)(ws + WS_R1 + R1_ZC), (const char*)(ws + WS_WUQ + l * SZ_WUQ), 1024 * EB, 512 * EB, 64, 5, 4 * EB, G, bid, 0};
              epi::EpiUQ E{(bf16_t*)(ws + WS_R2 + R2_QA), st_cq, (const f32x2*)(ws + WS_CS64), F8_B ? 1.0f / (F8_SZ * F8_SW) : 1.0f};
              pg8::gemm_phase<epi::EpiUQ, pg8::SchedGrid, false, F8_B>(F.lds, F.tid, 1024 * EB, 512 * EB, S, E); }
            { OPQ constexpr int EB = F8_B ? 1 : 2;
              pg8::SchedGrid S{(const char*)(ws + WS_R1 + R1_ZC) + 512 * EB, (const char*)(ws + WS_WUKV + l * SZ_WUKV), 1024 * EB, 512 * EB, 64, 6, 4 * EB, G, (bid + G - 64) % G, 0};
              epi::EpiPlain E{(bf16_t*)(ws + WS_R2 + R2_KVA), 1536, st_ckv, 1.0f / 512, F8_B ? 1.0f / (F8_SZ * F8_SW) : 1.0f};
              pg8::gemm_phase<epi::EpiPlain, pg8::SchedGrid, false, F8_B>(F.lds, F.tid, 1024 * EB, 512 * EB, S, E); }
        }
        SEAM(base + 1);
        }
        if (IN(base + 2)) { KP_HERE FRAME_HERE attn_phase(F, kp, l); }
        SEAM(base + 2);
#ifdef DUP_ATTN
        if (IN(base + 2)) { KP_HERE FRAME_HERE attn_phase<ATT_DBG>(F, kp, l, 1, DUP_ATTN); }
        SEAM(base + 2);
#endif
        for (int rep_ = 0; rep_ < (((DUPMASK >> 4) & 1) ? 2 : 1); ++rep_) {
        if (IN(base + 3)) {
            OPQ
            pg8::SchedUp S{(const char*)(ws + WS_R2 + R2_OCAT), (const char*)(ws + WS_WUP + l * SZ_SQ), G, bid};
            epi::EpiUp E{(const unsigned char*)(ws + WS_R1 + R1_G), (bf16_t*)(ws + WS_R2 + R2_MERGED)};
            pg8::gemm_phase<epi::EpiUp, pg8::SchedUp, false, false, false, F8_DUP>(F.lds, F.tid, 4096, 4096, S, E);
        }
        SEAM(base + 3);
        }
        for (int rep_ = 0; rep_ < (((DUPMASK >> 5) & 1) ? 2 : 1); ++rep_) {
        if (IN(base + 4)) {
            OPQ
            pg8::SchedGrid S{(const char*)(ws + WS_R2 + R2_MERGED), (const char*)(ws + WS_WO + l * SZ_SQ), 4096, 4096, 64, 8, 32, G, bid, 0};
            epi::EpiRes E{rep_ ? hdummy : HB, rep_ ? stq_dummy : st_x, (F8_XATTN && !rep_) ? ws + WS_HB8 : nullptr, 1.0f};
            pg8::gemm_phase<epi::EpiRes, pg8::SchedGrid>(F.lds, F.tid, 4096, 4096, S, E);
        }
        SEAM(base + 4);
        }
        for (int rep_ = 0; rep_ < (((DUPMASK >> 7) & 1) ? 2 : 1); ++rep_) {
        if (IN(base + 6)) {
            OPQ
            constexpr int EB = F8_XATTN ? 1 : 2;
            pg8::SchedXS2 S{(const char*)(F8_XATTN ? ws + WS_HB8 : (unsigned char*)HB), (const char*)(ws + WS_MT), l, G, bid, EB};
            epi::EpiXS E{(bf16_t*)(ws + WS_R2 + R2_PX), (LAS float*)(F.lds + LDS_EPI), st_x, F8_XATTN ? 1.0f / (F8_SA * F8_SM) : 1.0f, F8_XATTN ? F8_SP : 0.f};
            pg8::gemm_phase<epi::EpiXS, pg8::SchedXS2, true, F8_XATTN>(F.lds, F.tid, D * EB, D * EB, S, E);
        }
        SEAM(base + 6);
        }
        for (int rep_ = 0; rep_ < (((DUPMASK >> 9) & 1) ? 2 : 1); ++rep_) {
        if (IN(base + 8)) {
            OPQ
            constexpr int EB = F8_XATTN ? 1 : 2;
            pg8::SchedXO S{(const char*)(ws + WS_R2 + R2_PX), (const char*)(ws + WS_NT), l, G, bid, EB};
            epi::EpiRes E{rep_ ? hdummy : HB, rep_ ? stq_dummy : st_ffn, (l == 0 && F8_DENSE) ? ws + WS_HB8 : nullptr, F8_XATTN ? 1.0f / (F8_SP * F8_SN) : 1.0f};
            pg8::gemm_phase<epi::EpiRes, pg8::SchedXO, false, F8_XATTN>(F.lds, F.tid, 1024 * EB, 1024 * EB, S, E);
        }
        SEAM(base + 8);
        }
        if (l == 0) {
            for (int rep_ = 0; rep_ < (((DUPMASK >> 10) & 1) ? 2 : 1); ++rep_) {
        if (IN(10)) {
                OPQ
                constexpr int EB = F8_DENSE ? 1 : 2;
                pg8::SchedGrid S{(const char*)(F8_DENSE ? ws + WS_HB8 : (unsigned char*)HB), (const char*)(ws + WS_WFF13), D * EB, D * EB, 64, 44, 16 * EB, G, bid, 0};
                epi::EpiSwiglu<(F8_DENSE || F8_DDOWN)> E{ws + WS_R1 + R1_ACT, DFF, st_ffn, F8_DENSE ? 1.0f / (F8_SA * F8_SW) : 1.0f};
                pg8::gemm_phase<epi::EpiSwiglu<(F8_DENSE || F8_DDOWN)>, pg8::SchedGrid, false, F8_DENSE>(F.lds, F.tid, D * EB, D * EB, S, E);
            }
            SEAM(10);
        }
            for (int rep_ = 0; rep_ < (((DUPMASK >> 11) & 1) ? 2 : 1); ++rep_) {
        if (IN(11)) {
                OPQ
                constexpr bool F8K = F8_DENSE || F8_DDOWN; constexpr int EB = F8K ? 1 : 2;
                pg8::SchedGrid S{(const char*)(ws + WS_R1 + R1_ACT), (const char*)(ws + WS_WFF2), DFF * EB, DFF * EB, 64, 8, DFF * EB / 128, G, bid, 0};
                epi::EpiRes E{rep_ ? hdummy : HB, rep_ ? stq_dummy : stq + (ST_MIX * 2 + 1) * T, (F8_GATES && !rep_) ? ws + WS_HB8 : nullptr, F8K ? 1.0f / (F8_SA * F8_SW) : 1.0f};
                pg8::gemm_phase<epi::EpiRes, pg8::SchedGrid, false, F8K>(F.lds, F.tid, DFF * EB, DFF * EB, S, E);
            }
            SEAM(11);
        }
        } else {
            for (int rep_ = 0; rep_ < (((DUPMASK >> 21) & 1) ? 2 : 1); ++rep_) {
            if (IN(21)) { KP_HERE FRAME_HERE moe_router(F, kp, rep_); }
            SEAM(21); }
            if (IN(22)) { KP_HERE FRAME_HERE moe_assign_gather(F, kp); }
            SEAM(22);
            for (int rep_ = 0; rep_ < (((DUPMASK >> 12) & 1) ? 2 : 1); ++rep_) {
        if (IN(23)) {
                OPQ
                pg8::SchedMoE S; S.A = (const char*)(ws + WS_R2 + R2_XS); S.Bt = (const char*)(ws + WS_WE13); constexpr int EB = F8_MOE ? 1 : 2; S.lda = D * EB; S.nN = 56; S.nt = 16 * EB; S.G = G; S.c = bid; S.wstride = SZ_WE13; S.init_counts(ctl + CW_MOE);
                epi::EpiSwiglu<F8_MOE> E{ws + WS_R1 + R1_ACTE, DFE, nullptr, F8_MOE ? 1.0f / (F8_SX * F8_SW) : 1.0f};
                pg8::gemm_phase<epi::EpiSwiglu<F8_MOE>, pg8::SchedMoE, false, F8_MOE>(F.lds, F.tid, D * EB, D * EB, S, E);
            }
            SEAM(23);
        }
            for (int rep_ = 0; rep_ < (((DUPMASK >> 13) & 1) ? 2 : 1); ++rep_) {
        if (IN(24)) {
                OPQ
                constexpr int EB = F8_MOE ? 1 : 2;
                if constexpr (MOE_TAIL && F8_MOE) {
                pg8::SchedMoEDown S; S.A = (const char*)(ws + WS_R1 + R1_ACTE); S.Bt = (const char*)(ws + WS_WE2); S.lda = DFE; S.G = G; S.c = bid; S.wstride = SZ_WE2; S.init_counts(ctl + CW_MOE);
                epi::EpiMoeDown E{(bf16_t*)(ws + WS_R2 + R2_YS), (bf16_t*)(ws + WS_R2 + R2_YP), S.nb_main * 256, (size_t)(S.nused - S.nb_main) * 256 * D, 1.0f / (F8_SA * F8_SW)};
                pg8::gemm_phase<epi::EpiMoeDown, pg8::SchedMoEDown, false, true>(F.lds, F.tid, DFE, DFE, S, E);
                } else {
                pg8::SchedMoE S; S.A = (const char*)(ws + WS_R1 + R1_ACTE); S.Bt = (const char*)(ws + WS_WE2); S.lda = DFE * EB; S.nN = 8; S.nt = DFE * EB / 128; S.G = G; S.c = bid; S.wstride = SZ_WE2; S.init_counts(ctl + CW_MOE);
                epi::EpiPlain E{(bf16_t*)(ws + WS_R2 + R2_YS), 2048, nullptr, 0.f, F8_MOE ? 1.0f / (F8_SA * F8_SW) : 1.0f};
                pg8::gemm_phase<epi::EpiPlain, pg8::SchedMoE, false, F8_MOE>(F.lds, F.tid, DFE * EB, DFE * EB, S, E); }
            }
            SEAM(24);
        }
            for (int rep_ = 0; rep_ < (((DUPMASK >> 25) & 1) ? 2 : 1); ++rep_) { if (rep_) xcd_barrier(bar, T0_HERE);
            if (IN(25)) { KP_HERE FRAME_HERE moe_combine_final(F, kp); } }
        }
    }
#ifdef TPROBE_A
    xcd_barrier(bar, T0_HERE); STAMP(26);
    xcd_barrier(bar, T0_HERE);
    { const unsigned long long* ts = (const unsigned long long*)((unsigned*)(P.ws + WS_CTL) + CW_TS);
      unsigned long long ta = 0, tb = 0;
      for (int k = 0; k < 26; ++k) { const unsigned long long d = __hip_atomic_load(ts + k + 1, __ATOMIC_RELAXED, __HIP_MEMORY_SCOPE_AGENT) - __hip_atomic_load(ts + k, __ATOMIC_RELAXED, __HIP_MEMORY_SCOPE_AGENT);
          if ((TPROBE_A >> k) & 1) ta += d; if ((TPROBE_B >> k) & 1) tb += d; }
      const float k2 = (float)ta * 0.01f, k1 = (float)tb * 10.0f;
      for (size_t i = (size_t)blockIdx.x * NTHR + threadIdx.x; i < (size_t)T * D; i += (size_t)gridDim.x * NTHR) P.out[i] = (i == 0) ? k1 : k2; }
#endif
#undef IN
#undef SEAM
#undef OPQ
}

extern "C" void kernel_launch(void* const* d_in, const int* in_sizes, int n_in, void* d_out, int out_size, void* d_ws, size_t ws_size, hipStream_t stream) {
    static int grid = 0;
    if (grid == 0) {
        if (n_in != 28 || out_size != T * D || ws_size < WS_END) { fprintf(stderr, "kernel_launch: unexpected shapes (n_in %d, out %d, ws %zu, need %zu)\n", n_in, out_size, ws_size, (size_t)WS_END); grid = -1; return; }
        int dev = 0, cus = 0, per_cu = 0;
        if (hipGetDevice(&dev) != hipSuccess || hipDeviceGetAttribute(&cus, hipDeviceAttributeMultiprocessorCount, dev) != hipSuccess) { grid = -1; return; }
        if (hipFuncSetAttribute((const void*)fwd, hipFuncAttributeMaxDynamicSharedMemorySize, LDS_BYTES) != hipSuccess) { fprintf(stderr, "kernel_launch: hipFuncSetAttribute failed\n"); grid = -1; return; }
        if (hipOccupancyMaxActiveBlocksPerMultiprocessor(&per_cu, (const void*)fwd, NTHR, LDS_BYTES) != hipSuccess || per_cu < 1) { fprintf(stderr, "kernel_launch: occupancy query says %d\n", per_cu); grid = -1; (void)hipGetLastError(); return; }
        grid = cus;
    }
    if (grid < 0) return;
    (void)hipMemsetAsync((char*)d_ws + WS_CTL, 0, CTL_BYTES, stream);
    Params p{};
    p.x = (const float*)d_in[0]; p.mem = (const float*)d_in[1]; p.positions = (const int*)d_in[2];
    p.g_mix = (const float*)d_in[3]; p.w_in = (const float*)d_in[4]; p.g_cq = (const float*)d_in[5]; p.g_ckv = (const float*)d_in[6]; p.w_uq = (const float*)d_in[7]; p.w_ukv = (const float*)d_in[8];
    p.w_up_a = (const float*)d_in[9]; p.w_up_b = (const float*)d_in[10]; p.w_up_c = (const float*)d_in[11]; p.w_o = (const float*)d_in[12]; p.g_x = (const float*)d_in[13]; p.g_mem = (const float*)d_in[14];
    p.w_xq = (const float*)d_in[15]; p.w_xk = (const float*)d_in[16]; p.w_xv = (const float*)d_in[17]; p.w_xo = (const float*)d_in[18]; p.g_ffn = (const float*)d_in[19];
    p.w_ff1 = (const float*)d_in[20]; p.w_ff3 = (const float*)d_in[21]; p.w_ff2 = (const float*)d_in[22]; p.w_router = (const float*)d_in[23]; p.w_e1 = (const float*)d_in[24]; p.w_e3 = (const float*)d_in[25];
    p.w_e2 = (const float*)d_in[26]; p.g_final = (const float*)d_in[27];
    p.out = (float*)d_out; p.ws = (unsigned char*)d_ws;
#if N_LAUNCH_MODE == 1
    p.ph_lo = 0; p.ph_hi = NPH;
    hipLaunchKernelGGL(fwd, dim3(grid), dim3(NTHR), LDS_BYTES, stream, p);
#else
    for (int ph = 0; ph < NPH; ++ph) { p.ph_lo = ph; p.ph_hi = ph + 1; hipLaunchKernelGGL(fwd, dim3(grid), dim3(NTHR), LDS_BYTES, stream, p); }
#endif
}
```

```cpp
#include <hip/hip_runtime.h>
#include <cstdio>
#include <cstdint>

#define LAS __attribute__((address_space(3)))
#define DI __device__ __forceinline__
typedef unsigned short bf16_t;
typedef short bf16x8 __attribute__((ext_vector_type(8)));
typedef short s16x4 __attribute__((ext_vector_type(4)));
typedef float f32x2 __attribute__((ext_vector_type(2)));
typedef float f32x4 __attribute__((ext_vector_type(4)));
typedef float f32x16 __attribute__((ext_vector_type(16)));
typedef unsigned u32x2 __attribute__((ext_vector_type(2)));
typedef unsigned u32x4 __attribute__((ext_vector_type(4)));
typedef __bf16 bf16x2_t __attribute__((ext_vector_type(2)));

#ifndef SIMPLE_GEMM
#define SIMPLE_GEMM 0
#endif
#ifndef N_LAUNCH_MODE
#define N_LAUNCH_MODE 1
#endif

constexpr int NB = 4, SEQ = 4096, T = NB * SEQ, D = 2048;
constexpr int IN_COLS = 11072, NIN = 11264;
constexpr int DFF = 5632, NEXP = 8, DFE = 7168;
constexpr int NSLOT_BLK = 136, NSLOT = NSLOT_BLK * 256;
constexpr float EPS = 1e-6f;
constexpr float LOG2E = 1.4426950408889634f;
constexpr int NWAVES = 8, NTHR = 512;

constexpr size_t MiB = 1u << 20;
constexpr size_t WS_CTL = 0, CTL_BYTES = 4 * MiB;
constexpr size_t WS_WIN = 4 * MiB;
constexpr size_t SZ_WIN = (size_t)NIN * D * 2;
constexpr size_t WS_WUQ = WS_WIN + 2 * SZ_WIN;
constexpr size_t SZ_WUQ = (size_t)1280 * 512 * 2;
constexpr size_t WS_WUKV = WS_WUQ + 2 * SZ_WUQ;
constexpr size_t SZ_WUKV = (size_t)1536 * 512 * 2;
constexpr size_t SZ_SQ = (size_t)D * D * 2;
constexpr size_t WS_WUP = WS_WUKV + 2 * SZ_WUKV;
constexpr size_t WS_WO = WS_WUP + 2 * SZ_SQ;
constexpr size_t WS_WXQ = WS_WO + 2 * SZ_SQ;
constexpr size_t WS_WXK = WS_WXQ + 2 * SZ_SQ;
constexpr size_t WS_WXV = WS_WXK + 2 * SZ_SQ;
constexpr size_t WS_WXO = WS_WXV + 2 * SZ_SQ;
constexpr size_t WS_WFF13 = WS_WXO + 2 * SZ_SQ;
constexpr size_t WS_WFF2 = WS_WFF13 + SZ_WIN;
constexpr size_t SZ_WFF2 = (size_t)D * DFF * 2;
constexpr size_t WS_WE13 = WS_WFF2 + SZ_WFF2;
constexpr size_t SZ_WE13 = (size_t)2 * DFE * D * 2;
constexpr size_t WS_WE2 = WS_WE13 + NEXP * SZ_WE13;
constexpr size_t SZ_WE2 = (size_t)D * DFE * 2;
constexpr size_t WS_HB = WS_WE2 + NEXP * SZ_WE2;
constexpr size_t WS_CS128 = WS_HB + (size_t)T * D * 2;
constexpr size_t WS_CS64 = WS_CS128 + (size_t)T * 64 * 8;
constexpr size_t WS_MEMN = WS_CS64 + (size_t)T * 32 * 8;
constexpr size_t WS_KMEM = WS_MEMN + 8 * MiB;
constexpr size_t WS_VMEMT = WS_KMEM + 8 * MiB;
constexpr size_t WS_TOK = WS_VMEMT + 8 * MiB;
constexpr size_t WS_R1 = WS_TOK + 1 * MiB;
constexpr size_t WS_R2 = WS_R1 + 512 * MiB;
constexpr size_t WS_HB8 = WS_R2 + 288 * MiB;
constexpr size_t WS_MT = WS_HB8 + 32 * MiB;
constexpr size_t WS_NT = WS_MT + 32 * MiB;
constexpr size_t WS_WING8 = WS_NT + 32 * MiB;
constexpr size_t WS_END = WS_WING8 + 24 * MiB;
constexpr size_t WS_WIN8X = WS_WE13 + SZ_WE13 / 2;
constexpr size_t R1_ZC = 0, R1_KPE = 32 * MiB, R1_MQK = 34 * MiB, R1_PL = 74 * MiB, R1_G = 154 * MiB;
constexpr size_t R1_ACT = 0;
constexpr size_t R1_ACTE = 0;
static_assert((size_t)NSLOT * DFE * 2 <= 512 * MiB && R1_G + (size_t)T * 6144 * 2 <= 512 * MiB, "R1");
constexpr size_t R2_QA = 0, R2_KVA = 36 * MiB, R2_OCAT = 84 * MiB, R2_MERGED = 148 * MiB;
constexpr size_t R2_QX = 0, R2_PX = 64 * MiB, R2_OX = 96 * MiB;
constexpr size_t R2_XS = 0, R2_YS = 136 * MiB;
static_assert(R2_YS + (size_t)NSLOT * D * 2 <= 288 * MiB, "R2");
constexpr size_t R2_YP = 72 * MiB;

constexpr int CW_BAR = 4096;
constexpr int CW_QUEUE = 8192;
constexpr int CW_TS = 10240;
constexpr int CW_MOE = 9216;
constexpr int CW_STAT = 16384;
constexpr int CW_KSUM = CW_STAT + 20 * T;
constexpr int KSUM_L = NB * 16 * 5 * 128;
static_assert((size_t)(CW_KSUM + 2 * KSUM_L) * 4 <= CTL_BYTES, "ctl");
enum { ST_MIX = 0, ST_CQ = 1, ST_CKV = 2, ST_X = 3, ST_FFN = 4 };

constexpr int LDS_STAGE = 131072;
constexpr int LDS_EPI = LDS_STAGE;
constexpr int LDS_MISC = LDS_STAGE + 8192;
constexpr int LDS_STATP = LDS_MISC + 1024;
constexpr int LDS_BYTES = 147456;

DI unsigned cvt_pk_bf16(float lo, float hi) { f32x2 v = {lo, hi}; bf16x2_t b = __builtin_convertvector(v, bf16x2_t); return __builtin_bit_cast(unsigned, b); }
DI u32x4 pack8(f32x4 a, f32x4 b) { u32x4 w; w.x = cvt_pk_bf16(a[0], a[1]); w.y = cvt_pk_bf16(a[2], a[3]); w.z = cvt_pk_bf16(b[0], b[1]); w.w = cvt_pk_bf16(b[2], b[3]); return w; }
typedef int i32x4 __attribute__((ext_vector_type(4)));
typedef int i32x8 __attribute__((ext_vector_type(8)));
DI unsigned pk_fp8x4(float a, float b, float c, float d) {
    a = __builtin_amdgcn_fmed3f(a, -448.f, 448.f); b = __builtin_amdgcn_fmed3f(b, -448.f, 448.f); c = __builtin_amdgcn_fmed3f(c, -448.f, 448.f); d = __builtin_amdgcn_fmed3f(d, -448.f, 448.f);
    int w = 0; w = __builtin_amdgcn_cvt_pk_fp8_f32(a, b, w, false); w = __builtin_amdgcn_cvt_pk_fp8_f32(c, d, w, true); return (unsigned)w; }
DI u32x2 pack8_fp8(f32x4 a, f32x4 b) { u32x2 w; w.x = pk_fp8x4(a[0], a[1], a[2], a[3]); w.y = pk_fp8x4(b[0], b[1], b[2], b[3]); return w; }
constexpr bool F8_XATTN = true;
constexpr float F8_SM = 512.0f, F8_SN = 64.0f, F8_SP = 256.0f;
#ifndef F8_B_
#define F8_B_ true
#endif
#ifndef F8_XPRE_
#define F8_XPRE_ true
#endif
#ifndef F8_DUP_
#define F8_DUP_ true
#endif
constexpr bool F8_DUP = F8_DUP_;
constexpr float F8_SO = 64.0f;
#ifndef MOE_TAIL_
#define MOE_TAIL_ true
#endif
constexpr bool MOE_TAIL = MOE_TAIL_;
constexpr bool F8_B = F8_B_;
constexpr bool F8_XPRE = F8_XPRE_;
constexpr float F8_SZ = 32.0f, F8_SWQ = 4096.0f;
#ifndef A8_TILES
#define A8_TILES 16
#endif
constexpr bool F8_AMM = true;
constexpr bool F8_GATES = true;
constexpr bool F8_DENSE = false, F8_MOE = true, F8_DDOWN = false;
constexpr float F8_SW = 512.0f, F8_SA = 8.0f, F8_SX = 16.0f;
DI i32x8 cat8(bf16x8 lo, bf16x8 hi) { const i32x4 a = __builtin_bit_cast(i32x4, lo), b = __builtin_bit_cast(i32x4, hi); return (i32x8){a[0], a[1], a[2], a[3], b[0], b[1], b[2], b[3]}; }
template <int N> DI float ubf(unsigned w) { return (float)((w >> (8 * N)) & 0xffu); }
DI float bf_lo(unsigned w) { return __uint_as_float(w << 16); }
DI float bf_hi(unsigned w) { return __uint_as_float(w & 0xffff0000u); }
typedef unsigned long long stat_t;
constexpr float STAT_SCALE = 16777216.0f, STAT_INV = 1.0f / 16777216.0f;
DI void atomic_adds(stat_t* p, float v) { __hip_atomic_fetch_add(p, (stat_t)(v * STAT_SCALE), __ATOMIC_RELAXED, __HIP_MEMORY_SCOPE_AGENT); }
DI void atomic_addf(float* p, float v) { __hip_atomic_fetch_add(p, v, __ATOMIC_RELAXED, __HIP_MEMORY_SCOPE_AGENT); }
template <int M> DI float swz_xor(float v) { return __int_as_float(__builtin_amdgcn_ds_swizzle(__float_as_int(v), 0x1f | (M << 10))); }
DI float half_sum(float v) { auto rr = __builtin_amdgcn_permlane32_swap(__float_as_uint(v), __float_as_uint(v), false, false); return __uint_as_float(rr[0]) + __uint_as_float(rr[1]); }
DI float half_max(float v) { auto rr = __builtin_amdgcn_permlane32_swap(__float_as_uint(v), __float_as_uint(v), false, false); return fmaxf(__uint_as_float(rr[0]), __uint_as_float(rr[1])); }
DI float wave_sum(float v) { v += swz_xor<1>(v); v += swz_xor<2>(v); v += swz_xor<4>(v); v += swz_xor<8>(v); v += swz_xor<16>(v); return half_sum(v); }
DI int lane_id_now() { int l; asm volatile("v_mbcnt_lo_u32_b32 %0, -1, 0\n\tv_mbcnt_hi_u32_b32 %0, -1, %0" : "=v"(l)); return l; }
DI float fast_exp2(float x) { return __builtin_amdgcn_exp2f(x); }
DI float fast_log2(float x) { return __builtin_amdgcn_logf(x); }
DI float fast_rcp(float x) { return __builtin_amdgcn_rcpf(x); }
DI float sigmoidf_(float x) { return fast_rcp(1.0f + fast_exp2(-x * LOG2E)); }

#define XB_TMO      128
#define XB_XCNT(j)  (256  + 64 * (j))
#define XB_XSUB(j)  (1280 + 64 * (j))
#define XB_XGEN(j)  (2304 + 64 * (j))
#define XB_TOP      3328
#define XB_TOPGEN   3392
#define XCD_BAR_WORDS 3456
#define XB_SPIN_CAP (1u << 18)

__device__ __forceinline__ unsigned xb_ld(unsigned* p)              { return __hip_atomic_load(p, __ATOMIC_RELAXED, __HIP_MEMORY_SCOPE_AGENT); }
__device__ __forceinline__ unsigned xb_add(unsigned* p, unsigned v) { return __hip_atomic_fetch_add(p, v, __ATOMIC_RELAXED, __HIP_MEMORY_SCOPE_AGENT); }
__device__ __forceinline__ unsigned xb_xcc_id() { return (unsigned)__builtin_amdgcn_s_getreg((3 << 11) | 20) & 0xFu; }
#define XB_SPIN(cond, bar) do { unsigned _sp = 0; while (cond) { __builtin_amdgcn_s_sleep(1); \
    if ((++_sp & 255u) == 0u) { if (xb_ld(&(bar)[XB_TMO])) break; if (_sp > XB_SPIN_CAP) { atomicAdd(&(bar)[XB_TMO], 1u); break; } } } } while (0)

struct XcdBarrier { unsigned* bar; unsigned x; volatile LAS unsigned* st; };

__device__ __forceinline__ XcdBarrier xcd_barrier_post(unsigned* bar, volatile LAS unsigned* st) {
    XcdBarrier b; b.bar = bar; b.x = xb_xcc_id(); b.st = st;
    if (threadIdx.x == 0) (void)xb_add(&bar[XB_XCNT(b.x)], 1u);
    return b;
}
__device__ __forceinline__ void xcd_barrier_complete(unsigned* bar, unsigned x, unsigned& nloc, unsigned& nx) {
    const unsigned G = gridDim.x * gridDim.y * gridDim.z;
    unsigned sum, cnt, mine, sp = 0u;
    for (;;) {
        sum = 0u; cnt = 0u; mine = 0u;
#pragma unroll
        for (unsigned j = 0; j < 16; ++j) { const unsigned c = xb_ld(&bar[XB_XCNT(j)]); sum += c; cnt += (c > 0u) ? 1u : 0u; mine = (j == x) ? c : mine; }
        if (sum == G) break;
        __builtin_amdgcn_s_sleep(1);
        if ((++sp & 255u) == 0u) { if (xb_ld(&bar[XB_TMO])) break; if (sp > XB_SPIN_CAP) { atomicAdd(&bar[XB_TMO], 1u); break; } }
    }
    nloc = mine > 0u ? mine : 1u; nx = cnt > 0u ? cnt : 1u;
}
__device__ __forceinline__ void xcd_barrier(const XcdBarrier& b, const bool thread0  ) {
    asm volatile("s_waitcnt vmcnt(0)" ::: "memory");
    __syncthreads();
    unsigned bx = b.x; asm volatile("" : "+s"(bx));
    if (thread0) {
        unsigned* bar = b.bar; asm volatile("" : "+s"(bar));
        __builtin_amdgcn_s_waitcnt(0);
        unsigned nloc = b.st[0], nx = b.st[1];
        if (nloc == 0u) { xcd_barrier_complete(bar, bx, nloc, nx); b.st[0] = nloc; b.st[1] = nx; }
        const unsigned old = xb_add(&bar[XB_XSUB(bx)], 1u);
        const unsigned gen = old / nloc;
        if (old + 1u == (gen + 1u) * nloc) {
            __builtin_amdgcn_fence(__ATOMIC_RELEASE, "agent");
            asm volatile("s_waitcnt vmcnt(0)" ::: "memory");
            const unsigned og = xb_add(&bar[XB_TOP], 1u);
            const unsigned tg = og / nx;
            if (og + 1u == (tg + 1u) * nx) xb_add(&bar[XB_TOPGEN], 1u);
            else XB_SPIN(xb_ld(&bar[XB_TOPGEN]) == tg, bar);
            __builtin_amdgcn_fence(__ATOMIC_ACQUIRE, "agent");
            xb_add(&bar[XB_XGEN(bx)], 1u);
            asm volatile("s_waitcnt vmcnt(0)" ::: "memory");
        } else {
            XB_SPIN(xb_ld(&bar[XB_XGEN(bx)]) == gen, bar);
            __builtin_amdgcn_fence(__ATOMIC_ACQUIRE, "agent");
            asm volatile("s_waitcnt vmcnt(0)" ::: "memory");
        }
    }
    __syncthreads();
}

namespace pg8 {
constexpr int BM = 256, BK = 64, HALF = 128, HTB = HALF * BK * 2, STAGE_BYTES = 8 * HTB, NXCD = 8, WGM = 8;
DI int lds_byte(int r, int c) { const int st = (r >> 4) * 2 + (c >> 5), rr = r & 15, cc = c & 31, ob = rr * 64 + cc * 2; return st * 1024 + (ob ^ (((ob >> 9) & 1) << 5)); }
DI void stage_rc(int b, int& R, int& C) { const int st = b / 1024, sb = b % 1024, swz = sb ^ (((sb >> 9) & 1) << 5); R = (st >> 1) * 16 + swz / 64; C = (st & 1) * 32 + (swz % 64) / 2; }
DI int perm32(int rho) { const int n = rho >> 4, i = rho & 15; return 8 * (i >> 2) + 4 * n + (i & 3); }

struct Unit { int pm, pn, aux, nt; const char* a; const char* b; int sp, bar; };

DI void tile_order(int L, int nM, int nN, int& pm, int& pn) {
    const int nwg = nM * nN; int wgid = L;
    { const int q = nwg / NXCD, r = nwg % NXCD, xcd = wgid % NXCD, off = wgid / NXCD; wgid = (xcd < r ? xcd * (q + 1) : r * (q + 1) + (xcd - r) * q) + off; }
    const int nig = WGM * nN, gid = wgid / nig, fm = gid * WGM, gsz = (nM - fm) < WGM ? (nM - fm) : WGM;
    pm = fm + ((wgid % nig) % gsz); pn = (wgid % nig) / gsz;
}

typedef f32x4 Acc[2][2][4][2];

#if !SIMPLE_GEMM
#ifndef ALIGN_DEFAULT
#define ALIGN_DEFAULT true
#endif
template <class Epi, class Sched, bool ALIGN_EPI_ = false, bool FP8 = false, bool NOALIGN = false, bool MIX = false>
DI void gemm_phase(LAS unsigned char* lds, const int tid_in, const int lda, const int ldb, const Sched& S, const Epi& E) {
    constexpr bool ALIGN_EPI = ALIGN_EPI_ || (ALIGN_DEFAULT && !NOALIGN); constexpr bool F8L = FP8 || MIX;
    int tid_ = tid_in; asm volatile("" : "+v"(tid_));
    const int tid = tid_, wid = __builtin_amdgcn_readfirstlane(tid >> 6), lane = tid & 63, wr = wid >> 2, wc = wid & 3, fr = lane & 15, fq = lane >> 4;
    unsigned voffA[2], voffB[2], voffAh[2], voffBh[2];
#pragma unroll
    for (int i = 0; i < 2; ++i) { int R, C; stage_rc(tid * 16 + i * 8192, R, C); const int Rb = (R & ~31) + perm32(R & 31);
        voffA[i] = (unsigned)(R * lda + C * 2); voffB[i] = (unsigned)(Rb * ldb + C * 2); voffAh[i] = voffA[i] + (unsigned)(HALF * lda); voffBh[i] = voffB[i] + (unsigned)(HALF * ldb); }
    const size_t kstep = (size_t)(BK * 2);
    const unsigned ldsw = (unsigned)wid * 1024u;
    const int aoff = lds_byte(wr * 64 + fr, fq * 8), boff = lds_byte(wc * 32 + fr, fq * 8);
#define PG8_SA(b, h) (((b) * 2 + (h)) * HTB)
#define PG8_SB(b, h) ((4 + (b) * 2 + (h)) * HTB)
#define PG8_STAGE(bufoff, gbase, voff) do { _Pragma("unroll") for (int _i = 0; _i < 2; ++_i) \
        __builtin_amdgcn_global_load_lds((const unsigned*)((const char*)(gbase) + (voff)[_i]), (LAS unsigned*)(lds + (bufoff) + ldsw + _i * 8192), 16, 0, 0); } while (0)
#define PG8_STAGE_AH(bufoff, gbase) do { if constexpr (MIX) PG8_STAGE(bufoff, (gbase) + (size_t)HALF * lda, voffA); else PG8_STAGE(bufoff, gbase, voffAh); } while (0)
#define PG8_STAGE_BH(bufoff, gbase) do { if constexpr (MIX) PG8_STAGE(bufoff, (gbase) + (size_t)HALF * ldb, voffB); else PG8_STAGE(bufoff, gbase, voffBh); } while (0)
#define PG8_LD8(p) ({ const i32x4 lo_ = *(const LAS i32x4*)(p), hi_ = *(const LAS i32x4*)((p) + 1024); (i32x8){lo_[0], lo_[1], lo_[2], lo_[3], hi_[0], hi_[1], hi_[2], hi_[3]}; })
#define PG8_LDA(dst, b, h) do { _Pragma("unroll") for (int m = 0; m < 4; ++m) { if constexpr (F8L) dst##8[m] = PG8_LD8(lds + PG8_SA(b, h) + aoff + m * 2048); \
        else { _Pragma("unroll") for (int k = 0; k < 2; ++k) dst[m][k] = *(const LAS bf16x8*)(lds + PG8_SA(b, h) + aoff + m * 2048 + k * 1024); } } } while (0)
#define PG8_LDB(dst, b, h) do { _Pragma("unroll") for (int n = 0; n < 2; ++n) { if constexpr (F8L) dst##8[n] = PG8_LD8(lds + PG8_SB(b, h) + boff + n * 2048); \
        else { _Pragma("unroll") for (int k = 0; k < 2; ++k) dst[n][k] = *(const LAS bf16x8*)(lds + PG8_SB(b, h) + boff + n * 2048 + k * 1024); } } } while (0)
#define PG8_H0(x) __builtin_bit_cast(bf16x8, __builtin_shufflevector(x, x, 0, 1, 2, 3))
#define PG8_H1(x) __builtin_bit_cast(bf16x8, __builtin_shufflevector(x, x, 4, 5, 6, 7))
#define PG8_MMA(MODE, ai, bj, At, Bt) do { __builtin_amdgcn_s_setprio(1);   \
        if constexpr ((MODE) == 1) { _Pragma("unroll") for (int m = 0; m < 4; ++m) _Pragma("unroll") for (int n = 0; n < 2; ++n) \
            asm volatile("v_mfma_scale_f32_16x16x128_f8f6f4 %0, %1, %2, %0, %3, %3 op_sel_hi:[0,0,0]" : "+v"(acc[ai][bj][m][n]) : "v"(Bt##8[n]), "v"(At##8[m]), "v"(f8one)); } \
        else if constexpr ((MODE) == 2) {   \
            _Pragma("unroll") for (int m = 0; m < 4; ++m) _Pragma("unroll") for (int n = 0; n < 2; ++n) \
                asm volatile("v_mfma_f32_16x16x32_bf16 %0, %1, %2, %0" : "+v"(acc[ai][bj][m][n]) : "v"(PG8_H0(Bt##8[n])), "v"(PG8_H0(At##8[m]))); \
            _Pragma("unroll") for (int m = 0; m < 4; ++m) _Pragma("unroll") for (int n = 0; n < 2; ++n) \
                asm volatile("v_mfma_f32_16x16x32_bf16 %0, %1, %2, %0" : "+v"(acc[ai][bj][m][n]) : "v"(PG8_H1(Bt##8[n])), "v"(PG8_H1(At##8[m]))); } \
        else { _Pragma("unroll") for (int m = 0; m < 4; ++m) _Pragma("unroll") for (int n = 0; n < 2; ++n) _Pragma("unroll") for (int k = 0; k < 2; ++k) \
            acc[ai][bj][m][n] = __builtin_amdgcn_mfma_f32_16x16x32_bf16(Bt[n][k], At[m][k], acc[ai][bj][m][n], 0, 0, 0); } \
        __builtin_amdgcn_s_setprio(0); } while (0)
#define PG8_WAIT_V(n) asm volatile("s_waitcnt vmcnt(" #n ")" ::: "memory")
#define PG8_WAIT_L(n) asm volatile("s_waitcnt lgkmcnt(" #n ")" ::: "memory")
#define PG8_BAR __builtin_amdgcn_s_barrier()
#define PG8_SCHED __builtin_amdgcn_sched_barrier(0)
#define PG8_KLOOP(MODE) \
        for (int t = 0; t < nt; t += 2) { \
            const bool last = (t == nt - 2); \
            const char* a1 = cA + (size_t)(t + 1) * kstep; \
            const char* a2 = last ? nA : cA + (size_t)(t + 2) * kstep; const char* b2 = last ? nB : cB + (size_t)(t + 2) * kstep; \
            const char* a3 = a2 + kstep; const char* b3 = b2 + kstep; \
            PG8_LDB(B0, 0, 0); PG8_LDB(B1, 0, 1); PG8_SCHED; PG8_LDA(At, 0, 0); PG8_STAGE_AH(PG8_SA(1, 1), a1); \
            PG8_WAIT_V(8); PG8_WAIT_L(0); PG8_BAR; PG8_MMA(MODE, 0, 0, At, B0); PG8_MMA(MODE, 0, 1, At, B1); PG8_BAR; PG8_SCHED; \
            PG8_LDA(At, 0, 1); PG8_STAGE(PG8_SB(0, 0), b2, voffB); PG8_STAGE_BH(PG8_SB(0, 1), b2); PG8_STAGE(PG8_SA(0, 0), a2, voffA); \
            PG8_WAIT_V(8); PG8_WAIT_L(0); PG8_BAR; PG8_MMA(MODE, 1, 0, At, B0); PG8_MMA(MODE, 1, 1, At, B1); PG8_BAR; PG8_SCHED; \
            PG8_LDB(B0, 1, 0); PG8_LDB(B1, 1, 1); PG8_SCHED; PG8_LDA(At, 1, 0); PG8_STAGE_AH(PG8_SA(0, 1), a2); \
            PG8_WAIT_V(8); PG8_WAIT_L(0); PG8_BAR; PG8_MMA(MODE, 0, 0, At, B0); PG8_MMA(MODE, 0, 1, At, B1); PG8_BAR; PG8_SCHED; \
            PG8_LDA(At, 1, 1); PG8_STAGE(PG8_SB(1, 0), b3, voffB); PG8_STAGE_BH(PG8_SB(1, 1), b3); PG8_STAGE(PG8_SA(1, 0), a3, voffA); \
            PG8_WAIT_V(8); PG8_WAIT_L(0); PG8_BAR; PG8_MMA(MODE, 1, 0, At, B0); PG8_MMA(MODE, 1, 1, At, B1); PG8_BAR; PG8_SCHED; \
        }
    const stat_t* const sp_src = E.stat_src();
#define PG8_STATDMA(unit, par, ln) do { if (sp_src && wid < 2) __builtin_amdgcn_global_load_lds((const unsigned*)((const char*)(sp_src + (size_t)(unit).pm * 256) + (wid * 64 + (ln)) * 16), \
        (LAS unsigned*)(lds + LDS_STATP + (par) * 2048 + wid * 1024), 16, 0, 0); } while (0)
    Unit cur, nxt; int ui = 0;
    if (!S.next(0, cur)) return;
    PG8_STATDMA(cur, 0, lane);
    Acc acc;
#pragma unroll
    for (int a = 0; a < 2; ++a)
#pragma unroll
        for (int b = 0; b < 2; ++b)
#pragma unroll
            for (int m = 0; m < 4; ++m)
#pragma unroll
                for (int n = 0; n < 2; ++n) acc[a][b][m][n] = (f32x4){0.f, 0.f, 0.f, 0.f};
    bf16x8 At[4][2], B0[2][2], B1[2][2]; i32x8 At8[4], B08[2], B18[2];
    int f8one = 0x7f7f7f7f; asm volatile("" : "+v"(f8one));
    const char* cA = cur.a; const char* cB = cur.b;
    PG8_STAGE(PG8_SB(0, 0), cB, voffB); PG8_STAGE_BH(PG8_SB(0, 1), cB); PG8_STAGE(PG8_SA(0, 0), cA, voffA); PG8_STAGE_AH(PG8_SA(0, 1), cA);
    if (wr == 1) PG8_BAR;
    PG8_WAIT_V(2); PG8_BAR;
    PG8_STAGE(PG8_SB(1, 0), cB + kstep, voffB); PG8_STAGE(PG8_SA(1, 0), cA + kstep, voffA); PG8_STAGE_BH(PG8_SB(1, 1), cB + kstep);
    PG8_WAIT_V(6); PG8_BAR;
#define PG8_UNIT(MODE) { \
        const bool has_next = S.next(ui + 1, nxt); \
        const char* nA = has_next ? nxt.a : cA; const char* nB = has_next ? nxt.b : cB; \
        const int nt = cur.nt; \
        PG8_KLOOP(MODE) \
        if constexpr ((MODE) != 0) asm volatile("s_nop 15\n\ts_nop 15" ::: "memory");     \
        if constexpr (ALIGN_EPI && !Epi::BAR_INSIDE) { if (wr == 0) PG8_BAR; } \
        cur.bar = (ALIGN_EPI && Epi::BAR_INSIDE && wr == 0) ? 1 : 0; \
        const int le_ = lane_id_now();                                 \
        if (has_next) PG8_STATDMA(nxt, (ui + 1) & 1, le_); \
        cur.sp = (int)(unsigned)(unsigned long long)(lds + LDS_STATP + (ui & 1) * 2048); \
        const bool keep = E(acc, cur, wr, wc, le_ & 15, le_ >> 4); \
        if (!has_next) break; \
        if (!keep) { \
            _Pragma("unroll") for (int a = 0; a < 2; ++a) _Pragma("unroll") for (int b = 0; b < 2; ++b) _Pragma("unroll") for (int m = 0; m < 4; ++m) _Pragma("unroll") for (int n = 0; n < 2; ++n) acc[a][b][m][n] = (f32x4){0.f, 0.f, 0.f, 0.f}; \
        } \
        cur = nxt; cA = nA; cB = nB; ++ui; \
        if constexpr (ALIGN_EPI) { if (wr == 1) PG8_BAR; } }
    for (;;) {
        if constexpr (MIX) { PG8_UNIT(1) PG8_UNIT(1) PG8_UNIT(2) }
        else if constexpr (FP8) { PG8_UNIT(1) } else { PG8_UNIT(0) }
    }
    PG8_WAIT_V(0);
    if constexpr (!ALIGN_EPI) { if (wr == 0) PG8_BAR; }
    PG8_BAR;
#undef PG8_SA
#undef PG8_SB
#undef PG8_STAGE
#undef PG8_STAGE_AH
#undef PG8_STAGE_BH
#undef PG8_LDA
#undef PG8_LD8
#undef PG8_LDB
#undef PG8_MMA
#undef PG8_KLOOP
#undef PG8_STATDMA
#undef PG8_UNIT
#undef PG8_H0
#undef PG8_H1
#undef PG8_WAIT_V
#undef PG8_WAIT_L
#undef PG8_BAR
#undef PG8_SCHED
}
#else
template <class Epi, class Sched, bool ALIGN_EPI = false, bool FP8 = false>
DI void gemm_phase(LAS unsigned char* lds, const int tid_in, const int lda, const int ldb, const Sched& S, const Epi& E) {
    static_assert(!FP8, "the debug fallback is bf16 only");
    const int tid = tid_in, wid = __builtin_amdgcn_readfirstlane(tid >> 6), lane = tid & 63, wr = wid >> 2, wc = wid & 3, fr = lane & 15, fq = lane >> 4;
    Unit cur; Acc acc; bool keep = false;
    for (int ui = 0; S.next(ui, cur); ++ui) {
        if (!keep) {
#pragma unroll
            for (int a = 0; a < 2; ++a)
#pragma unroll
                for (int b = 0; b < 2; ++b)
#pragma unroll
                    for (int m = 0; m < 4; ++m)
#pragma unroll
                        for (int n = 0; n < 2; ++n) acc[a][b][m][n] = (f32x4){0.f, 0.f, 0.f, 0.f};
        }
        for (int k0 = 0; k0 < cur.nt * 64; k0 += 32) {
            bf16x8 Af[2][4], Bf[2][2];
#pragma unroll
            for (int ai = 0; ai < 2; ++ai)
#pragma unroll
                for (int m = 0; m < 4; ++m) Af[ai][m] = *(const bf16x8*)(cur.a + (size_t)(ai * 128 + wr * 64 + m * 16 + fr) * lda + (size_t)(k0 + fq * 8) * 2);
#pragma unroll
            for (int bj = 0; bj < 2; ++bj)
#pragma unroll
                for (int n = 0; n < 2; ++n) Bf[bj][n] = *(const bf16x8*)(cur.b + (size_t)(bj * 128 + wc * 32 + perm32(n * 16 + fr)) * ldb + (size_t)(k0 + fq * 8) * 2);
#pragma unroll
            for (int ai = 0; ai < 2; ++ai)
#pragma unroll
                for (int bj = 0; bj < 2; ++bj)
#pragma unroll
                    for (int m = 0; m < 4; ++m)
#pragma unroll
                        for (int n = 0; n < 2; ++n) acc[ai][bj][m][n] = __builtin_amdgcn_mfma_f32_16x16x32_bf16(Bf[bj][n], Af[ai][m], acc[ai][bj][m][n], 0, 0, 0);
        }
        if constexpr (ALIGN_EPI) __syncthreads();
        keep = E(acc, cur, wr, wc, fr, fq);
        if constexpr (ALIGN_EPI) __syncthreads();
    }
    __syncthreads();
}
#endif

struct SchedGrid {
    const char* A; const char* Bt; int lda, ldb, nM, nN, nt, G, c, pn0;
    DI bool next(int i, Unit& u) const {
        const long L = (long)i * G + c; if (L >= (long)nM * nN) return false;
        tile_order((int)L, nM, nN, u.pm, u.pn); u.pn += pn0; u.aux = 0; u.nt = nt;
        u.a = A + (size_t)u.pm * 256 * lda; u.b = Bt + (size_t)u.pn * 256 * ldb; return true;
    }
};
}

namespace epi {
using pg8::Acc; using pg8::Unit;
DI float row_rs(const stat_t* stat, int row, float inv_n) { return __builtin_amdgcn_rsqf((float)stat[row] * STAT_INV * inv_n + EPS); }

DI void load_rs(const stat_t* stat, int row0, float inv_n, float mul, float (&rs)[2][4]) {
    stat_t v[2][4];
#pragma unroll
    for (int ai = 0; ai < 2; ++ai)
#pragma unroll
        for (int m = 0; m < 4; ++m) v[ai][m] = stat ? stat[row0 + ai * 128 + m * 16] : (stat_t)0;
#pragma unroll
    for (int ai = 0; ai < 2; ++ai)
#pragma unroll
        for (int m = 0; m < 4; ++m) rs[ai][m] = stat ? mul * __builtin_amdgcn_rsqf((float)v[ai][m] * STAT_INV * inv_n + EPS) : mul;
}
DI void load_rs_lds(bool has, int sp, int rl0, float inv_n, float mul, float (&rs)[2][4]) {
    const LAS stat_t* sb = (const LAS stat_t*)(size_t)(unsigned)sp; stat_t v[2][4];
#pragma unroll
    for (int ai = 0; ai < 2; ++ai)
#pragma unroll
        for (int m = 0; m < 4; ++m) v[ai][m] = has ? sb[rl0 + ai * 128 + m * 16] : (stat_t)0;
#pragma unroll
    for (int ai = 0; ai < 2; ++ai)
#pragma unroll
        for (int m = 0; m < 4; ++m) rs[ai][m] = has ? mul * __builtin_amdgcn_rsqf((float)v[ai][m] * STAT_INV * inv_n + EPS) : mul;
}
DI void stat_atomics(const float (&ss)[2][4], stat_t* stat, int row0, int fq) {
#pragma unroll
    for (int ai = 0; ai < 2; ++ai)
#pragma unroll
        for (int m = 0; m < 4; ++m) { float s = ss[ai][m]; s += swz_xor<16>(s); s = half_sum(s);
            if (fq == 0) atomic_adds(stat + row0 + ai * 128 + m * 16, s); }
}

template <int EMASK> struct EpiIn {
    const stat_t* stat_in; bf16_t* ZC; bf16_t* KPE; bf16_t* MQK; bf16_t* PL; bf16_t* G;
    stat_t* stat_cq; stat_t* stat_ckv; float* ksum; const f32x2* cs128; const f32x2* cs64; float dsc;
    static constexpr bool BAR_INSIDE = false;
    DI const stat_t* stat_src() const { return stat_in; }
    DI bool operator()(Acc& acc, const Unit& u, int wr, int wc, int fr, int fq) const {
        asm volatile("" : "+v"(fr), "+v"(fq));
        const int row0 = u.pm * 256 + wr * 64 + fr, tile = u.pn;
        float rs[2][4]; load_rs_lds(stat_in != nullptr, u.sp, wr * 64 + fr, 1.0f / D, dsc, rs);
        if ((EMASK & 1) && tile < 4) {
            float ss[2][4];
#pragma unroll
            for (int ai = 0; ai < 2; ++ai)
#pragma unroll
                for (int m = 0; m < 4; ++m) { const int row = row0 + ai * 128 + m * 16; const float rsv = rs[ai][m]; float s = 0.f;
#pragma unroll
                    for (int bj = 0; bj < 2; ++bj) { const f32x4 v0 = acc[ai][bj][m][0] * rsv, v1 = acc[ai][bj][m][1] * rsv;
                        s += (v0[0] * v0[0] + v0[1] * v0[1]) + (v0[2] * v0[2] + v0[3] * v0[3]) + (v1[0] * v1[0] + v1[1] * v1[1]) + (v1[2] * v1[2] + v1[3] * v1[3]);
                        if constexpr (F8_B) *(u32x2*)((unsigned char*)ZC + (size_t)row * 1024 + tile * 256 + bj * 128 + wc * 32 + 8 * fq) = pack8_fp8(v0 * F8_SZ, v1 * F8_SZ);
                        else *(u32x4*)(ZC + (size_t)row * 1024 + tile * 256 + bj * 128 + wc * 32 + 8 * fq) = pack8(v0, v1); }
                    ss[ai][m] = s; }
            stat_atomics(ss, tile < 2 ? stat_cq : stat_ckv, row0, fq);
        } else if ((EMASK & 2) && tile == 4) {
            if (wc == 0) {
#pragma unroll
                for (int ai = 0; ai < 2; ++ai)
#pragma unroll
                    for (int m = 0; m < 4; ++m) { const int row = row0 + ai * 128 + m * 16; const float rsv = rs[ai][m]; const f32x2* cs = cs64 + (size_t)row * 32 + 8 * fq;
                        f32x4 o1[2], o2[2];
#pragma unroll
                        for (int n = 0; n < 2; ++n)
#pragma unroll
                            for (int e = 0; e < 4; ++e) { const f32x2 c = cs[4 * n + e]; const float x1 = acc[ai][0][m][n][e] * rsv, x2 = acc[ai][1][m][n][e] * rsv;
                                o1[n][e] = x1 * c.x - x2 * c.y; o2[n][e] = x2 * c.x + x1 * c.y; }
                        *(u32x4*)(KPE + (size_t)row * 64 + 8 * fq) = pack8(o1[0], o1[1]);
                        *(u32x4*)(KPE + (size_t)row * 64 + 32 + 8 * fq) = pack8(o2[0], o2[1]); }
            }
        } else if ((EMASK & 4) && tile < 10) {
            const int tt = tile - 5, hd = 2 * tt + (wc >> 1), dl0 = (32 * wc + 8 * fq) & 63;
            f32x4 cs1[2], cs2[2];
#pragma unroll
            for (int n = 0; n < 2; ++n) { cs1[n] = (f32x4){0.f, 0.f, 0.f, 0.f}; cs2[n] = (f32x4){0.f, 0.f, 0.f, 0.f}; }
#pragma unroll
            for (int ai = 0; ai < 2; ++ai)
#pragma unroll
                for (int m = 0; m < 4; ++m) { const int row = row0 + ai * 128 + m * 16; const float rsv = rs[ai][m]; const f32x2* cs = cs128 + (size_t)row * 64 + dl0;
                    f32x4 o1[2], o2[2];
#pragma unroll
                    for (int n = 0; n < 2; ++n)
#pragma unroll
                        for (int e = 0; e < 4; ++e) { const f32x2 c = cs[4 * n + e]; const float x1 = acc[ai][0][m][n][e] * rsv, x2 = acc[ai][1][m][n][e] * rsv;
                            o1[n][e] = x1 * c.x - x2 * c.y; o2[n][e] = x2 * c.x + x1 * c.y; }
                    *(u32x4*)(MQK + (size_t)row * 1280 + hd * 128 + dl0) = pack8(o1[0], o1[1]);
                    *(u32x4*)(MQK + (size_t)row * 1280 + hd * 128 + 64 + dl0) = pack8(o2[0], o2[1]);
                    cs1[0] += o1[0]; cs1[1] += o1[1]; cs2[0] += o2[0]; cs2[1] += o2[1]; }
            if (hd >= 5) {
                float* kd = ksum + ((size_t)u.pm * 5 + (hd - 5)) * 128 + dl0;
#pragma unroll
                for (int n = 0; n < 2; ++n)
#pragma unroll
                    for (int e = 0; e < 4; ++e) { float a = cs1[n][e], b = cs2[n][e];
                        a += swz_xor<1>(a); b += swz_xor<1>(b); a += swz_xor<2>(a); b += swz_xor<2>(b); a += swz_xor<4>(a); b += swz_xor<4>(b); a += swz_xor<8>(a); b += swz_xor<8>(b);
                        if (fr == 0) { atomic_addf(kd + 4 * n + e, a); atomic_addf(kd + 64 + 4 * n + e, b); } }
            }
        } else if ((EMASK & 8) && tile < 20) {
#pragma unroll
            for (int ai = 0; ai < 2; ++ai)
#pragma unroll
                for (int m = 0; m < 4; ++m) { const int row = row0 + ai * 128 + m * 16; const float rsv = rs[ai][m];
#pragma unroll
                    for (int bj = 0; bj < 2; ++bj)
                        *(u32x4*)(PL + (size_t)row * 2560 + (tile - 10) * 256 + bj * 128 + wc * 32 + 8 * fq) = pack8(acc[ai][bj][m][0] * rsv, acc[ai][bj][m][1] * rsv); }
        } else if (EMASK & 16) {
            unsigned char* G8 = (unsigned char*)G;
#pragma unroll
            for (int ai = 0; ai < 2; ++ai)
#pragma unroll
                for (int m = 0; m < 4; ++m) { const int row = row0 + ai * 128 + m * 16; const float rsn = rs[ai][m] * -LOG2E;
#pragma unroll
                    for (int bj = 0; bj < 2; ++bj) { unsigned q[8];
#pragma unroll
                        for (int e = 0; e < 8; ++e) { const float t = acc[ai][bj][m][e >> 2][e & 3] * rsn;
                            q[e] = __float_as_uint(fmaxf(__builtin_fmaf(fast_rcp(1.0f + fast_exp2(t)), 255.0f, 8388608.0f), 8388609.0f)); }
                        u32x2 w; w.x = __builtin_amdgcn_perm(__builtin_amdgcn_perm(q[3], q[2], 0x0c0c0400u), __builtin_amdgcn_perm(q[1], q[0], 0x0c0c0400u), 0x05040100u);
                        w.y = __builtin_amdgcn_perm(__builtin_amdgcn_perm(q[7], q[6], 0x0c0c0400u), __builtin_amdgcn_perm(q[5], q[4], 0x0c0c0400u), 0x05040100u);
                        *(u32x2*)(G8 + (size_t)row * 6144 + (tile - 20) * 256 + bj * 128 + wc * 32 + 8 * fq) = w; } }
        }
        return false;
    }
};

struct EpiPlain {
    bf16_t* O; int ldo; const stat_t* stat; float inv_n; float osc;
    static constexpr bool BAR_INSIDE = false;
    DI const stat_t* stat_src() const { return stat; }
    DI bool operator()(Acc& acc, const Unit& u, int wr, int wc, int fr, int fq) const {
        asm volatile("" : "+v"(fr), "+v"(fq));
        const int row0 = u.pm * 256 + wr * 64 + fr;
        float rs[2][4]; load_rs_lds(stat != nullptr, u.sp, wr * 64 + fr, inv_n, osc, rs);
#pragma unroll
        for (int ai = 0; ai < 2; ++ai)
#pragma unroll
            for (int m = 0; m < 4; ++m) { const int row = row0 + ai * 128 + m * 16; const float r = rs[ai][m];
#pragma unroll
                for (int bj = 0; bj < 2; ++bj)
                    *(u32x4*)(O + (size_t)row * ldo + u.pn * 256 + bj * 128 + wc * 32 + 8 * fq) = pack8(acc[ai][bj][m][0] * r, acc[ai][bj][m][1] * r); }
        return false;
    }
};

struct EpiMoeDown {
    bf16_t* YS; bf16_t* YP; int tail_row0; size_t slab; float osc;
    static constexpr bool BAR_INSIDE = false;
    DI const stat_t* stat_src() const { return nullptr; }
    DI bool operator()(Acc& acc, const Unit& u, int wr, int wc, int fr, int fq) const {
        asm volatile("" : "+v"(fr), "+v"(fq));
        const int row0 = u.pm * 256 + wr * 64 + fr;
        bf16_t* O = u.aux ? YP + (size_t)(u.aux - 1) * slab - (size_t)tail_row0 * D : YS;
#pragma unroll
        for (int ai = 0; ai < 2; ++ai)
#pragma unroll
            for (int m = 0; m < 4; ++m) { const int row = row0 + ai * 128 + m * 16;
#pragma unroll
                for (int bj = 0; bj < 2; ++bj)
                    *(u32x4*)(O + (size_t)row * D + u.pn * 256 + bj * 128 + wc * 32 + 8 * fq) = pack8(acc[ai][bj][m][0] * osc, acc[ai][bj][m][1] * osc); }
        return false;
    }
};

struct EpiUQ {
    bf16_t* QA; const stat_t* stat; const f32x2* cs64; float dsc;
    static constexpr bool BAR_INSIDE = false;
    DI const stat_t* stat_src() const { return stat; }
    DI bool operator()(Acc& acc, const Unit& u, int wr, int wc, int fr, int fq) const {
        asm volatile("" : "+v"(fr), "+v"(fq));
        const int row0 = u.pm * 256 + wr * 64 + fr, tile = u.pn;
        float rs[2][4]; load_rs_lds(stat != nullptr, u.sp, wr * 64 + fr, 1.0f / 512, dsc, rs);
        if (tile < 3) {
#pragma unroll
            for (int ai = 0; ai < 2; ++ai)
#pragma unroll
                for (int m = 0; m < 4; ++m) { const int row = row0 + ai * 128 + m * 16; const float r = rs[ai][m];
#pragma unroll
                    for (int bj = 0; bj < 2; ++bj) { const int h = tile * 2 + bj;
                        *(u32x4*)(QA + (size_t)row * 1152 + h * 192 + wc * 32 + 8 * fq) = pack8(acc[ai][bj][m][0] * r, acc[ai][bj][m][1] * r); } }
        } else { const int h = (tile - 3) * 4 + wc;
            if (h < 6) {
#pragma unroll
                for (int g = 0; g < 4; ++g) { const int ai = g >> 1, mb = (g & 1) * 2;
                    f32x4 cs[2][4];
#pragma unroll
                    for (int mm = 0; mm < 2; ++mm) { const f32x4* cp = (const f32x4*)(cs64 + (size_t)(row0 + ai * 128 + (mb + mm) * 16) * 32 + 8 * fq);
#pragma unroll
                        for (int q = 0; q < 4; ++q) cs[mm][q] = cp[q]; }
#pragma unroll
                    for (int mm = 0; mm < 2; ++mm) { const int m = mb + mm; const int row = row0 + ai * 128 + m * 16; const float r = rs[ai][m]; f32x4 o1[2], o2[2];
#pragma unroll
                        for (int n = 0; n < 2; ++n)
#pragma unroll
                            for (int e = 0; e < 4; ++e) { const f32x4 cc = cs[mm][2 * n + (e >> 1)]; const float c = cc[2 * (e & 1)], sn = cc[2 * (e & 1) + 1];
                                const float x1 = acc[ai][0][m][n][e] * r, x2 = acc[ai][1][m][n][e] * r; o1[n][e] = x1 * c - x2 * sn; o2[n][e] = x2 * c + x1 * sn; }
                        *(u32x4*)(QA + (size_t)row * 1152 + h * 192 + 128 + 8 * fq) = pack8(o1[0], o1[1]);
                        *(u32x4*)(QA + (size_t)row * 1152 + h * 192 + 160 + 8 * fq) = pack8(o2[0], o2[1]); }
                    asm volatile("" ::: "memory"); } } }
        return false;
    }
};

struct EpiUp {
    const unsigned char* G; bf16_t* MERGED;
    static constexpr bool BAR_INSIDE = true;
    DI const stat_t* stat_src() const { return nullptr; }
    DI bool operator()(Acc& acc, const Unit& u, int wr, int wc, int fr, int fq) const {
        asm volatile("" : "+v"(fr), "+v"(fq));
        const int row0 = u.pm * 256 + wr * 64 + fr, br = u.aux; const int col0 = u.pn * 256 + wc * 32 + 8 * fq;
        const bool fin = br == 2; const int gboff = fin ? 0 : 2048; const float bs = (F8_DUP && br == 1) ? F8_SO * F8_SW : 1.0f;
        u32x2 ga[2][4][2], gb[2][4][2];
#pragma unroll
        for (int ai = 0; ai < 2; ++ai)
#pragma unroll
            for (int m = 0; m < 4; ++m)
#pragma unroll
                for (int bj = 0; bj < 2; ++bj) { const unsigned char* gp = G + (size_t)(row0 + ai * 128 + m * 16) * 6144 + br * 2048 + col0 + bj * 128; ga[ai][m][bj] = *(const u32x2*)gp; gb[ai][m][bj] = *(const u32x2*)(gp + gboff); }
        if (u.bar) { asm volatile("" ::: "memory"); __builtin_amdgcn_s_barrier(); asm volatile("" ::: "memory"); }
#pragma unroll
        for (int ai = 0; ai < 2; ++ai)
#pragma unroll
            for (int m = 0; m < 4; ++m)
#pragma unroll
                for (int bj = 0; bj < 2; ++bj) {
#pragma unroll
                    for (int q = 0; q < 2; ++q) { const unsigned a = ga[ai][m][bj][q], b = gb[ai][m][bj][q];
                        const float d0 = fin ? (1.0f / 255.0f) : fast_rcp(ubf<0>(b) * bs), d1 = fin ? (1.0f / 255.0f) : fast_rcp(ubf<1>(b) * bs),
                                    d2 = fin ? (1.0f / 255.0f) : fast_rcp(ubf<2>(b) * bs), d3 = fin ? (1.0f / 255.0f) : fast_rcp(ubf<3>(b) * bs);
                        acc[ai][bj][m][q][0] *= ubf<0>(a) * d0; acc[ai][bj][m][q][1] *= ubf<1>(a) * d1;
                        acc[ai][bj][m][q][2] *= ubf<2>(a) * d2; acc[ai][bj][m][q][3] *= ubf<3>(a) * d3; }
                    if (fin) *(u32x4*)(MERGED + (size_t)(row0 + ai * 128 + m * 16) * D + col0 + bj * 128) = pack8(acc[ai][bj][m][0], acc[ai][bj][m][1]); }
        return !fin;
    }
};

struct EpiRes {
    bf16_t* HB; stat_t* stat; unsigned char* HB8; float dsc;
    static constexpr bool BAR_INSIDE = true;
    DI const stat_t* stat_src() const { return nullptr; }
    DI bool operator()(Acc& acc, const Unit& u, int wr, int wc, int fr, int fq) const {
        asm volatile("" : "+v"(fr), "+v"(fq));
        const int row0 = u.pm * 256 + wr * 64 + fr; float ss[2][4]; const int col0 = u.pn * 256 + wc * 32 + 8 * fq;
#pragma unroll
        for (int ai = 0; ai < 2; ++ai) {
            u32x4 h[4][2];
#pragma unroll
            for (int m = 0; m < 4; ++m)
#pragma unroll
                for (int bj = 0; bj < 2; ++bj) h[m][bj] = *(const u32x4*)(HB + (size_t)(row0 + ai * 128 + m * 16) * D + col0 + bj * 128);
            if (ai == 0 && u.bar) { asm volatile("" ::: "memory"); __builtin_amdgcn_s_barrier(); asm volatile("" ::: "memory"); }
#pragma unroll
            for (int m = 0; m < 4; ++m) { float s = 0.f;
#pragma unroll
                for (int bj = 0; bj < 2; ++bj) { const size_t off = (size_t)(row0 + ai * 128 + m * 16) * D + col0 + bj * 128; const u32x4 hw = h[m][bj];
                    const f32x4 v0 = (f32x4){bf_lo(hw[0]), bf_hi(hw[0]), bf_lo(hw[1]), bf_hi(hw[1])} + acc[ai][bj][m][0] * dsc, v1 = (f32x4){bf_lo(hw[2]), bf_hi(hw[2]), bf_lo(hw[3]), bf_hi(hw[3])} + acc[ai][bj][m][1] * dsc;
                    *(u32x4*)(HB + off) = pack8(v0, v1);
                    if (HB8) *(u32x2*)(HB8 + off) = pack8_fp8(v0 * F8_SA, v1 * F8_SA);
                    s += (v0[0] * v0[0] + v0[1] * v0[1]) + (v0[2] * v0[2] + v0[3] * v0[3]) + (v1[0] * v1[0] + v1[1] * v1[1]) + (v1[2] * v1[2] + v1[3] * v1[3]); }
                ss[ai][m] = s; }
            asm volatile("" ::: "memory"); }
        stat_atomics(ss, stat, row0, fq);
        return false;
    }
};

template <bool F8> struct EpiSwiglu {
    void* Ov; int ldo; const stat_t* stat; float dsc;
    static constexpr bool BAR_INSIDE = false;
    DI const stat_t* stat_src() const { return stat; }
    DI bool operator()(Acc& acc, const Unit& u, int wr, int wc, int fr, int fq) const {
        asm volatile("" : "+v"(fr), "+v"(fq));
        const int row0 = u.pm * 256 + wr * 64 + fr;
        float rs[2][4]; load_rs_lds(stat != nullptr, u.sp, wr * 64 + fr, 1.0f / D, dsc, rs);
#pragma unroll
        for (int ai = 0; ai < 2; ++ai)
#pragma unroll
            for (int m = 0; m < 4; ++m) { const int row = row0 + ai * 128 + m * 16; const float r = rs[ai][m];
                f32x4 o[2]; const float rn = r * -LOG2E, rb = r * (F8 ? F8_SA : 1.0f);
#pragma unroll
                for (int n = 0; n < 2; ++n) { const f32x4 a = acc[ai][0][m][n] * r, t = acc[ai][0][m][n] * rn, b = acc[ai][1][m][n] * rb; f32x4 sg;
#pragma unroll
                    for (int e = 0; e < 4; ++e) sg[e] = fast_rcp(1.0f + fast_exp2(t[e]));
                    o[n] = (a * sg) * b; }
                if constexpr (F8) *(u32x2*)((unsigned char*)Ov + (size_t)row * ldo + u.pn * 128 + wc * 32 + 8 * fq) = pack8_fp8(o[0], o[1]);
                else *(u32x4*)((bf16_t*)Ov + (size_t)row * ldo + u.pn * 128 + wc * 32 + 8 * fq) = pack8(o[0], o[1]); }
        return false;
    }
};

struct EpiXS {
    bf16_t* PX; LAS float* scr; const stat_t* stat; float dsc; float p8;
    static constexpr bool BAR_INSIDE = false;
    DI const stat_t* stat_src() const { return stat; }
    DI bool operator()(Acc& acc, const Unit& u, int wr, int wc, int fr, int fq) const {
        asm volatile("" : "+v"(fr), "+v"(fq));
        const int row0 = u.pm * 256 + wr * 64 + fr;
        { float rs[2][4]; load_rs_lds(stat != nullptr, u.sp, wr * 64 + fr, 1.0f / D, dsc, rs);
#pragma unroll
        for (int ai = 0; ai < 2; ++ai)
#pragma unroll
            for (int m = 0; m < 4; ++m)
#pragma unroll
                for (int bj = 0; bj < 2; ++bj) { acc[ai][bj][m][0] *= rs[ai][m]; acc[ai][bj][m][1] *= rs[ai][m]; } }
        asm volatile("" ::: "memory");
#pragma unroll
        for (int ai = 0; ai < 2; ++ai)
#pragma unroll
            for (int m = 0; m < 4; ++m) { float v = -3.0e38f;
#pragma unroll
                for (int bj = 0; bj < 2; ++bj)
#pragma unroll
                    for (int n = 0; n < 2; ++n)
#pragma unroll
                        for (int e = 0; e < 4; ++e) v = fmaxf(v, acc[ai][bj][m][n][e]);
                v = fmaxf(v, swz_xor<16>(v)); v = half_max(v);
                if (fq == 0) scr[(ai * 128 + wr * 64 + m * 16 + fr) * 4 + wc] = v; }
        asm volatile("s_waitcnt lgkmcnt(0)" ::: "memory"); __builtin_amdgcn_s_barrier(); asm volatile("" ::: "memory");
#pragma unroll
        for (int ai = 0; ai < 2; ++ai)
#pragma unroll
            for (int m = 0; m < 4; ++m) { const f32x4 q = *(const LAS f32x4*)(scr + (ai * 128 + wr * 64 + m * 16 + fr) * 4);
                const float mxr = fmaxf(fmaxf(q[0], q[1]), fmaxf(q[2], q[3])); float s = 0.f;
#pragma unroll
                for (int bj = 0; bj < 2; ++bj)
#pragma unroll
                    for (int n = 0; n < 2; ++n)
#pragma unroll
                        for (int e = 0; e < 4; ++e) { const float p = fast_exp2(acc[ai][bj][m][n][e] - mxr); acc[ai][bj][m][n][e] = p; s += p; }
                s += swz_xor<16>(s); s = half_sum(s);
                if (fq == 0) scr[1024 + (ai * 128 + wr * 64 + m * 16 + fr) * 4 + wc] = s; }
        asm volatile("s_waitcnt lgkmcnt(0)" ::: "memory"); __builtin_amdgcn_s_barrier(); asm volatile("" ::: "memory");
#pragma unroll
        for (int ai = 0; ai < 2; ++ai)
#pragma unroll
            for (int m = 0; m < 4; ++m) { const int row = row0 + ai * 128 + m * 16; const f32x4 q = *(const LAS f32x4*)(scr + 1024 + (ai * 128 + wr * 64 + m * 16 + fr) * 4);
                const float inv = (p8 > 0.f ? p8 : 1.0f) / ((q[0] + q[1]) + (q[2] + q[3]));
#pragma unroll
                for (int bj = 0; bj < 2; ++bj) {
                    if (p8 > 0.f) *(u32x2*)((unsigned char*)PX + (size_t)row * 1024 + u.pn * 256 + bj * 128 + wc * 32 + 8 * fq) = pack8_fp8(acc[ai][bj][m][0] * inv, acc[ai][bj][m][1] * inv);
                    else *(u32x4*)(PX + (size_t)row * 1024 + u.pn * 256 + bj * 128 + wc * 32 + 8 * fq) = pack8(acc[ai][bj][m][0] * inv, acc[ai][bj][m][1] * inv); } }
        return false;
    }
};
}

namespace pg8 {
struct SchedUp {
    const char* A; const char* Bt; int G, c;
    DI bool next(int i, Unit& u) const {
        const int tr = i / 3, br = i - 3 * tr; const long L = (long)tr * G + c; if (L >= 64 * 8) return false;
        tile_order((int)L, 64, 8, u.pm, u.pn); u.aux = br;
        if (F8_DUP) { u.nt = br == 2 ? 10 : 6; const int kb = br == 0 ? 0 : (br == 1 ? 768 : 2816);
            u.a = A + (size_t)u.pm * 256 * D * 2 + kb; u.b = Bt + (size_t)u.pn * 256 * D * 2 + kb; return true; }
        u.nt = br == 0 ? 12 : 10;
        const int koff = br == 0 ? 0 : (br == 1 ? 768 : 1408);
        u.a = A + ((size_t)u.pm * 256 * D + koff) * 2; u.b = Bt + ((size_t)u.pn * 256 * D + koff) * 2; return true;
    }
};
struct SchedXS {
    const char* QX; const char* KM; int G, c;
    DI bool next(int i, Unit& u) const {
        const long L = (long)i * G + c; if (L >= 256) return false;
        const int hd = (int)L & 3, rt = (int)L >> 2;
        u.pm = rt; u.pn = hd; u.aux = 0; u.nt = 8;
        u.a = QX + ((size_t)rt * 256 * D + hd * 512) * 2; u.b = KM + ((size_t)(rt >> 4) * 256 * D + hd * 512) * 2; return true;
    }
};
struct SchedXPV {
    const char* PX; const char* VT; int G, c;
    DI bool next(int i, Unit& u) const {
        const long L = (long)i * G + c; if (L >= 512) return false;
        const int pn = (int)L & 7, rt = (int)L >> 3;
        u.pm = rt; u.pn = pn; u.aux = 0; u.nt = 4;
        u.a = PX + ((size_t)rt * 256 * 1024 + (pn >> 1) * 256) * 2; u.b = VT + ((size_t)pn * 256 * 1024 + (rt >> 4) * 256) * 2; return true;
    }
};
struct MoeTail { int nused, nb_main, f; };
DI MoeTail moe_tail_plan(const unsigned* counts, int G) {
    int b = 0;
#pragma unroll
    for (int e = 0; e < 8; ++e) { const unsigned cnt = __hip_atomic_load(counts + 64 * e, __ATOMIC_RELAXED, __HIP_MEMORY_SCOPE_AGENT); b += (int)((cnt + 255u) >> 8); }
    MoeTail p; p.nused = b; p.nb_main = b; p.f = 1;
    if (MOE_TAIL && F8_MOE && (G & 7) == 0) { const int total = b * 8, nfull = (total / G) * G, R = total - nfull;
        const int f = R == 0 ? 1 : (R * 14 <= G ? 14 : (R * 7 <= G ? 7 : (R * 4 <= G ? 4 : (R * 2 <= G ? 2 : 1))));
        if (f > 1) { p.f = f; p.nb_main = nfull / 8; } }
    return p;
}
struct SchedMoE {
    const char* A; const char* Bt; int lda, nN, nt, G, c; size_t wstride; int nused; int bend[8];
    DI void init_counts(const unsigned* counts) { int b = 0;
#pragma unroll
        for (int e = 0; e < 8; ++e) { const unsigned cnt = __hip_atomic_load(counts + 64 * e, __ATOMIC_RELAXED, __HIP_MEMORY_SCOPE_AGENT); b += (int)((cnt + 255u) >> 8); bend[e] = b; }
        nused = b; }
    DI bool next(int i, Unit& u) const {
        const long L = (long)i * G + c; if (L >= (long)nused * nN) return false;
        tile_order((int)L, nused, nN, u.pm, u.pn); u.aux = 0; u.nt = nt;
        int e = 0;
#pragma unroll
        for (int q = 0; q < 7; ++q) e += (u.pm >= bend[q]) ? 1 : 0;
        u.a = A + (size_t)u.pm * 256 * lda; u.b = Bt + (size_t)e * wstride + (size_t)u.pn * 256 * (size_t)(nt * 128); return true;
    }
};
struct SchedMoEDown {
    const char* A; const char* Bt; int lda, G, c; size_t wstride; int nused, nb_main, f; int bend[8];
    DI void init_counts(const unsigned* counts) { int b = 0;
#pragma unroll
        for (int e = 0; e < 8; ++e) { const unsigned cnt = __hip_atomic_load(counts + 64 * e, __ATOMIC_RELAXED, __HIP_MEMORY_SCOPE_AGENT); b += (int)((cnt + 255u) >> 8); bend[e] = b; }
        const MoeTail p = moe_tail_plan(counts, G); nused = p.nused; nb_main = p.nb_main; f = p.f; }
    DI bool next(int i, Unit& u) const {
        const long L = (long)i * G + c; const int nmain = nb_main * 8; int koff = 0;
        if (L < nmain) { tile_order((int)L, nb_main, 8, u.pm, u.pn); u.aux = 0; u.nt = 56; }
        else { const int s_ = (int)(L - nmain), R = (nused - nb_main) * 8; if (s_ >= R * f) return false;
            const int j = s_ / R, t = s_ - j * R; u.pm = nb_main + (t >> 3); u.pn = t & 7; u.aux = j; u.nt = 56 / f; koff = j * u.nt * 128; }
        int e = 0;
#pragma unroll
        for (int q = 0; q < 7; ++q) e += (u.pm >= bend[q]) ? 1 : 0;
        u.a = A + (size_t)u.pm * 256 * lda + koff; u.b = Bt + (size_t)e * wstride + (size_t)u.pn * 256 * (size_t)lda + koff; return true;
    }
};
}

struct Params {
    const float* x; const float* mem; const int* positions;
    const float *g_mix, *w_in, *g_cq, *g_ckv, *w_uq, *w_ukv, *w_up_a, *w_up_b, *w_up_c, *w_o, *g_x, *g_mem, *w_xq, *w_xk, *w_xv, *w_xo, *g_ffn, *w_ff1, *w_ff3, *w_ff2, *w_router, *w_e1, *w_e3, *w_e2, *g_final;
    float* out; unsigned char* ws; int ph_lo, ph_hi;
};
struct Frame { LAS unsigned char* lds; int tid, lane, wave, G, bid; };
typedef const __attribute__((address_space(4))) Params* KPtr;
#define KP_HERE KPtr kp = (KPtr)__builtin_amdgcn_kernarg_segment_ptr(); asm volatile("" : "+s"(kp));
#define FRAME_HERE Frame F; { int w_ = wave_id_; asm volatile("" : "+s"(w_)); int t_ = w_ * 64 + lane_id_now(), b_ = blockIdx.x, g_ = gridDim.x; asm volatile("" : "+v"(t_)); asm volatile("" : "+s"(b_), "+s"(g_)); \
        F.lds = (LAS unsigned char*)lds_; F.tid = t_; F.lane = t_ & 63; F.wave = __builtin_amdgcn_readfirstlane(t_ >> 6); F.G = g_; F.bid = b_; }


template <bool F8, class Map>
DI void transpose_cvt(const Frame& F, const float* __restrict__ W, int ldw, int K, void* __restrict__ dstv, int ldd, int koff, int ngroups, const float* __restrict__ gain, Map map, int& rot) {
    bf16_t* dst = (bf16_t*)dstv; unsigned char* dst8 = (unsigned char*)dstv;
    LAS float* scr = (LAS float*)(F.lds + F.wave * 17408);
    const int NGW = F.G * NWAVES, gw = F.bid * NWAVES + F.wave, lane = F.lane;
    if (F8 && (K & 127) == 0) {
        const int items8 = (K / 128) * ngroups, c8 = lane & 7, nl = lane >> 3;
        int it8 = gw - rot; if (it8 < 0) it8 += NGW;
        for (; it8 < items8; it8 += NGW) {
            const int kb = it8 / ngroups, ng = it8 - kb * ngroups, k0 = kb * 128;
            int src; float sc; map(ng, src, sc);
            if (src == -2) continue;
            if (src < 0) {
#pragma unroll
                for (int j = 0; j < 4; ++j) *(u32x4*)(dst8 + (size_t)(ng * 32 + nl + 8 * j) * ldd + koff + k0 + 16 * c8) = (u32x4){0u, 0u, 0u, 0u};
                continue;
            }
            f32x4 v[16];
#pragma unroll
            for (int i = 0; i < 16; ++i) v[i] = *(const f32x4*)(W + (size_t)(k0 + 8 * i + nl) * ldw + src + 4 * c8);
#pragma unroll
            for (int i = 0; i < 16; ++i) { const float g = (gain ? gain[k0 + 8 * i + nl] : 1.0f) * sc;
                LAS float* sp = scr + (8 * (i >> 1) + nl + 64 * (i & 1)) * 33 + 4 * c8; sp[0] = v[i][0] * g; sp[1] = v[i][1] * g; sp[2] = v[i][2] * g; sp[3] = v[i][3] * g; }
            asm volatile("s_waitcnt lgkmcnt(0)" ::: "memory");
#pragma unroll
            for (int j = 0; j < 4; ++j) { const int n = nl + 8 * j; const LAS float* sp = scr + (8 * c8) * 33 + n; const LAS float* sq = sp + 64 * 33; u32x4 o;
                o.x = pk_fp8x4(sp[0 * 33], sp[1 * 33], sp[2 * 33], sp[3 * 33]); o.y = pk_fp8x4(sp[4 * 33], sp[5 * 33], sp[6 * 33], sp[7 * 33]);
                o.z = pk_fp8x4(sq[0 * 33], sq[1 * 33], sq[2 * 33], sq[3 * 33]); o.w = pk_fp8x4(sq[4 * 33], sq[5 * 33], sq[6 * 33], sq[7 * 33]);
                *(u32x4*)(dst8 + (size_t)(ng * 32 + n) * ldd + koff + k0 + 16 * c8) = o; }
            asm volatile("s_waitcnt lgkmcnt(0)" ::: "memory");
        }
        rot = (rot + items8) % NGW;
        return;
    }
    const int items = (K / 64) * ngroups;
    int it = gw - rot; if (it < 0) it += NGW;
    for (; it < items; it += NGW) {
        int kb, ng; if (F8 && !((K / 64) & 1) && !(rot & 1)) { const int pi = it >> 1, kp = pi / ngroups; ng = pi - kp * ngroups; kb = 2 * kp + (it & 1); } else { kb = it / ngroups; ng = it - kb * ngroups; }
        const int k0 = kb * 64;
        int src; float sc; map(ng, src, sc);
        const int c8 = lane & 7;
        if (src == -2) continue;
        if (src < 0) {
#pragma unroll
            for (int j = 0; j < 4; ++j) { const int n = (lane >> 3) + 8 * j; if constexpr (F8) *(u32x2*)(dst8 + (size_t)(ng * 32 + n) * ldd + koff + k0 + 8 * c8) = (u32x2){0u, 0u}; else *(u32x4*)(dst + (size_t)(ng * 32 + n) * ldd + koff + k0 + 8 * c8) = (u32x4){0u, 0u, 0u, 0u}; }
            continue;
        }
        f32x4 v[8];
#pragma unroll
        for (int i = 0; i < 8; ++i) { const int kk = 8 * i + (lane >> 3); v[i] = *(const f32x4*)(W + (size_t)(k0 + kk) * ldw + src + 4 * c8); }
#pragma unroll
        for (int i = 0; i < 8; ++i) { const int kk = 8 * i + (lane >> 3); const float g = (gain ? gain[k0 + kk] : 1.0f) * sc;
            LAS float* s = scr + kk * 33 + 4 * c8; s[0] = v[i][0] * g; s[1] = v[i][1] * g; s[2] = v[i][2] * g; s[3] = v[i][3] * g; }
        asm volatile("s_waitcnt lgkmcnt(0)" ::: "memory");
#pragma unroll
        for (int j = 0; j < 4; ++j) { const int n = (lane >> 3) + 8 * j; const LAS float* s = scr + (8 * c8) * 33 + n;
            if constexpr (F8) { u32x2 o; o.x = pk_fp8x4(s[0 * 33], s[1 * 33], s[2 * 33], s[3 * 33]); o.y = pk_fp8x4(s[4 * 33], s[5 * 33], s[6 * 33], s[7 * 33]);
                *(u32x2*)(dst8 + (size_t)(ng * 32 + n) * ldd + koff + k0 + 8 * c8) = o; }
            else { u32x4 o; o.x = cvt_pk_bf16(s[0 * 33], s[1 * 33]); o.y = cvt_pk_bf16(s[2 * 33], s[3 * 33]); o.z = cvt_pk_bf16(s[4 * 33], s[5 * 33]); o.w = cvt_pk_bf16(s[6 * 33], s[7 * 33]);
                *(u32x4*)(dst + (size_t)(ng * 32 + n) * ldd + koff + k0 + 8 * c8) = o; } }
        asm volatile("s_waitcnt lgkmcnt(0)" ::: "memory");
    }
    rot = (rot + items) % NGW;
}

DI void prologue(const Frame& F, KPtr kp) {
    unsigned char* ws = kp->ws; int rot = 0;
    const float QS128 = 0.08838834764831845f * LOG2E, QS192 = 0.07216878364870322f * LOG2E, QS512 = 0.04419417382415922f * LOG2E;
    for (int l = 0; l < 2; ++l) {
        if (F8_GATES) transpose_cvt<true>(F, kp->w_in + (size_t)l * D * IN_COLS, IN_COLS, D, ws + WS_WING8 + (size_t)l * 6144 * D, D, 0, 6144 / 32, kp->g_mix + l * D,
            [=](int ng, int& src, float& sc) { sc = F8_SW; src = 4928 + ng * 32; }, rot);
        auto win_map = [=](int ng, int& src, float& sc) { sc = 1.0f; const int n = ng * 32;
                if (n < 1024) { src = n; }
                else if (n < 1280) { const int p = n - 1024; src = (p == 0) ? 1024 : (p == 128 ? 1056 : -1); }
                else if (n < 2560) { const int tt = (n - 1280) >> 8, p = (n - 1280) & 255, bj = p >> 7, pp = p & 127, hd = 2 * tt + (pp >> 6), d = (pp & 63) + 64 * bj; src = 1088 + hd * 128 + d; if (hd < 5) sc = QS128; }
                else if (n < 5120) { src = 2368 + (n - 2560); if (src >= 3008 && src < 3648) sc = QS128; }
                else { src = 4928 + (n - 5120); } };
        constexpr int NG8 = (F8_AMM && F8_GATES) ? A8_TILES * 256 / 32 : 0;
        if (NG8) transpose_cvt<true>(F, kp->w_in + (size_t)l * D * IN_COLS, IN_COLS, D, ws + WS_WIN8X + l * SZ_WE13, D, 0, NG8, kp->g_mix + l * D,
            [=](int ng, int& src, float& sc) { win_map(ng, src, sc); sc *= F8_SW; }, rot);
        transpose_cvt<false>(F, kp->w_in + (size_t)l * D * IN_COLS, IN_COLS, D, (bf16_t*)(ws + WS_WIN + l * SZ_WIN) + (size_t)NG8 * 32 * D, D, 0, (F8_GATES ? 5120 : NIN) / 32 - NG8, kp->g_mix + l * D,
            [=](int ng, int& src, float& sc) { win_map(ng + NG8, src, sc); }, rot);
        transpose_cvt<F8_B>(F, kp->w_uq + (size_t)l * 512 * 1152, 1152, 512, ws + WS_WUQ + l * SZ_WUQ, 512, 0, 1280 / 32, kp->g_cq + l * 512,
            [=](int ng, int& src, float& sc) { sc = F8_B ? QS192 * F8_SW : QS192; const int n = ng * 32;
                if (n < 768) { src = (n >> 7) * 192 + (n & 127); }
                else { const int rt = (n - 768) >> 8, p = (n - 768) & 255, bj = p >> 7, hh = (p & 127) >> 5, h = 4 * rt + hh; src = h < 6 ? h * 192 + 128 + 32 * bj : -1; } }, rot);
        transpose_cvt<F8_B>(F, kp->w_ukv + (size_t)l * 512 * 1536, 1536, 512, ws + WS_WUKV + l * SZ_WUKV, 512, 0, 1536 / 32, kp->g_ckv + l * 512,
            [=](int ng, int& src, float& sc) { sc = F8_B ? F8_SW : 1.0f; src = ng * 32; }, rot);
        bf16_t* wup = (bf16_t*)(ws + WS_WUP + l * SZ_SQ);
        if (F8_DUP) {
            transpose_cvt<true>(F, kp->w_up_a + (size_t)l * 768 * D, D, 768, wup, 2 * D, 0, D / 32, nullptr, [=](int ng, int& src, float& sc) { sc = F8_SW; src = ng * 32; }, rot);
            transpose_cvt<true>(F, kp->w_up_b + (size_t)l * 640 * D, D, 640, wup, 2 * D, 768, D / 32, nullptr, [=](int ng, int& src, float& sc) { sc = F8_SW; src = ng * 32; }, rot);
            transpose_cvt<true>(F, kp->w_up_b + (size_t)l * 640 * D, D, 128, wup, 2 * D, 1408, D / 32, nullptr, [=](int ng, int& src, float& sc) { sc = 1.0f; src = -1; }, rot);
        } else {
        transpose_cvt<false>(F, kp->w_up_a + (size_t)l * 768 * D, D, 768, wup, D, 0, D / 32, nullptr, [=](int ng, int& src, float& sc) { sc = 1.0f; src = ng * 32; }, rot);
        transpose_cvt<false>(F, kp->w_up_b + (size_t)l * 640 * D, D, 640, wup, D, 768, D / 32, nullptr, [=](int ng, int& src, float& sc) { sc = 1.0f; src = ng * 32; }, rot); }
        transpose_cvt<false>(F, kp->w_up_c + (size_t)l * 640 * D, D, 640, wup, D, 1408, D / 32, nullptr, [=](int ng, int& src, float& sc) { sc = 1.0f; src = ng * 32; }, rot);
        transpose_cvt<false>(F, kp->w_o + (size_t)l * D * D, D, D, (bf16_t*)(ws + WS_WO + l * SZ_SQ), D, 0, D / 32, nullptr, [=](int ng, int& src, float& sc) { sc = 1.0f; src = ng * 32; }, rot);
        {
          const float* W = kp->w_xq + (size_t)l * D * D; bf16_t* O = (bf16_t*)(ws + WS_WXQ + l * SZ_SQ); const float* gx = kp->g_x + l * D;
          for (int c = F.bid * NTHR + F.tid; c < D * D / 8; c += F.G * NTHR) { const float g = gx[c >> 8] * (F8_XPRE ? QS512 * F8_SWQ : QS512);
              const f32x4 a = __builtin_nontemporal_load((const f32x4*)(W + (size_t)c * 8)), b = __builtin_nontemporal_load((const f32x4*)(W + (size_t)c * 8 + 4));
              if constexpr (F8_XPRE) *(u32x2*)((unsigned char*)O + (size_t)c * 8) = pack8_fp8(a * g, b * g);
              else *(u32x4*)(O + (size_t)c * 8) = pack8(a * g, b * g); } }
        transpose_cvt<F8_XPRE>(F, kp->w_xk + (size_t)l * D * D, D, D, ws + WS_WXK + l * SZ_SQ, D, 0, D / 32, nullptr, [=](int ng, int& src, float& sc) { sc = F8_XPRE ? F8_SW : 1.0f; src = ng * 32; }, rot);
        transpose_cvt<F8_XPRE>(F, kp->w_xv + (size_t)l * D * D, D, D, ws + WS_WXV + l * SZ_SQ, D, 0, D / 32, nullptr, [=](int ng, int& src, float& sc) { sc = F8_XPRE ? F8_SW : 1.0f; src = ng * 32; }, rot);
        transpose_cvt<F8_XPRE>(F, kp->w_xo + (size_t)l * D * D, D, D, ws + WS_WXO + l * SZ_SQ, D, 0, D / 32, nullptr, [=](int ng, int& src, float& sc) { sc = F8_XPRE ? F8_SW : 1.0f; src = ng * 32; }, rot);
    }
    { unsigned char* w13 = ws + WS_WFF13;
      for (int half = 0; half < 2; ++half) { const float* W = half ? kp->w_ff3 : kp->w_ff1;
        transpose_cvt<F8_DENSE>(F, W, DFF, D, w13, D, 0, NIN / 32, kp->g_ffn,
            [=](int ng, int& src, float& sc) { sc = F8_DENSE ? F8_SW : 1.0f; const int t = ng >> 3, bj = (ng >> 2) & 1, q = ng & 3; src = (bj == half) ? t * 128 + q * 32 : -2; }, rot); }
      transpose_cvt<(F8_DENSE || F8_DDOWN)>(F, kp->w_ff2, D, DFF, ws + WS_WFF2, DFF, 0, D / 32, nullptr, [=](int ng, int& src, float& sc) { sc = (F8_DENSE || F8_DDOWN) ? F8_SW : 1.0f; src = ng * 32; }, rot); }
    for (int e = 0; e < NEXP; ++e) {
        unsigned char* w13 = ws + WS_WE13 + e * SZ_WE13;
        for (int half = 0; half < 2; ++half) { const float* W = (half ? kp->w_e3 : kp->w_e1) + (size_t)e * D * DFE;
            transpose_cvt<F8_MOE>(F, W, DFE, D, w13, D, 0, 2 * DFE / 32, kp->g_ffn + D,
                [=](int ng, int& src, float& sc) { sc = F8_MOE ? F8_SW : 1.0f; const int t = ng >> 3, bj = (ng >> 2) & 1, q = ng & 3; src = (bj == half) ? t * 128 + q * 32 : -2; }, rot); }
        transpose_cvt<F8_MOE>(F, kp->w_e2 + (size_t)e * DFE * D, D, DFE, ws + WS_WE2 + e * SZ_WE2, DFE, 0, D / 32, nullptr, [=](int ng, int& src, float& sc) { sc = F8_MOE ? F8_SW : 1.0f; src = ng * 32; }, rot);
    }
    { f32x2* cs128 = (f32x2*)(ws + WS_CS128); f32x2* cs64 = (f32x2*)(ws + WS_CS64);
      const int gt = F.bid * NTHR + F.tid, NT_ = F.G * NTHR;
      for (int idx = gt; idx < T * 96; idx += NT_) { const int t = idx / 96, q = idx - t * 96;
          const float inv = q < 64 ? powf(10000.0f, -(float)q / 64.0f) : powf(10000.0f, -(float)(q - 64) / 32.0f);
          const float ang = (float)kp->positions[t] * inv;
          const double rev = (double)ang * 0.15915494309189535; const float fr = (float)(rev - floor(rev));
          const f32x2 v = {__builtin_amdgcn_cosf(fr), __builtin_amdgcn_sinf(fr)};
          if (q < 64) cs128[(size_t)t * 64 + q] = v; else cs64[(size_t)t * 32 + (q - 64)] = v; } }
    { const int gw = F.bid * NWAVES + F.wave, NGW = F.G * NWAVES, lane = F.lane;
      stat_t* stat = (stat_t*)((unsigned*)(ws + WS_CTL) + CW_STAT) + (ST_MIX * 2 + 0) * T;
      for (int r = gw; r < T + 1024; r += NGW) {
          const bool is_mem = r >= T; const float* src = is_mem ? kp->mem + (size_t)(r - T) * D : kp->x + (size_t)r * D;
          f32x4 v[8]; float s = 0.f;
#pragma unroll
          for (int j = 0; j < 8; ++j) { v[j] = *(const f32x4*)(src + 4 * lane + 256 * j); s += (v[j][0] * v[j][0] + v[j][1] * v[j][1]) + (v[j][2] * v[j][2] + v[j][3] * v[j][3]); }
          s = wave_sum(s);
          if (!is_mem) { if (lane == 0) stat[r] = (stat_t)(s * STAT_SCALE);
#pragma unroll
              for (int j = 0; j < 8; ++j) {
                  u32x2 w; w.x = cvt_pk_bf16(v[j][0], v[j][1]); w.y = cvt_pk_bf16(v[j][2], v[j][3]); *(u32x2*)((bf16_t*)(ws + WS_HB) + (size_t)r * D + 4 * lane + 256 * j) = w;
                  if (F8_GATES) *(unsigned*)(ws + WS_HB8 + (size_t)r * D + 4 * lane + 256 * j) = pk_fp8x4(v[j][0] * F8_SA, v[j][1] * F8_SA, v[j][2] * F8_SA, v[j][3] * F8_SA); }
          } else { const float rs = 1.0f / sqrtf(s * (1.0f / D) + EPS);
              for (int l = 0; l < 2; ++l) {
#pragma unroll
                  for (int j = 0; j < 8; ++j) { const f32x4 g = *(const f32x4*)(kp->g_mem + l * D + 4 * lane + 256 * j); const f32x4 o = v[j] * rs * g;
                      if constexpr (F8_XPRE) *(unsigned*)(ws + WS_MEMN + ((size_t)l * 1024 + (r - T)) * D + 4 * lane + 256 * j) = pk_fp8x4(o[0] * F8_SX, o[1] * F8_SX, o[2] * F8_SX, o[3] * F8_SX);
                      else { u32x2 w; w.x = cvt_pk_bf16(o[0], o[1]); w.y = cvt_pk_bf16(o[2], o[3]); *(u32x2*)((bf16_t*)(ws + WS_MEMN) + ((size_t)l * 1024 + (r - T)) * D + 4 * lane + 256 * j) = w; } } } }
      } }
}

DI void moe_router(const Frame& F, KPtr kp, const int dummy = 0) {
    unsigned char* ws = kp->ws;
    LAS float* gwt = (LAS float*)F.lds;
    LAS int* cnt = (LAS int*)(F.lds + 65536);
    for (int j = F.tid; j < D * 8; j += NTHR) { const int e = j >> 11, c = j & (D - 1); gwt[j] = kp->g_ffn[D + c] * kp->w_router[c * 8 + e]; }
    if (F.tid < 8) cnt[F.tid] = 0;
    __syncthreads();
    unsigned* tokE = (unsigned*)(ws + WS_TOK); f32x2* tokG = (f32x2*)(ws + WS_TOK + 65536); float* tokR = (float*)(ws + WS_TOK + 3 * 65536);
    const int lane = F.lane; const bf16_t* HBp = (const bf16_t*)(ws + WS_HB);
    for (int row0 = (F.bid * NWAVES + F.wave) * 2; row0 < T; row0 += F.G * NWAVES * 2) {
        u32x2 hw[2][8];
#pragma unroll
        for (int q = 0; q < 2; ++q)
#pragma unroll
            for (int j = 0; j < 8; ++j) hw[q][j] = *(const u32x2*)(HBp + (size_t)(row0 + q) * D + 4 * lane + 256 * j);
#pragma unroll
        for (int q = 0; q < 2; ++q) { const int row = row0 + q;
            float lg[8] = {0.f, 0.f, 0.f, 0.f, 0.f, 0.f, 0.f, 0.f}; float ss = 0.f;
#pragma unroll
            for (int j = 0; j < 8; ++j) { const f32x4 v = {bf_lo(hw[q][j].x), bf_hi(hw[q][j].x), bf_lo(hw[q][j].y), bf_hi(hw[q][j].y)};
                ss += (v[0] * v[0] + v[1] * v[1]) + (v[2] * v[2] + v[3] * v[3]);
#pragma unroll
                for (int e = 0; e < 8; ++e) { const f32x4 w = *(const LAS f32x4*)(gwt + e * D + 4 * lane + 256 * j); lg[e] += (v[0] * w[0] + v[1] * w[1]) + (v[2] * w[2] + v[3] * w[3]); } }
            ss = wave_sum(ss);
#pragma unroll
            for (int e = 0; e < 8; ++e) lg[e] = wave_sum(lg[e]);
            const float r = __builtin_amdgcn_rsqf(ss * (1.0f / D) + EPS);
            int i0 = 0; float v0 = lg[0];
#pragma unroll
            for (int e = 1; e < 8; ++e) if (lg[e] > v0) { v0 = lg[e]; i0 = e; }
            int i1 = -1; float v1 = -3.0e38f;
#pragma unroll
            for (int e = 0; e < 8; ++e) if (e != i0 && lg[e] > v1) { v1 = lg[e]; i1 = e; }
            const float g0 = 1.0f / (1.0f + expf((v1 - v0) * r)), g1 = 1.0f - g0;
            if (lane == 0) { tokE[row] = (unsigned)i0 | ((unsigned)i1 << 8); tokG[row] = (f32x2){g0, g1}; tokR[row] = r;
                __hip_atomic_fetch_add(cnt + i0, 1, __ATOMIC_RELAXED, __HIP_MEMORY_SCOPE_WORKGROUP); __hip_atomic_fetch_add(cnt + i1, 1, __ATOMIC_RELAXED, __HIP_MEMORY_SCOPE_WORKGROUP); } }
    }
    __syncthreads();
    if (F.tid < 8) { const int c = cnt[F.tid]; if (c) __hip_atomic_fetch_add((unsigned*)(ws + WS_CTL) + (dummy ? 700000 : CW_MOE) + 64 * F.tid, (unsigned)c, __ATOMIC_RELAXED, __HIP_MEMORY_SCOPE_AGENT); }
}
DI void moe_assign_gather(const Frame& F, KPtr kp) {
    unsigned char* ws = kp->ws;
    unsigned* ctl = (unsigned*)(ws + WS_CTL);
    const unsigned* tokE = (const unsigned*)(ws + WS_TOK); const float* tokR = (const float*)(ws + WS_TOK + 3 * 65536); int* slot = (int*)(ws + WS_TOK + 4 * 65536);
    unsigned char* XS = ws + WS_R2 + R2_XS;
    LAS int* sl = (LAS int*)F.lds;
    int pstart[8]; { int b = 0;
#pragma unroll
        for (int e = 0; e < 8; ++e) { pstart[e] = b * 256; const unsigned c = __hip_atomic_load(ctl + CW_MOE + 64 * e, __ATOMIC_RELAXED, __HIP_MEMORY_SCOPE_AGENT); b += (int)((c + 255u) >> 8); } }
    const int lane = F.lane; const bf16_t* HBp = (const bf16_t*)(ws + WS_HB);
    for (int batch = F.bid; batch < T / 64; batch += F.G) {
        if (F.wave == 0) { const int t = batch * 64 + lane; const unsigned ee = tokE[t];
#pragma unroll
            for (int k = 0; k < 2; ++k) { const int ek = (int)((ee >> (8 * k)) & 0xffu);
                unsigned long long mk[8]; int mycnt = 0;
#pragma unroll
                for (int e = 0; e < 8; ++e) { mk[e] = __ballot(ek == e); if (lane == e) mycnt = __popcll(mk[e]); }
                unsigned base = 0; if (lane < 8 && mycnt) base = __hip_atomic_fetch_add(ctl + CW_MOE + 512 + 64 * lane, (unsigned)mycnt, __ATOMIC_RELAXED, __HIP_MEMORY_SCOPE_AGENT);
                int myslot = 0;
#pragma unroll
                for (int e = 0; e < 8; ++e) { const unsigned be = (unsigned)__builtin_amdgcn_readlane((int)base, e); if (ek == e) myslot = pstart[e] + (int)be + __popcll(mk[e] & ((1ull << lane) - 1ull)); }
                sl[lane * 2 + k] = myslot; slot[t * 2 + k] = myslot; } }
        __syncthreads();
        for (int j = 0; j < 8; j += 2) {
            u32x2 hw[2][8]; int s0[2], s1[2]; float r[2];
#pragma unroll
            for (int q = 0; q < 2; ++q) { const int tl = F.wave * 8 + j + q, t = batch * 64 + tl; s0[q] = sl[tl * 2]; s1[q] = sl[tl * 2 + 1]; r[q] = tokR[t];
#pragma unroll
                for (int c = 0; c < 8; ++c) hw[q][c] = *(const u32x2*)(HBp + (size_t)t * D + 4 * lane + 256 * c); }
#pragma unroll
            for (int q = 0; q < 2; ++q)
#pragma unroll
                for (int c = 0; c < 8; ++c) { const f32x4 v = (f32x4){bf_lo(hw[q][c].x), bf_hi(hw[q][c].x), bf_lo(hw[q][c].y), bf_hi(hw[q][c].y)} * (F8_MOE ? r[q] * F8_SX : r[q]);
                    if constexpr (F8_MOE) { const unsigned w = pk_fp8x4(v[0], v[1], v[2], v[3]);
                        *(unsigned*)(XS + (size_t)s0[q] * D + 4 * lane + 256 * c) = w; *(unsigned*)(XS + (size_t)s1[q] * D + 4 * lane + 256 * c) = w; }
                    else { u32x2 w; w.x = cvt_pk_bf16(v[0], v[1]); w.y = cvt_pk_bf16(v[2], v[3]);
                        *(u32x2*)((bf16_t*)XS + (size_t)s0[q] * D + 4 * lane + 256 * c) = w; *(u32x2*)((bf16_t*)XS + (size_t)s1[q] * D + 4 * lane + 256 * c) = w; } } }
        __syncthreads();
    }
}
DI void moe_combine_final(const Frame& F, KPtr kp) {
    unsigned char* ws = kp->ws;
    const f32x2* tokG = (const f32x2*)(ws + WS_TOK + 65536); const int* slot = (const int*)(ws + WS_TOK + 4 * 65536);
    const bf16_t* YS = (const bf16_t*)(ws + WS_R2 + R2_YS); const bf16_t* HBp = (const bf16_t*)(ws + WS_HB); const int lane = F.lane;
    const pg8::MoeTail tp = pg8::moe_tail_plan((const unsigned*)(ws + WS_CTL) + CW_MOE, F.G); const int tail0 = tp.nb_main * 256; const size_t tslab = (size_t)(tp.nused - tp.nb_main) * 256 * D;
    const bf16_t* YP = (const bf16_t*)(ws + WS_R2 + R2_YP);
    for (int row0 = (F.bid * NWAVES + F.wave) * 2; row0 < T; row0 += F.G * NWAVES * 2) {
        int s0[2], s1[2]; f32x2 g[2]; u32x2 hw[2][8], ya[2][8], yb[2][8];
#pragma unroll
        for (int q = 0; q < 2; ++q) { s0[q] = slot[(row0 + q) * 2]; s1[q] = slot[(row0 + q) * 2 + 1]; g[q] = tokG[row0 + q]; }
#pragma unroll
        for (int q = 0; q < 2; ++q)
#pragma unroll
            for (int j = 0; j < 8; ++j) { const int c = 4 * lane + 256 * j; hw[q][j] = *(const u32x2*)(HBp + (size_t)(row0 + q) * D + c);
                ya[q][j] = *(const u32x2*)(YS + (size_t)s0[q] * D + c); yb[q][j] = *(const u32x2*)(YS + (size_t)s1[q] * D + c); }
        if (tp.f > 1) {
#pragma unroll
            for (int q = 0; q < 2; ++q)
#pragma unroll
                for (int w = 0; w < 2; ++w) { const int sl = w ? s1[q] : s0[q]; if (sl < tail0) continue;
                    for (int k = 1; k < tp.f; ++k) { const bf16_t* pr = YP + (size_t)(k - 1) * tslab + (size_t)(sl - tail0) * D; u32x2 pv[8];
#pragma unroll
                        for (int j = 0; j < 8; ++j) pv[j] = *(const u32x2*)(pr + 4 * lane + 256 * j);
#pragma unroll
                        for (int j = 0; j < 8; ++j) { u32x2& y = w ? yb[q][j] : ya[q][j];
                            y.x = cvt_pk_bf16(bf_lo(y.x) + bf_lo(pv[j].x), bf_hi(y.x) + bf_hi(pv[j].x)); y.y = cvt_pk_bf16(bf_lo(y.y) + bf_lo(pv[j].y), bf_hi(y.y) + bf_hi(pv[j].y)); } } }
        }
#pragma unroll
        for (int q = 0; q < 2; ++q) { f32x4 v[8]; float ss = 0.f;
#pragma unroll
            for (int j = 0; j < 8; ++j) { const u32x2 h = hw[q][j], a = ya[q][j], b = yb[q][j]; f32x4 o;
                o[0] = bf_lo(h.x) + (g[q].x * bf_lo(a.x) + g[q].y * bf_lo(b.x)); o[1] = bf_hi(h.x) + (g[q].x * bf_hi(a.x) + g[q].y * bf_hi(b.x));
                o[2] = bf_lo(h.y) + (g[q].x * bf_lo(a.y) + g[q].y * bf_lo(b.y)); o[3] = bf_hi(h.y) + (g[q].x * bf_hi(a.y) + g[q].y * bf_hi(b.y));
                v[j] = o; ss += (o[0] * o[0] + o[1] * o[1]) + (o[2] * o[2] + o[3] * o[3]); }
            ss = wave_sum(ss); const float r = __builtin_amdgcn_rsqf(ss * (1.0f / D) + EPS);
#pragma unroll
            for (int j = 0; j < 8; ++j) { const int c = 4 * lane + 256 * j; __builtin_nontemporal_store(v[j] * r * *(const f32x4*)(kp->g_final + c), (f32x4*)(kp->out + (size_t)(row0 + q) * D + c)); } }
    }
}
namespace att {
constexpr int SHM_V = 16384, NW_ATT = 8;
DI int v_st(int k, int c) { const int kk = (k & ~0xC) | ((k & 4) << 1) | ((k & 8) >> 1); return ((kk >> 3) * 4 + (c >> 5)) * 512 + ((kk & 7) * 32 + (c & 31)) * 2; }
DI int v_rd_base(int lane) { return ((lane & 3) << 3) | (((lane >> 2) & 3) << 6) | (((lane >> 4) & 1) << 5) | (((lane >> 5) & 1) << 8); }
struct Src { const bf16_t* q; const bf16_t* k; const bf16_t* k2; const bf16_t* v; bf16_t* o; int ldq, ldk, ldv; };
DI float swap_max(float x) { auto rr = __builtin_amdgcn_permlane32_swap(__float_as_uint(x), __float_as_uint(x), false, false); return fmaxf(__uint_as_float(rr[0]), __uint_as_float(rr[1])); }
DI float swap_sum(float x) { auto rr = __builtin_amdgcn_permlane32_swap(__float_as_uint(x), __float_as_uint(x), false, false); return __uint_as_float(rr[0]) + __uint_as_float(rr[1]); }
#define ATT_PK4(P, B_, OUT) do { unsigned a0 = cvt_pk_bf16(P[B_+0], P[B_+1]), a1 = cvt_pk_bf16(P[B_+2], P[B_+3]);                          \
        unsigned b0 = cvt_pk_bf16(P[B_+4], P[B_+5]), b1 = cvt_pk_bf16(P[B_+6], P[B_+7]);                                             \
        auto r0 = __builtin_amdgcn_permlane32_swap(a0, b0, false, false); auto r1 = __builtin_amdgcn_permlane32_swap(a1, b1, false, false); \
        u32x4 w = {r0[0], r1[0], r0[1], r1[1]}; OUT = __builtin_bit_cast(bf16x8, w); } while (0)

template <int KIND, int DK, int DBG = 0>
DI void tile_compute(const unsigned kaddr  , const int (&kx)[4], const unsigned vaddr  ,
                     const bf16x8 (&qr)[DK / 16], f32x16 (&o)[4], float& m_reg, float& l_reg, float& R, const int dq, const bool bmask, const bool blk_ok, const int hi) {
    constexpr int ND = DK / 16, KROW = DK * 2;
    f32x16 p0, p1;
    const bool mvalid = m_reg > -1e29f; const float base = mvalid ? m_reg : 0.f;
    const float pinit = (KIND == 2) ? 0.f : ((KIND == 1 && !blk_ok) ? -__builtin_inff() : -base);
#pragma unroll
    for (int r = 0; r < 16; ++r) { p0[r] = pinit; p1[r] = pinit; }
    constexpr int KG = ND > 8 ? 4 : ND;
    if constexpr (DBG & 1) { p0[0] = __int_as_float(kaddr & 3); }
    else
#pragma unroll
    for (int g0 = 0; g0 < ND; g0 += KG) {
        bf16x8 kf[KG][2];
#pragma unroll
        for (int d = 0; d < KG; ++d) { const int d0 = g0 + d; const LAS unsigned char* a = (const LAS unsigned char*)(size_t)(kaddr + kx[d0 & 3] + (d0 >> 2) * 128);
            if constexpr (DBG & 16) { kf[d][0] = qr[d0]; kf[d][1] = qr[(d0 + 1) % ND]; (void)a; } else { kf[d][0] = *(const LAS bf16x8*)a; kf[d][1] = *(const LAS bf16x8*)(a + 32 * KROW); } }
        __builtin_amdgcn_sched_barrier(0);
#pragma unroll
        for (int d = 0; d < KG; ++d) { p0 = __builtin_amdgcn_mfma_f32_32x32x16_bf16(kf[d][0], qr[g0 + d], p0, 0, 0, 0); p1 = __builtin_amdgcn_mfma_f32_32x32x16_bf16(kf[d][1], qr[g0 + d], p1, 0, 0, 0); }
    }
    const float NEG = -__builtin_inff();
    if constexpr (DBG & 2) { (void)NEG; }
    else if constexpr (KIND != 2) {
        if (bmask) {
#pragma unroll
            for (int r = 0; r < 16; ++r) { const int c = (r & 3) + 8 * (r >> 2); if (c > dq) p0[r] = NEG; if (c + 32 > dq) p1[r] = NEG; }
        }
        float pmax = p0[0];
#pragma unroll
        for (int r = 1; r < 16; ++r) pmax = fmaxf(pmax, p0[r]);
#pragma unroll
        for (int r = 0; r < 16; ++r) pmax = fmaxf(pmax, p1[r]);
        pmax = swap_max(pmax);
        float alpha = 1.0f, ps = 0.f;
        if (__all(mvalid && pmax <= 8.0f)) {
#pragma unroll
            for (int r = 0; r < 16; ++r) { p0[r] = fast_exp2(p0[r]); ps += p0[r]; }
#pragma unroll
            for (int r = 0; r < 16; ++r) { p1[r] = fast_exp2(p1[r]); ps += p1[r]; }
        } else {
            const float mnew = fmaxf(m_reg, base + pmax), delta = mnew - base;
            alpha = fast_exp2(m_reg - mnew); m_reg = mnew;
#pragma unroll
            for (int r = 0; r < 16; ++r) { p0[r] = fast_exp2(p0[r] - delta); ps += p0[r]; }
#pragma unroll
            for (int r = 0; r < 16; ++r) { p1[r] = fast_exp2(p1[r] - delta); ps += p1[r]; }
        }
        ps = swap_sum(ps);
        l_reg = l_reg * alpha + ps;
        if (__any(alpha < 1.0f)) {
#pragma unroll
            for (int d = 0; d < 4; ++d)
#pragma unroll
                for (int r = 0; r < 16; ++r) o[d][r] *= alpha;
        }
    } else {
        float y0[16], y1[16];
#pragma unroll
        for (int r = 0; r < 16; ++r) { const int c = (r & 3) + 8 * (r >> 2);
            const float ua = fast_exp2(fminf(p0[r], 100.f)), ub = fast_exp2(fminf(p1[r], 100.f));
            float ra = fast_rcp(1.0f + ua), rb = fast_rcp(1.0f + ub), ba = ua * ra, bb = ub * rb;
            if (bmask) { if (!(c < dq)) { ra = 1.f; ba = 0.f; } if (!(c + 32 < dq)) { rb = 1.f; bb = 0.f; } }
            y0[r] = ra; y1[r] = rb; p0[r] = ba; p1[r] = bb; }
        float pair[8], gpl[8];
#pragma unroll
        for (int k = 0; k < 8; ++k) { const float g = k < 4 ? (y0[4 * k] * y0[4 * k + 1]) * (y0[4 * k + 2] * y0[4 * k + 3]) : (y1[4 * (k - 4)] * y1[4 * (k - 4) + 1]) * (y1[4 * (k - 4) + 2] * y1[4 * (k - 4) + 3]);
            auto rr = __builtin_amdgcn_permlane32_swap(__float_as_uint(g), __float_as_uint(g), false, false);
            const float glo = __uint_as_float(rr[0]), ghi = __uint_as_float(rr[1]);
            pair[k] = glo * ghi; gpl[k] = hi ? 1.0f : ghi; }
        float off[8]; { float e = R;
#pragma unroll
            for (int k = 7; k >= 0; --k) { off[k] = e * gpl[k]; e *= pair[k]; }
            R = e; }
#pragma unroll
        for (int j = 0; j < 4; ++j) {
            { const float e3 = off[j], e2 = y0[4 * j + 3] * e3, e1 = y0[4 * j + 2] * e2, e0 = y0[4 * j + 1] * e1;
              p0[4 * j + 3] *= e3; p0[4 * j + 2] *= e2; p0[4 * j + 1] *= e1; p0[4 * j] *= e0; }
            { const float e3 = off[4 + j], e2 = y1[4 * j + 3] * e3, e1 = y1[4 * j + 2] * e2, e0 = y1[4 * j + 1] * e1;
              p1[4 * j + 3] *= e3; p1[4 * j + 2] *= e2; p1[4 * j + 1] *= e1; p1[4 * j] *= e0; } }
    }
    bf16x8 pa0, pa1, pa2, pa3;
    ATT_PK4(p0, 0, pa0); ATT_PK4(p0, 8, pa1); ATT_PK4(p1, 0, pa2); ATT_PK4(p1, 8, pa3);
#define ATT_TRRD(dst, off) asm volatile("ds_read_b64_tr_b16 %0, %1 offset:%2" : "=&v"(dst) : "v"(vaddr), "i"(off) : "memory")
#define ATT_VRD(V, d0) do { if constexpr (DBG & 32) { _Pragma("unroll") for (int q_ = 0; q_ < 8; ++q_) V[q_] = (s16x4){pa0[q_ & 7], pa1[q_ & 7], pa2[q_ & 7], pa3[q_ & 7]}; break; } constexpr int b_ = (d0) * 512; ATT_TRRD(V[0], b_); ATT_TRRD(V[1], b_ + 2048); ATT_TRRD(V[2], b_ + 4096); ATT_TRRD(V[3], b_ + 6144); ATT_TRRD(V[4], b_ + 8192); ATT_TRRD(V[5], b_ + 10240); ATT_TRRD(V[6], b_ + 12288); ATT_TRRD(V[7], b_ + 14336); } while (0)
#define ATT_VF(V, k) ((bf16x8){V[2 * (k)][0], V[2 * (k)][1], V[2 * (k)][2], V[2 * (k)][3], V[2 * (k) + 1][0], V[2 * (k) + 1][1], V[2 * (k) + 1][2], V[2 * (k) + 1][3]})
#define ATT_PVM(V, d0) do { o[d0] = __builtin_amdgcn_mfma_f32_32x32x16_bf16(ATT_VF(V, 0), pa0, o[d0], 0, 0, 0); o[d0] = __builtin_amdgcn_mfma_f32_32x32x16_bf16(ATT_VF(V, 1), pa1, o[d0], 0, 0, 0); \
        o[d0] = __builtin_amdgcn_mfma_f32_32x32x16_bf16(ATT_VF(V, 2), pa2, o[d0], 0, 0, 0); o[d0] = __builtin_amdgcn_mfma_f32_32x32x16_bf16(ATT_VF(V, 3), pa3, o[d0], 0, 0, 0); } while (0)
#define ATT_LW(n) do { asm volatile("s_waitcnt lgkmcnt(" #n ")" ::: "memory"); __builtin_amdgcn_sched_barrier(0); } while (0)
    if constexpr (DBG & 4) { o[0][0] += __builtin_bit_cast(f32x4, __builtin_bit_cast(u32x4, pa0) ^ __builtin_bit_cast(u32x4, pa1) ^ __builtin_bit_cast(u32x4, pa2) ^ __builtin_bit_cast(u32x4, pa3))[0]; }
    else { s16x4 va[8], vb[8];
      __builtin_amdgcn_sched_barrier(0);
      ATT_VRD(va, 0); ATT_VRD(vb, 1);
      ATT_LW(8); ATT_PVM(va, 0); __builtin_amdgcn_sched_barrier(0);
      ATT_VRD(va, 2);
      ATT_LW(8); ATT_PVM(vb, 1); __builtin_amdgcn_sched_barrier(0);
      ATT_VRD(vb, 3);
      ATT_LW(8); ATT_PVM(va, 2); __builtin_amdgcn_sched_barrier(0);
      ATT_LW(0); ATT_PVM(vb, 3); }
#undef ATT_LW
#undef ATT_PVM
#undef ATT_VF
#undef ATT_VRD
#undef ATT_TRRD
}

template <int KIND, int DBG = 0>
DI void attn_unit(LAS unsigned char* lds, const int tid_in, const Src& s, const int qb, const float* ksum_bh) {
    constexpr int DK = KIND == 0 ? 192 : 128, ND = DK / 16, KROW = DK * 2, SHM_K = 64 * KROW, NKC = DK / 8, NST = 64 * NKC / 512;
    int tid_ = tid_in; asm volatile("" : "+v"(tid_));
    const int tid = tid_, wid = __builtin_amdgcn_readfirstlane(tid >> 6), lane = tid & 63, r32 = lane & 31, hi = lane >> 5;
    const int P0 = qb * 256, qlo = P0 + wid * 32, qpos = qlo + r32, NT = 4 * (qb + 1);
    bf16x8 qr[ND];
#pragma unroll
    for (int d0 = 0; d0 < ND; ++d0) qr[d0] = *(const bf16x8*)(s.q + (size_t)qpos * s.ldq + d0 * 16 + hi * 8);
    unsigned allowed = 0xffffffffu;
    LAS float* ksl = (LAS float*)(lds + 98304);
    f32x4 ksv = {0.f, 0.f, 0.f, 0.f};
    if constexpr (KIND == 1) { if (tid < qb * 32) ksv = *(const f32x4*)(ksum_bh + (size_t)(tid >> 5) * 640 + (tid & 31) * 4); }
    f32x16 o[4];
#pragma unroll
    for (int d = 0; d < 4; ++d)
#pragma unroll
        for (int r = 0; r < 16; ++r) o[d][r] = 0.f;
    float m_reg = -1e30f, l_reg = 0.f, R = (KIND == 2) ? 1.0f : 0.f;
    LAS unsigned char* Vl = lds; LAS unsigned char* Kl = lds + 3 * SHM_V;
    const bf16_t* ksrc[NST]; int kstr[NST];
#pragma unroll
    for (int i = 0; i < NST; ++i) { const int ci = tid + 512 * i, row = ci / NKC, ccp = ci - row * NKC, cc = ccp ^ (row & 7);
        if (KIND == 0 && cc >= 16) { ksrc[i] = s.k2 + (size_t)row * 64 + (cc - 16) * 8; kstr[i] = 64; } else { ksrc[i] = s.k + (size_t)row * s.ldk + cc * 8; kstr[i] = s.ldk; } }
    unsigned vsrc[2];
#pragma unroll
    for (int i = 0; i < 2; ++i) { const int j = tid + 512 * i, st = j >> 5, sl = j & 31, kk = (st >> 2) * 8 + (sl >> 2), c = (st & 3) * 32 + 8 * (sl & 3);
        const int k = (kk & ~0xC) | ((kk & 4) << 1) | ((kk & 8) >> 1); vsrc[i] = (unsigned)((k * s.ldv + c) * 2); }
    const unsigned vbase = (unsigned)(unsigned long long)Vl + (unsigned)v_rd_base(lane);
    const unsigned kbase = (unsigned)(unsigned long long)Kl + (unsigned)(r32 * KROW);
    int kx[4];
#pragma unroll
    for (int dd = 0; dd < 4; ++dd) kx[dd] = (dd * 32 + hi * 16) ^ ((r32 & 7) << 4);
    constexpr int NDMA = NST + 2;
#define ATT_DMA(t, slot) do { const int kb_ = (t) * 64; const char* vb_ = (const char*)(s.v + (size_t)kb_ * s.ldv); \
        _Pragma("unroll") for (int i_ = 0; i_ < 2; ++i_) __builtin_amdgcn_global_load_lds((const unsigned*)(vb_ + vsrc[i_]), (LAS unsigned*)(Vl + (slot) * SHM_V + (wid * 64 + 512 * i_) * 16), 16, 0, 0); \
        _Pragma("unroll") for (int i_ = 0; i_ < NST; ++i_) __builtin_amdgcn_global_load_lds((const unsigned*)(ksrc[i_] + (size_t)kb_ * kstr[i_]), (LAS unsigned*)(Kl + (slot) * SHM_K + (wid * 64 + 512 * i_) * 16), 16, 0, 0); } while (0)
#define ATT_TILE(i_) ((KIND == 2) ? (NT - 1 - (i_)) : (i_))
#define ATT_WAITV(n) asm volatile("s_waitcnt vmcnt(%0)" :: "i"(n) : "memory")
#define ATT_BARRIER() do { asm volatile("s_waitcnt lgkmcnt(0)" ::: "memory"); __builtin_amdgcn_s_barrier(); asm volatile("" ::: "memory"); } while (0)
    volatile LAS int* wdone_cnt = (volatile LAS int*)(lds + LDS_MISC) + 5;
    bool wdone = false;
    if (KIND == 2 && tid == 0) *wdone_cnt = 0;
    ATT_DMA(ATT_TILE(0), 0); ATT_DMA(ATT_TILE(1), 1);
    if constexpr (KIND == 1) {
        if (tid < qb * 32) *(LAS f32x4*)(ksl + tid * 4) = ksv;
        ATT_BARRIER();
        allowed = 1u << qb;
        float v0 = -__builtin_inff(), v1 = v0, v2 = v0; int i0 = -1, i1 = -1, i2 = -1;
        for (int n = 0; n < qb; ++n) {
            const LAS float* kp = ksl + n * 128 + hi * 8; float g = 0.f;
#pragma unroll
            for (int d0 = 0; d0 < 8; ++d0) { const f32x4 k0 = *(const LAS f32x4*)(kp + d0 * 16), k1 = *(const LAS f32x4*)(kp + d0 * 16 + 4); const u32x4 qw = __builtin_bit_cast(u32x4, qr[d0]);
                g += bf_lo(qw[0]) * k0[0] + bf_hi(qw[0]) * k0[1] + bf_lo(qw[1]) * k0[2] + bf_hi(qw[1]) * k0[3] + bf_lo(qw[2]) * k1[0] + bf_hi(qw[2]) * k1[1] + bf_lo(qw[3]) * k1[2] + bf_hi(qw[3]) * k1[3]; }
            g = swap_sum(g);
            if (g > v0) { v2 = v1; i2 = i1; v1 = v0; i1 = i0; v0 = g; i0 = n; } else if (g > v1) { v2 = v1; i2 = i1; v1 = g; i1 = n; } else if (g > v2) { v2 = g; i2 = n; }
        }
        if (i0 >= 0) allowed |= 1u << i0; if (i1 >= 0) allowed |= 1u << i1; if (i2 >= 0) allowed |= 1u << i2;
    }
    ATT_WAITV(NDMA); ATT_BARRIER();
    int slot = 0;
    for (int i = 0; i < NT; ++i) {
        const int t_ = ATT_TILE(i), kb_ = t_ * 64; const int s2 = slot == 0 ? 2 : slot - 1;
        const bool more = !(DBG & 8) && (i + 2 < NT);
        if (more) ATT_DMA(ATT_TILE(i + 2), s2);
        if (kb_ <= qlo + 31 && !wdone) { const bool bm_ = (KIND == 2) ? (kb_ + 63 >= qlo) : (kb_ + 63 > qlo);
            tile_compute<KIND, DK, DBG>(kbase + slot * SHM_K, kx, vbase + slot * SHM_V, qr, o, m_reg, l_reg, R, qpos - kb_ - 4 * hi, bm_, ((allowed >> (kb_ >> 8)) & 1u) != 0u, hi);
            if (KIND == 2 && !(DBG & 64) && __all(R == 0.0f)) { wdone = true; if (lane == 0) __hip_atomic_fetch_add((LAS int*)wdone_cnt, 1, __ATOMIC_RELAXED, __HIP_MEMORY_SCOPE_WORKGROUP); } }
        if (more) ATT_WAITV(NDMA); else ATT_WAITV(0);
        ATT_BARRIER();
        slot = slot == 2 ? 0 : slot + 1;
        if (KIND == 2) {
            const int c_ = __builtin_amdgcn_readfirstlane(*wdone_cnt); ATT_BARRIER();
            if (c_ == NW_ATT) { ATT_WAITV(0); ATT_BARRIER(); break; } }
    }
#undef ATT_BARRIER
#undef ATT_WAITV
#undef ATT_TILE
#undef ATT_DMA
    const float inv = (KIND == 2) ? 1.0f : 1.0f / l_reg;
    if constexpr (F8_DUP && KIND != 2) {
        unsigned char* ob = (unsigned char*)s.o + (size_t)qpos * (2 * D) + 8 * hi; const float i8 = inv * F8_SO;
#pragma unroll
        for (int d0 = 0; d0 < 4; ++d0)
#pragma unroll
            for (int g = 0; g < 4; g += 2) {
                const unsigned a = pk_fp8x4(o[d0][4 * g] * i8, o[d0][4 * g + 1] * i8, o[d0][4 * g + 2] * i8, o[d0][4 * g + 3] * i8), b = pk_fp8x4(o[d0][4 * g + 4] * i8, o[d0][4 * g + 5] * i8, o[d0][4 * g + 6] * i8, o[d0][4 * g + 7] * i8);
                auto r = __builtin_amdgcn_permlane32_swap(a, b, false, false);
                *(u32x2*)(ob + 32 * d0 + 8 * g) = (u32x2){r[0], r[1]}; }
        return; }
    bf16_t* orow = s.o + (size_t)qpos * D + 8 * hi;
#pragma unroll
    for (int d0 = 0; d0 < 4; ++d0)
#pragma unroll
        for (int g = 0; g < 4; g += 2) {
            const unsigned a0 = cvt_pk_bf16(o[d0][4 * g] * inv, o[d0][4 * g + 1] * inv), a1 = cvt_pk_bf16(o[d0][4 * g + 2] * inv, o[d0][4 * g + 3] * inv);
            const unsigned b0 = cvt_pk_bf16(o[d0][4 * g + 4] * inv, o[d0][4 * g + 5] * inv), b1 = cvt_pk_bf16(o[d0][4 * g + 6] * inv, o[d0][4 * g + 7] * inv);
            auto r0 = __builtin_amdgcn_permlane32_swap(a0, b0, false, false); auto r1 = __builtin_amdgcn_permlane32_swap(a1, b1, false, false);
            const u32x4 w = {r0[0], r1[0], r0[1], r1[1]};
            *(u32x4*)(orow + 32 * d0 + 8 * g) = w; }
}
}

namespace pg8 {
struct SchedMemKV {
    const char* MEMN; const char* WXK; const char* WXV; int G, c, eb;
    DI bool next(int i, Unit& u) const {
        const long L = (long)i * G + c; if (L >= 128) return false;
        const int ll = (int)L >> 6, kind = ((int)L >> 5) & 1, r = (int)L & 31; u.aux = ll * 2 + kind; u.nt = 16 * eb;
        u.pm = r >> 3; u.pn = r & 7; u.a = MEMN + (size_t)ll * 1024 * D * eb + (size_t)u.pm * 256 * D * eb; u.b = (kind ? WXV : WXK) + (size_t)ll * SZ_SQ + (size_t)u.pn * 256 * D * eb;
        return true;
    }
};
struct SchedXPre {
    const char* KMEM; const char* VMEM; const char* WXQN; const char* WXO; int G, c, eb;
    DI bool next(int i, Unit& u) const {
        const long L = (long)i * G + c; if (L >= 512) return false;
        const int kind = (int)L >> 8, r = (int)L & 255, ll = r >> 7, bh = (r >> 3) & 15, b = bh >> 2, h = bh & 3, p = r & 7; u.aux = kind; u.nt = 4 * eb;
        const size_t mem = ((size_t)(ll * 1024 + b * 256) * D + h * 512) * eb, wgt = (size_t)ll * SZ_SQ + ((size_t)p * 256 * D + h * 512) * eb;
        if (kind == 0) { u.a = KMEM + mem; u.b = WXQN + wgt; u.pm = (ll * 4 + b) * 4 + h; u.pn = p; }
        else { u.a = WXO + wgt; u.b = VMEM + mem; u.pm = (ll * 4 + b) * 8 + p; u.pn = h; }
        return true;
    }
};
struct SchedXS2 {
    const char* HBp; const char* MT; int l, G, c, eb;
    DI bool next(int i, Unit& u) const {
        const long L = (long)i * G + c; if (L >= 256) return false;
        const int hd = (int)L & 3, rt = (int)L >> 2; u.pm = rt; u.pn = hd; u.aux = 0; u.nt = 16 * eb;
        u.a = HBp + (size_t)rt * 256 * D * eb; u.b = MT + ((size_t)((l * 4 + (rt >> 4)) * 1024 + hd * 256) * D) * eb; return true;
    }
};
struct SchedXO {
    const char* PX; const char* NT; int l, G, c, eb;
    DI bool next(int i, Unit& u) const {
        const long L = (long)i * G + c; if (L >= 512) return false;
        tile_order((int)L, 64, 8, u.pm, u.pn); u.aux = 0; u.nt = 8 * eb;
        u.a = PX + (size_t)u.pm * 256 * 1024 * eb; u.b = NT + ((size_t)((l * 4 + (u.pm >> 4)) * 2048 + u.pn * 256) * 1024) * eb; return true;
    }
};
}
namespace epi {
struct EpiTwo {
    bf16_t* O0; bf16_t* O1; int ld0, ld1; size_t slab; float sc0 = 0.f, sc1 = 0.f;
    static constexpr bool BAR_INSIDE = false;
    DI const stat_t* stat_src() const { return nullptr; }
    DI bool operator()(Acc& acc, const Unit& u, int wr, int wc, int fr, int fq) const {
        asm volatile("" : "+v"(fr), "+v"(fq));
        const int kind = u.aux & 1; const int ldo = kind ? ld1 : ld0; const float sc = kind ? sc1 : sc0;
        const int row0 = u.pm * 256 + wr * 64 + fr;
        if (sc > 0.f) { unsigned char* O = (unsigned char*)(kind ? O1 : O0) + (size_t)(u.aux >> 1) * slab;
#pragma unroll
            for (int ai = 0; ai < 2; ++ai)
#pragma unroll
                for (int m = 0; m < 4; ++m) { const int row = row0 + ai * 128 + m * 16;
#pragma unroll
                    for (int bj = 0; bj < 2; ++bj)
                        *(u32x2*)(O + (size_t)row * ldo + u.pn * 256 + bj * 128 + wc * 32 + 8 * fq) = pack8_fp8(acc[ai][bj][m][0] * sc, acc[ai][bj][m][1] * sc); }
            return false; }
        bf16_t* O = (kind ? O1 : O0) + (size_t)(u.aux >> 1) * slab;
#pragma unroll
        for (int ai = 0; ai < 2; ++ai)
#pragma unroll
            for (int m = 0; m < 4; ++m) { const int row = row0 + ai * 128 + m * 16;
#pragma unroll
                for (int bj = 0; bj < 2; ++bj)
                    *(u32x4*)(O + (size_t)row * ldo + u.pn * 256 + bj * 128 + wc * 32 + 8 * fq) = pack8(acc[ai][bj][m][0], acc[ai][bj][m][1]); }
        return false;
    }
};
}

#ifndef ATT_DBG
#define ATT_DBG 0
#endif
template <int DBG = 0>
DI void attn_phase(const Frame& F, KPtr kp, const int l, const int qoff = 0, const int kmask = 7) {
    unsigned char* ws = kp->ws; unsigned* ctl = (unsigned*)(ws + WS_CTL);
    volatile LAS int* misc = (volatile LAS int*)(F.lds + LDS_MISC);
    const bf16_t* QA = (const bf16_t*)(ws + WS_R2 + R2_QA); const bf16_t* KVA = (const bf16_t*)(ws + WS_R2 + R2_KVA); const bf16_t* KPE = (const bf16_t*)(ws + WS_R1 + R1_KPE);
    const bf16_t* MQK = (const bf16_t*)(ws + WS_R1 + R1_MQK); const bf16_t* PL = (const bf16_t*)(ws + WS_R1 + R1_PL); bf16_t* OCAT = qoff ? (bf16_t*)(ws + WS_R1 + 352 * MiB) : (bf16_t*)(ws + WS_R2 + R2_OCAT);
    const float* ksum = (const float*)(ws + WS_CTL) + CW_KSUM + l * KSUM_L;
#define ATT_U0 att::attn_unit<0, DBG>
#define ATT_U1 att::attn_unit<1, DBG>
#define ATT_U2 att::attn_unit<2, DBG>
#define ATT_QUEUE_LOOP(KIND, NH, BODY) for (;;) { if (F.tid == 0) misc[4] = (int)__hip_atomic_fetch_add(ctl + CW_QUEUE + (qoff * 6 + l * 3 + (KIND)) * 64, 1u, __ATOMIC_RELAXED, __HIP_MEMORY_SCOPE_AGENT); \
        __syncthreads(); const int it = __builtin_amdgcn_readfirstlane(misc[4]); __syncthreads(); if (it >= 16 * NB * (NH)) break; \
        const int qb = 15 - it / (NB * (NH)), r_ = it % (NB * (NH)), b = r_ / (NH), h = r_ % (NH); const size_t t0 = (size_t)b * SEQ; att::Src s; BODY }
#ifndef ATT_MASK
#define ATT_MASK 7
#endif
    if ((ATT_MASK & 1) && (kmask & 1)) ATT_QUEUE_LOOP(0, 6, { s.q = QA + t0 * 1152 + h * 192; s.k = KVA + t0 * 1536 + h * 256; s.k2 = KPE + t0 * 64; s.v = KVA + t0 * 1536 + h * 256 + 128; s.o = F8_DUP ? (bf16_t*)((unsigned char*)(OCAT + t0 * D) + h * 128) : OCAT + t0 * D + h * 128;
        s.ldq = 1152; s.ldk = 1536; s.ldv = 1536; ATT_U0(F.lds, F.tid, s, qb, nullptr); })
    if ((ATT_MASK & 2) && (kmask & 2)) ATT_QUEUE_LOOP(1, 5, { s.q = MQK + t0 * 1280 + h * 128; s.k = MQK + t0 * 1280 + (5 + h) * 128; s.k2 = nullptr; s.v = PL + t0 * 2560 + h * 128; s.o = F8_DUP ? (bf16_t*)((unsigned char*)(OCAT + t0 * D) + 768 + h * 128) : OCAT + t0 * D + 768 + h * 128;
        s.ldq = 1280; s.ldk = 1280; s.ldv = 2560; ATT_U1(F.lds, F.tid, s, qb, ksum + ((size_t)b * 16 * 5 + h) * 128); })
    if ((ATT_MASK & 4) && (kmask & 4)) ATT_QUEUE_LOOP(2, 5, { s.q = PL + t0 * 2560 + 640 + h * 128; s.k = PL + t0 * 2560 + 1280 + h * 128; s.k2 = nullptr; s.v = PL + t0 * 2560 + 1920 + h * 128; s.o = OCAT + t0 * D + 1408 + h * 128;
        s.ldq = 2560; s.ldk = 2560; s.ldv = 2560; ATT_U2(F.lds, F.tid, s, qb, nullptr); })
#undef ATT_QUEUE_LOOP
}

constexpr int NPH = 26;
__global__ void __launch_bounds__(NTHR, 2) fwd(Params P) {
    extern __shared__ __attribute__((aligned(16))) unsigned char lds_[];
    int wave_id_ = __builtin_amdgcn_readfirstlane(threadIdx.x >> 6); asm volatile("" : "+s"(wave_id_));
    volatile LAS unsigned* MISC = (volatile LAS unsigned*)((LAS unsigned char*)lds_ + LDS_MISC);
    if (threadIdx.x < 32) MISC[threadIdx.x] = 0u;
    __syncthreads();
#if N_LAUNCH_MODE == 1
    constexpr int lo = 0, hi = 26;
#else
    const int lo = P.ph_lo, hi = P.ph_hi;
#endif
    XcdBarrier bar; bar.bar = (unsigned*)(P.ws + WS_CTL) + CW_BAR; bar.x = 0; bar.st = nullptr;
    if (hi - lo > 1) bar = xcd_barrier_post((unsigned*)(P.ws + WS_CTL) + CW_BAR, MISC + 8);
#ifndef PH_ONLY
#define PH_ONLY -1
#endif
#ifndef DUPMASK
#define DUPMASK 0
#endif
#ifndef PH_MASK
#define PH_MASK 0xffffffffu
#endif
#define IN(k) ((PH_ONLY < 0 || PH_ONLY == (k)) && ((PH_MASK >> ((k) >= 12 ? (k) - 11 : (k))) & 1u) && lo <= (k) && (k) < hi)
#ifdef TPROBE_A
#define STAMP(k) do { if (blockIdx.x == 0 && threadIdx.x == 0) ((unsigned long long*)((unsigned*)(P.ws + WS_CTL) + CW_TS))[(k)] = __builtin_amdgcn_s_memrealtime(); } while (0)
#else
#define STAMP(k) do { } while (0)
#endif
#define T0_HERE (wave_id_ == 0 && lane_id_now() == 0)
#ifndef DUP_BAR
#define DUP_BAR 0
#endif
#define SEAM(k) do { if (IN(k) && IN((k) + 1)) { xcd_barrier(bar, T0_HERE); if (DUP_BAR) xcd_barrier(bar, T0_HERE); } STAMP((k) + 1); } while (0)
#define OPQ KP_HERE FRAME_HERE unsigned char* ws = kp->ws; float* out = kp->out; unsigned* ctl = (unsigned*)(ws + WS_CTL); float* ctlf = (float*)(ws + WS_CTL); bf16_t* HB = (bf16_t*)(ws + WS_HB); \
        const int G = F.G, bid = F.bid; (void)ctl; (void)ctlf; (void)HB; (void)out; (void)G; (void)bid; \
        stat_t* stq = (stat_t*)(ctl + CW_STAT); stat_t* st_mix = stq + (ST_MIX * 2 + l) * T; stat_t* st_cq = stq + (ST_CQ * 2 + l) * T; stat_t* st_ckv = stq + (ST_CKV * 2 + l) * T; \
        stat_t* st_x = stq + (ST_X * 2 + l) * T; stat_t* st_ffn = stq + (ST_FFN * 2 + l) * T; stat_t* stq_dummy = (stat_t*)(ctl + 600000); bf16_t* hdummy = (bf16_t*)(ws + WS_R1 + 352 * MiB); (void)stq_dummy; (void)hdummy; (void)st_mix; (void)st_cq; (void)st_ckv; (void)st_x; (void)st_ffn;

    STAMP(0);
    if (IN(0)) { KP_HERE FRAME_HERE prologue(F, kp); } SEAM(0);
#ifdef DUP_PROLOGUE
    if (IN(0)) { KP_HERE FRAME_HERE prologue(F, kp); } SEAM(0);
#endif

    for (int l = 0; l < 2; ++l) {
        const int base = l ? 12 : 1;
        for (int rep_ = 0; rep_ < (((DUPMASK >> 1) & 1) ? 2 : 1); ++rep_) {
        if (IN(base + 0)) {
#ifndef NO_MEMKV
            if (l == 0) { OPQ constexpr bool XP = F8_XPRE && F8_XATTN; constexpr int EB = XP ? 1 : 2;
                pg8::SchedMemKV S{(const char*)(ws + WS_MEMN), (const char*)(ws + WS_WXK), (const char*)(ws + WS_WXV), G, (bid + 128) % G, EB};
                epi::EpiTwo E{(bf16_t*)(ws + WS_KMEM), (bf16_t*)(ws + WS_VMEMT), 2048, 2048, (size_t)1024 * D, XP ? 1.0f / F8_SW : 0.f, XP ? 1.0f / F8_SW : 0.f};
                pg8::gemm_phase<epi::EpiTwo, pg8::SchedMemKV, false, XP>(F.lds, F.tid, D * EB, D * EB, S, E); }
#endif
            constexpr bool AMM = F8_AMM && F8_GATES;
            { OPQ constexpr int EB = AMM ? 1 : 2;
              pg8::SchedGrid S{(const char*)(AMM ? ws + WS_HB8 : (unsigned char*)HB), (const char*)(AMM ? ws + WS_WIN8X + l * SZ_WE13 : ws + WS_WIN + l * SZ_WIN), D * EB, D * EB, 64, 5, 16 * EB, G, bid, 0};
              if (rep_) { st_cq = stq_dummy; st_ckv = stq_dummy + T; }
              epi::EpiIn<3> E{st_mix, (bf16_t*)(ws + WS_R1 + R1_ZC), (bf16_t*)(ws + WS_R1 + R1_KPE), (bf16_t*)(ws + WS_R1 + R1_MQK), (bf16_t*)(ws + WS_R1 + R1_PL), (bf16_t*)(ws + WS_R1 + R1_G),
                         st_cq, st_ckv, ctlf + CW_KSUM + l * KSUM_L, (const f32x2*)(ws + WS_CS128), (const f32x2*)(ws + WS_CS64), AMM ? 1.0f / (F8_SA * F8_SW) : 1.0f};
              pg8::gemm_phase<epi::EpiIn<3>, pg8::SchedGrid, false, AMM>(F.lds, F.tid, D * EB, D * EB, S, E); }
            if (AMM) {
            { OPQ pg8::SchedGrid S{(const char*)(ws + WS_HB8), (const char*)(ws + WS_WIN8X + l * SZ_WE13), D, D, 64, A8_TILES - 5, 16, G, (bid + G - 64) % G, 5};
              float* ksum_ = rep_ ? (float*)(stq_dummy + 2 * T) : ctlf + CW_KSUM + l * KSUM_L;
              epi::EpiIn<12> E{st_mix, (bf16_t*)(ws + WS_R1 + R1_ZC), (bf16_t*)(ws + WS_R1 + R1_KPE), (bf16_t*)(ws + WS_R1 + R1_MQK), (bf16_t*)(ws + WS_R1 + R1_PL), (bf16_t*)(ws + WS_R1 + R1_G),
                         st_cq, st_ckv, ksum_, (const f32x2*)(ws + WS_CS128), (const f32x2*)(ws + WS_CS64), 1.0f / (F8_SA * F8_SW)};
              pg8::gemm_phase<epi::EpiIn<12>, pg8::SchedGrid, false, true>(F.lds, F.tid, D, D, S, E); }
            { OPQ pg8::SchedGrid S{(const char*)HB, (const char*)(ws + WS_WIN + l * SZ_WIN), 4096, 4096, 64, 20 - A8_TILES, 32, G, (A8_TILES == 12) ? bid : (bid + G - 64) % G, A8_TILES};
              epi::EpiIn<8> E{st_mix, (bf16_t*)(ws + WS_R1 + R1_ZC), (bf16_t*)(ws + WS_R1 + R1_KPE), (bf16_t*)(ws + WS_R1 + R1_MQK), (bf16_t*)(ws + WS_R1 + R1_PL), (bf16_t*)(ws + WS_R1 + R1_G),
                         st_cq, st_ckv, nullptr, (const f32x2*)(ws + WS_CS128), (const f32x2*)(ws + WS_CS64), 1.0f};
              pg8::gemm_phase<epi::EpiIn<8>, pg8::SchedGrid>(F.lds, F.tid, 4096, 4096, S, E); }
            { OPQ pg8::SchedGrid S{(const char*)(ws + WS_HB8), (const char*)(ws + WS_WING8 + (size_t)l * 6144 * D) - (size_t)20 * 256 * D, 2048, 2048, 64, 24, 16, G, bid, 20};
              epi::EpiIn<16> E{st_mix, (bf16_t*)(ws + WS_R1 + R1_ZC), (bf16_t*)(ws + WS_R1 + R1_KPE), (bf16_t*)(ws + WS_R1 + R1_MQK), (bf16_t*)(ws + WS_R1 + R1_PL), (bf16_t*)(ws + WS_R1 + R1_G),
                         st_cq, st_ckv, nullptr, (const f32x2*)(ws + WS_CS128), (const f32x2*)(ws + WS_CS64), 1.0f / (F8_SA * F8_SW)};
              pg8::gemm_phase<epi::EpiIn<16>, pg8::SchedGrid, false, true>(F.lds, F.tid, 2048, 2048, S, E); }
            } else if (F8_GATES) {
            { OPQ pg8::SchedGrid S{(const char*)HB, (const char*)(ws + WS_WIN + l * SZ_WIN), 4096, 4096, 64, 15, 32, G, (bid + G - 64) % G, 5};
              float* ksum_ = rep_ ? (float*)(stq_dummy + 2 * T) : ctlf + CW_KSUM + l * KSUM_L;
              epi::EpiIn<12> E{st_mix, (bf16_t*)(ws + WS_R1 + R1_ZC), (bf16_t*)(ws + WS_R1 + R1_KPE), (bf16_t*)(ws + WS_R1 + R1_MQK), (bf16_t*)(ws + WS_R1 + R1_PL), (bf16_t*)(ws + WS_R1 + R1_G),
                         st_cq, st_ckv, ksum_, (const f32x2*)(ws + WS_CS128), (const f32x2*)(ws + WS_CS64), 1.0f};
              pg8::gemm_phase<epi::EpiIn<12>, pg8::SchedGrid>(F.lds, F.tid, 4096, 4096, S, E); }
            { OPQ pg8::SchedGrid S{(const char*)(ws + WS_HB8), (const char*)(ws + WS_WING8 + (size_t)l * 6144 * D) - (size_t)20 * 256 * D, 2048, 2048, 64, 24, 16, G, bid, 20};
              epi::EpiIn<16> E{st_mix, (bf16_t*)(ws + WS_R1 + R1_ZC), (bf16_t*)(ws + WS_R1 + R1_KPE), (bf16_t*)(ws + WS_R1 + R1_MQK), (bf16_t*)(ws + WS_R1 + R1_PL), (bf16_t*)(ws + WS_R1 + R1_G),
                         st_cq, st_ckv, nullptr, (const f32x2*)(ws + WS_CS128), (const f32x2*)(ws + WS_CS64), 1.0f / (F8_SA * F8_SW)};
              pg8::gemm_phase<epi::EpiIn<16>, pg8::SchedGrid, false, true>(F.lds, F.tid, 2048, 2048, S, E); }
            } else {
            { OPQ pg8::SchedGrid S{(const char*)HB, (const char*)(ws + WS_WIN + l * SZ_WIN), 4096, 4096, 64, 39, 32, G, (bid + G - 64) % G, 5};
              float* ksum_ = rep_ ? (float*)(stq_dummy + 2 * T) : ctlf + CW_KSUM + l * KSUM_L;
              epi::EpiIn<28> E{st_mix, (bf16_t*)(ws + WS_R1 + R1_ZC), (bf16_t*)(ws + WS_R1 + R1_KPE), (bf16_t*)(ws + WS_R1 + R1_MQK), (bf16_t*)(ws + WS_R1 + R1_PL), (bf16_t*)(ws + WS_R1 + R1_G),
                         st_cq, st_ckv, ksum_, (const f32x2*)(ws + WS_CS128), (const f32x2*)(ws + WS_CS64), 1.0f};
              pg8::gemm_phase<epi::EpiIn<28>, pg8::SchedGrid>(F.lds, F.tid, 4096, 4096, S, E); }
            }
        }
        SEAM(base + 0);
        }
        for (int rep_ = 0; rep_ < (((DUPMASK >> 2) & 1) ? 2 : 1); ++rep_) {
        if (IN(base + 1)) {
            if (l == 0) { OPQ constexpr bool XP = F8_XPRE && F8_XATTN; constexpr int EB = XP ? 1 : 2;
                pg8::SchedXPre S{(const char*)(ws + WS_KMEM), (const char*)(ws + WS_VMEMT), (const char*)(ws + WS_WXQ), (const char*)(ws + WS_WXO), G, bid, EB};
                epi::EpiTwo E{(bf16_t*)(ws + WS_MT), (bf16_t*)(ws + WS_NT), 2048, 1024, 0, XP ? F8_SM / (F8_SX * F8_SWQ) : (F8_XATTN ? F8_SM : 0.f), XP ? F8_SN / (F8_SW * F8_SX) : (F8_XATTN ? F8_SN : 0.f)};
                pg8::gemm_phase<epi::EpiTwo, pg8::SchedXPre, false, XP>(F.lds, F.tid, D * EB, D * EB, S, E); }
            if (F8_DUP && !rep_) { OPQ
              unsigned z_ = 0u; asm volatile("" : "+v"(z_));
              for (int j = bid * NTHR + F.tid; j < T * 8; j += G * NTHR) *(u32x4*)(ws + WS_R2 + R2_OCAT + (size_t)(j >> 3) * (2 * D) + 1408 + 16 * (j & 7)) = (u32x4){z_, z_, z_, z_}; }
            { OPQ constexpr int EB = F8_B ? 1 : 2;
              pg8::SchedGrid S{(const char*)(ws + WS_R1 + R1_ZC), (const char*)(ws + WS_WUQ + l * SZ_WUQ), 1024 * EB, 512 * EB, 64, 5, 4 * EB, G, bid, 0};
              epi::EpiUQ E{(bf16_t*)(ws + WS_R2 + R2_QA), st_cq, (const f32x2*)(ws + WS_CS64), F8_B ? 1.0f / (F8_SZ * F8_SW) : 1.0f};
              pg8::gemm_phase<epi::EpiUQ, pg8::SchedGrid, false, F8_B>(F.lds, F.tid, 1024 * EB, 512 * EB, S, E); }
            { OPQ constexpr int EB = F8_B ? 1 : 2;
              pg8::SchedGrid S{(const char*)(ws + WS_R1 + R1_ZC) + 512 * EB, (const char*)(ws + WS_WUKV + l * SZ_WUKV), 1024 * EB, 512 * EB, 64, 6, 4 * EB, G, (bid + G - 64) % G, 0};
              epi::EpiPlain E{(bf16_t*)(ws + WS_R2 + R2_KVA), 1536, st_ckv, 1.0f / 512, F8_B ? 1.0f / (F8_SZ * F8_SW) : 1.0f};
              pg8::gemm_phase<epi::EpiPlain, pg8::SchedGrid, false, F8_B>(F.lds, F.tid, 1024 * EB, 512 * EB, S, E); }
        }
        SEAM(base + 1);
        }
        if (IN(base + 2)) { KP_HERE FRAME_HERE attn_phase(F, kp, l); }
        SEAM(base + 2);
#ifdef DUP_ATTN
        if (IN(base + 2)) { KP_HERE FRAME_HERE attn_phase<ATT_DBG>(F, kp, l, 1, DUP_ATTN); }
        SEAM(base + 2);
#endif
        for (int rep_ = 0; rep_ < (((DUPMASK >> 4) & 1) ? 2 : 1); ++rep_) {
        if (IN(base + 3)) {
            OPQ
            pg8::SchedUp S{(const char*)(ws + WS_R2 + R2_OCAT), (const char*)(ws + WS_WUP + l * SZ_SQ), G, bid};
            epi::EpiUp E{(const unsigned char*)(ws + WS_R1 + R1_G), (bf16_t*)(ws + WS_R2 + R2_MERGED)};
            pg8::gemm_phase<epi::EpiUp, pg8::SchedUp, false, false, false, F8_DUP>(F.lds, F.tid, 4096, 4096, S, E);
        }
        SEAM(base + 3);
        }
        for (int rep_ = 0; rep_ < (((DUPMASK >> 5) & 1) ? 2 : 1); ++rep_) {
        if (IN(base + 4)) {
            OPQ
            pg8::SchedGrid S{(const char*)(ws + WS_R2 + R2_MERGED), (const char*)(ws + WS_WO + l * SZ_SQ), 4096, 4096, 64, 8, 32, G, bid, 0};
            epi::EpiRes E{rep_ ? hdummy : HB, rep_ ? stq_dummy : st_x, (F8_XATTN && !rep_) ? ws + WS_HB8 : nullptr, 1.0f};
            pg8::gemm_phase<epi::EpiRes, pg8::SchedGrid>(F.lds, F.tid, 4096, 4096, S, E);
        }
        SEAM(base + 4);
        }
        for (int rep_ = 0; rep_ < (((DUPMASK >> 7) & 1) ? 2 : 1); ++rep_) {
        if (IN(base + 6)) {
            OPQ
            constexpr int EB = F8_XATTN ? 1 : 2;
            pg8::SchedXS2 S{(const char*)(F8_XATTN ? ws + WS_HB8 : (unsigned char*)HB), (const char*)(ws + WS_MT), l, G, bid, EB};
            epi::EpiXS E{(bf16_t*)(ws + WS_R2 + R2_PX), (LAS float*)(F.lds + LDS_EPI), st_x, F8_XATTN ? 1.0f / (F8_SA * F8_SM) : 1.0f, F8_XATTN ? F8_SP : 0.f};
            pg8::gemm_phase<epi::EpiXS, pg8::SchedXS2, true, F8_XATTN>(F.lds, F.tid, D * EB, D * EB, S, E);
        }
        SEAM(base + 6);
        }
        for (int rep_ = 0; rep_ < (((DUPMASK >> 9) & 1) ? 2 : 1); ++rep_) {
        if (IN(base + 8)) {
            OPQ
            constexpr int EB = F8_XATTN ? 1 : 2;
            pg8::SchedXO S{(const char*)(ws + WS_R2 + R2_PX), (const char*)(ws + WS_NT), l, G, bid, EB};
            epi::EpiRes E{rep_ ? hdummy : HB, rep_ ? stq_dummy : st_ffn, (l == 0 && F8_DENSE) ? ws + WS_HB8 : nullptr, F8_XATTN ? 1.0f / (F8_SP * F8_SN) : 1.0f};
            pg8::gemm_phase<epi::EpiRes, pg8::SchedXO, false, F8_XATTN>(F.lds, F.tid, 1024 * EB, 1024 * EB, S, E);
        }
        SEAM(base + 8);
        }
        if (l == 0) {
            for (int rep_ = 0; rep_ < (((DUPMASK >> 10) & 1) ? 2 : 1); ++rep_) {
        if (IN(10)) {
                OPQ
                constexpr int EB = F8_DENSE ? 1 : 2;
                pg8::SchedGrid S{(const char*)(F8_DENSE ? ws + WS_HB8 : (unsigned char*)HB), (const char*)(ws + WS_WFF13), D * EB, D * EB, 64, 44, 16 * EB, G, bid, 0};
                epi::EpiSwiglu<(F8_DENSE || F8_DDOWN)> E{ws + WS_R1 + R1_ACT, DFF, st_ffn, F8_DENSE ? 1.0f / (F8_SA * F8_SW) : 1.0f};
                pg8::gemm_phase<epi::EpiSwiglu<(F8_DENSE || F8_DDOWN)>, pg8::SchedGrid, false, F8_DENSE>(F.lds, F.tid, D * EB, D * EB, S, E);
            }
            SEAM(10);
        }
            for (int rep_ = 0; rep_ < (((DUPMASK >> 11) & 1) ? 2 : 1); ++rep_) {
        if (IN(11)) {
                OPQ
                constexpr bool F8K = F8_DENSE || F8_DDOWN; constexpr int EB = F8K ? 1 : 2;
                pg8::SchedGrid S{(const char*)(ws + WS_R1 + R1_ACT), (const char*)(ws + WS_WFF2), DFF * EB, DFF * EB, 64, 8, DFF * EB / 128, G, bid, 0};
                epi::EpiRes E{rep_ ? hdummy : HB, rep_ ? stq_dummy : stq + (ST_MIX * 2 + 1) * T, (F8_GATES && !rep_) ? ws + WS_HB8 : nullptr, F8K ? 1.0f / (F8_SA * F8_SW) : 1.0f};
                pg8::gemm_phase<epi::EpiRes, pg8::SchedGrid, false, F8K>(F.lds, F.tid, DFF * EB, DFF * EB, S, E);
            }
            SEAM(11);
        }
        } else {
            for (int rep_ = 0; rep_ < (((DUPMASK >> 21) & 1) ? 2 : 1); ++rep_) {
            if (IN(21)) { KP_HERE FRAME_HERE moe_router(F, kp, rep_); }
            SEAM(21); }
            if (IN(22)) { KP_HERE FRAME_HERE moe_assign_gather(F, kp); }
            SEAM(22);
            for (int rep_ = 0; rep_ < (((DUPMASK >> 12) & 1) ? 2 : 1); ++rep_) {
        if (IN(23)) {
                OPQ
                pg8::SchedMoE S; S.A = (const char*)(ws + WS_R2 + R2_XS); S.Bt = (const char*)(ws + WS_WE13); constexpr int EB = F8_MOE ? 1 : 2; S.lda = D * EB; S.nN = 56; S.nt = 16 * EB; S.G = G; S.c = bid; S.wstride = SZ_WE13; S.init_counts(ctl + CW_MOE);
                epi::EpiSwiglu<F8_MOE> E{ws + WS_R1 + R1_ACTE, DFE, nullptr, F8_MOE ? 1.0f / (F8_SX * F8_SW) : 1.0f};
                pg8::gemm_phase<epi::EpiSwiglu<F8_MOE>, pg8::SchedMoE, false, F8_MOE>(F.lds, F.tid, D * EB, D * EB, S, E);
            }
            SEAM(23);
        }
            for (int rep_ = 0; rep_ < (((DUPMASK >> 13) & 1) ? 2 : 1); ++rep_) {
        if (IN(24)) {
                OPQ
                constexpr int EB = F8_MOE ? 1 : 2;
                if constexpr (MOE_TAIL && F8_MOE) {
                pg8::SchedMoEDown S; S.A = (const char*)(ws + WS_R1 + R1_ACTE); S.Bt = (const char*)(ws + WS_WE2); S.lda = DFE; S.G = G; S.c = bid; S.wstride = SZ_WE2; S.init_counts(ctl + CW_MOE);
                epi::EpiMoeDown E{(bf16_t*)(ws + WS_R2 + R2_YS), (bf16_t*)(ws + WS_R2 + R2_YP), S.nb_main * 256, (size_t)(S.nused - S.nb_main) * 256 * D, 1.0f / (F8_SA * F8_SW)};
                pg8::gemm_phase<epi::EpiMoeDown, pg8::SchedMoEDown, false, true>(F.lds, F.tid, DFE, DFE, S, E);
                } else {
                pg8::SchedMoE S; S.A = (const char*)(ws + WS_R1 + R1_ACTE); S.Bt = (const char*)(ws + WS_WE2); S.lda = DFE * EB; S.nN = 8; S.nt = DFE * EB / 128; S.G = G; S.c = bid; S.wstride = SZ_WE2; S.init_counts(ctl + CW_MOE);
                epi::EpiPlain E{(bf16_t*)(ws + WS_R2 + R2_YS), 2048, nullptr, 0.f, F8_MOE ? 1.0f / (F8_SA * F8_SW) : 1.0f};
                pg8::gemm_phase<epi::EpiPlain, pg8::SchedMoE, false, F8_MOE>(F.lds, F.tid, DFE * EB, DFE * EB, S, E); }
            }
            SEAM(24);
        }
            for (int rep_ = 0; rep_ < (((DUPMASK >> 25) & 1) ? 2 : 1); ++rep_) { if (rep_) xcd_barrier(bar, T0_HERE);
            if (IN(25)) { KP_HERE FRAME_HERE moe_combine_final(F, kp); } }
        }
    }
#ifdef TPROBE_A
    xcd_barrier(bar, T0_HERE); STAMP(26);
    xcd_barrier(bar, T0_HERE);
    { const unsigned long long* ts = (const unsigned long long*)((unsigned*)(P.ws + WS_CTL) + CW_TS);
      unsigned long long ta = 0, tb = 0;
      for (int k = 0; k < 26; ++k) { const unsigned long long d = __hip_atomic_load(ts + k + 1, __ATOMIC_RELAXED, __HIP_MEMORY_SCOPE_AGENT) - __hip_atomic_load(ts + k, __ATOMIC_RELAXED, __HIP_MEMORY_SCOPE_AGENT);
          if ((TPROBE_A >> k) & 1) ta += d; if ((TPROBE_B >> k) & 1) tb += d; }
      const float k2 = (float)ta * 0.01f, k1 = (float)tb * 10.0f;
      for (size_t i = (size_t)blockIdx.x * NTHR + threadIdx.x; i < (size_t)T * D; i += (size_t)gridDim.x * NTHR) P.out[i] = (i == 0) ? k1 : k2; }
#endif
#undef IN
#undef SEAM
#undef OPQ
}

extern "C" void kernel_launch(void* const* d_in, const int* in_sizes, int n_in, void* d_out, int out_size, void* d_ws, size_t ws_size, hipStream_t stream) {
    static int grid = 0;
    if (grid == 0) {
        if (n_in != 28 || out_size != T * D || ws_size < WS_END) { fprintf(stderr, "kernel_launch: unexpected shapes (n_in %d, out %d, ws %zu, need %zu)\n", n_in, out_size, ws_size, (size_t)WS_END); grid = -1; return; }
        int dev = 0, cus = 0, per_cu = 0;
        if (hipGetDevice(&dev) != hipSuccess || hipDeviceGetAttribute(&cus, hipDeviceAttributeMultiprocessorCount, dev) != hipSuccess) { grid = -1; return; }
        if (hipFuncSetAttribute((const void*)fwd, hipFuncAttributeMaxDynamicSharedMemorySize, LDS_BYTES) != hipSuccess) { fprintf(stderr, "kernel_launch: hipFuncSetAttribute failed\n"); grid = -1; return; }
        if (hipOccupancyMaxActiveBlocksPerMultiprocessor(&per_cu, (const void*)fwd, NTHR, LDS_BYTES) != hipSuccess || per_cu < 1) { fprintf(stderr, "kernel_launch: occupancy query says %d\n", per_cu); grid = -1; (void)hipGetLastError(); return; }
        grid = cus;
    }
    if (grid < 0) return;
    (void)hipMemsetAsync((char*)d_ws + WS_CTL, 0, CTL_BYTES, stream);
    Params p{};
    p.x = (const float*)d_in[0]; p.mem = (const float*)d_in[1]; p.positions = (const int*)d_in[2];
    p.g_mix = (const float*)d_in[3]; p.w_in = (const float*)d_in[4]; p.g_cq = (const float*)d_in[5]; p.g_ckv = (const float*)d_in[6]; p.w_uq = (const float*)d_in[7]; p.w_ukv = (const float*)d_in[8];
    p.w_up_a = (const float*)d_in[9]; p.w_up_b = (const float*)d_in[10]; p.w_up_c = (const float*)d_in[11]; p.w_o = (const float*)d_in[12]; p.g_x = (const float*)d_in[13]; p.g_mem = (const float*)d_in[14];
    p.w_xq = (const float*)d_in[15]; p.w_xk = (const float*)d_in[16]; p.w_xv = (const float*)d_in[17]; p.w_xo = (const float*)d_in[18]; p.g_ffn = (const float*)d_in[19];
    p.w_ff1 = (const float*)d_in[20]; p.w_ff3 = (const float*)d_in[21]; p.w_ff2 = (const float*)d_in[22]; p.w_router = (const float*)d_in[23]; p.w_e1 = (const float*)d_in[24]; p.w_e3 = (const float*)d_in[25];
    p.w_e2 = (const float*)d_in[26]; p.g_final = (const float*)d_in[27];
    p.out = (float*)d_out; p.ws = (unsigned char*)d_ws;
#if N_LAUNCH_MODE == 1
    p.ph_lo = 0; p.ph_hi = NPH;
    hipLaunchKernelGGL(fwd, dim3(grid), dim3(NTHR), LDS_BYTES, stream, p);
#else
    for (int ph = 0; ph < NPH; ++ph) { p.ph_lo = ph; p.ph_hi = ph + 1; hipLaunchKernelGGL(fwd, dim3(grid), dim3(NTHR), LDS_BYTES, stream, p); }
#endif
}
```

```cpp
#include <hip/hip_runtime.h>
#include <cstdio>
#include <cstdint>

#define LAS __attribute__((address_space(3)))
#define DI __device__ __forceinline__
typedef unsigned short bf16_t;
typedef short bf16x8 __attribute__((ext_vector_type(8)));
typedef short s16x4 __attribute__((ext_vector_type(4)));
typedef float f32x2 __attribute__((ext_vector_type(2)));
typedef float f32x4 __attribute__((ext_vector_type(4)));
typedef float f32x16 __attribute__((ext_vector_type(16)));
typedef unsigned u32x2 __attribute__((ext_vector_type(2)));
typedef unsigned u32x4 __attribute__((ext_vector_type(4)));
typedef __bf16 bf16x2_t __attribute__((ext_vector_type(2)));

#ifndef SIMPLE_GEMM
#define SIMPLE_GEMM 0
#endif
#ifndef N_LAUNCH_MODE
#define N_LAUNCH_MODE 1
#endif

constexpr int NB = 4, SEQ = 4096, T = NB * SEQ, D = 2048;
constexpr int IN_COLS = 11072, NIN = 11264;
constexpr int DFF = 5632, NEXP = 8, DFE = 7168;
constexpr int NSLOT_BLK = 136, NSLOT = NSLOT_BLK * 256;
constexpr float EPS = 1e-6f;
constexpr float LOG2E = 1.4426950408889634f;
constexpr int NWAVES = 8, NTHR = 512;

constexpr size_t MiB = 1u << 20;
constexpr size_t WS_CTL = 0, CTL_BYTES = 4 * MiB;
constexpr size_t WS_WIN = 4 * MiB;
constexpr size_t SZ_WIN = (size_t)NIN * D * 2;
constexpr size_t WS_WUQ = WS_WIN + 2 * SZ_WIN;
constexpr size_t SZ_WUQ = (size_t)1280 * 512 * 2;
constexpr size_t WS_WUKV = WS_WUQ + 2 * SZ_WUQ;
constexpr size_t SZ_WUKV = (size_t)1536 * 512 * 2;
constexpr size_t SZ_SQ = (size_t)D * D * 2;
constexpr size_t WS_WUP = WS_WUKV + 2 * SZ_WUKV;
constexpr size_t WS_WO = WS_WUP + 2 * SZ_SQ;
constexpr size_t WS_WXQ = WS_WO + 2 * SZ_SQ;
constexpr size_t WS_WXK = WS_WXQ + 2 * SZ_SQ;
constexpr size_t WS_WXV = WS_WXK + 2 * SZ_SQ;
constexpr size_t WS_WXO = WS_WXV + 2 * SZ_SQ;
constexpr size_t WS_WFF13 = WS_WXO + 2 * SZ_SQ;
constexpr size_t WS_WFF2 = WS_WFF13 + SZ_WIN;
constexpr size_t SZ_WFF2 = (size_t)D * DFF * 2;
constexpr size_t WS_WE13 = WS_WFF2 + SZ_WFF2;
constexpr size_t SZ_WE13 = (size_t)2 * DFE * D * 2;
constexpr size_t WS_WE2 = WS_WE13 + NEXP * SZ_WE13;
constexpr size_t SZ_WE2 = (size_t)D * DFE * 2;
constexpr size_t WS_HB = WS_WE2 + NEXP * SZ_WE2;
constexpr size_t WS_CS128 = WS_HB + (size_t)T * D * 2;
constexpr size_t WS_CS64 = WS_CS128 + (size_t)T * 64 * 8;
constexpr size_t WS_MEMN = WS_CS64 + (size_t)T * 32 * 8;
constexpr size_t WS_KMEM = WS_MEMN + 8 * MiB;
constexpr size_t WS_VMEMT = WS_KMEM + 8 * MiB;
constexpr size_t WS_TOK = WS_VMEMT + 8 * MiB;
constexpr size_t WS_R1 = WS_TOK + 1 * MiB;
constexpr size_t WS_R2 = WS_R1 + 512 * MiB;
constexpr size_t WS_HB8 = WS_R2 + 288 * MiB;
constexpr size_t WS_MT = WS_HB8 + 32 * MiB;
constexpr size_t WS_NT = WS_MT + 32 * MiB;
constexpr size_t WS_WING8 = WS_NT + 32 * MiB;
constexpr size_t WS_END = WS_WING8 + 24 * MiB;
constexpr size_t WS_WIN8X = WS_WE13 + SZ_WE13 / 2;
constexpr size_t R1_ZC = 0, R1_KPE = 32 * MiB, R1_MQK = 34 * MiB, R1_PL = 74 * MiB, R1_G = 154 * MiB;
constexpr size_t R1_ACT = 0;
constexpr size_t R1_ACTE = 0;
static_assert((size_t)NSLOT * DFE * 2 <= 512 * MiB && R1_G + (size_t)T * 6144 * 2 <= 512 * MiB, "R1");
constexpr size_t R2_QA = 0, R2_KVA = 36 * MiB, R2_OCAT = 84 * MiB, R2_MERGED = 148 * MiB;
constexpr size_t R2_QX = 0, R2_PX = 64 * MiB, R2_OX = 96 * MiB;
constexpr size_t R2_XS = 0, R2_YS = 136 * MiB;
static_assert(R2_YS + (size_t)NSLOT * D * 2 <= 288 * MiB, "R2");
constexpr size_t R2_YP = 72 * MiB;

constexpr int CW_BAR = 4096;
constexpr int CW_QUEUE = 8192;
constexpr int CW_TS = 10240;
constexpr int CW_MOE = 9216;
constexpr int CW_STAT = 16384;
constexpr int CW_KSUM = CW_STAT + 20 * T;
constexpr int KSUM_L = NB * 16 * 5 * 128;
static_assert((size_t)(CW_KSUM + 2 * KSUM_L) * 4 <= CTL_BYTES, "ctl");
enum { ST_MIX = 0, ST_CQ = 1, ST_CKV = 2, ST_X = 3, ST_FFN = 4 };

constexpr int LDS_STAGE = 131072;
constexpr int LDS_EPI = LDS_STAGE;
constexpr int LDS_MISC = LDS_STAGE + 8192;
constexpr int LDS_STATP = LDS_MISC + 1024;
constexpr int LDS_BYTES = 147456;

DI unsigned cvt_pk_bf16(float lo, float hi) { f32x2 v = {lo, hi}; bf16x2_t b = __builtin_convertvector(v, bf16x2_t); return __builtin_bit_cast(unsigned, b); }
DI u32x4 pack8(f32x4 a, f32x4 b) { u32x4 w; w.x = cvt_pk_bf16(a[0], a[1]); w.y = cvt_pk_bf16(a[2], a[3]); w.z = cvt_pk_bf16(b[0], b[1]); w.w = cvt_pk_bf16(b[2], b[3]); return w; }
typedef int i32x4 __attribute__((ext_vector_type(4)));
typedef int i32x8 __attribute__((ext_vector_type(8)));
DI unsigned pk_fp8x4(float a, float b, float c, float d) {
    a = __builtin_amdgcn_fmed3f(a, -448.f, 448.f); b = __builtin_amdgcn_fmed3f(b, -448.f, 448.f); c = __builtin_amdgcn_fmed3f(c, -448.f, 448.f); d = __builtin_amdgcn_fmed3f(d, -448.f, 448.f);
    int w = 0; w = __builtin_amdgcn_cvt_pk_fp8_f32(a, b, w, false); w = __builtin_amdgcn_cvt_pk_fp8_f32(c, d, w, true); return (unsigned)w; }
DI u32x2 pack8_fp8(f32x4 a, f32x4 b) { u32x2 w; w.x = pk_fp8x4(a[0], a[1], a[2], a[3]); w.y = pk_fp8x4(b[0], b[1], b[2], b[3]); return w; }
constexpr bool F8_XATTN = true;
constexpr float F8_SM = 512.0f, F8_SN = 64.0f, F8_SP = 256.0f;
#ifndef F8_B_
#define F8_B_ true
#endif
#ifndef F8_XPRE_
#define F8_XPRE_ false
#endif
#ifndef F8_DUP_
#define F8_DUP_ true
#endif
constexpr bool F8_DUP = F8_DUP_;
constexpr float F8_SO = 64.0f;
#ifndef MOE_TAIL_
#define MOE_TAIL_ true
#endif
constexpr bool MOE_TAIL = MOE_TAIL_;
constexpr bool F8_B = F8_B_;
constexpr bool F8_XPRE = F8_XPRE_;
constexpr float F8_SZ = 32.0f, F8_SWQ = 4096.0f;
#ifndef A8_TILES
#define A8_TILES 16
#endif
constexpr bool F8_AMM = true;
constexpr bool F8_GATES = true;
constexpr bool F8_DENSE = false, F8_MOE = true, F8_DDOWN = true;
constexpr float F8_SW = 512.0f, F8_SA = 8.0f, F8_SX = 16.0f;
DI i32x8 cat8(bf16x8 lo, bf16x8 hi) { const i32x4 a = __builtin_bit_cast(i32x4, lo), b = __builtin_bit_cast(i32x4, hi); return (i32x8){a[0], a[1], a[2], a[3], b[0], b[1], b[2], b[3]}; }
template <int N> DI float ubf(unsigned w) { return (float)((w >> (8 * N)) & 0xffu); }
DI float bf_lo(unsigned w) { return __uint_as_float(w << 16); }
DI float bf_hi(unsigned w) { return __uint_as_float(w & 0xffff0000u); }
typedef unsigned long long stat_t;
constexpr float STAT_SCALE = 16777216.0f, STAT_INV = 1.0f / 16777216.0f;
DI void atomic_adds(stat_t* p, float v) { __hip_atomic_fetch_add(p, (stat_t)(v * STAT_SCALE), __ATOMIC_RELAXED, __HIP_MEMORY_SCOPE_AGENT); }
DI void atomic_addf(float* p, float v) { __hip_atomic_fetch_add(p, v, __ATOMIC_RELAXED, __HIP_MEMORY_SCOPE_AGENT); }
template <int M> DI float swz_xor(float v) { return __int_as_float(__builtin_amdgcn_ds_swizzle(__float_as_int(v), 0x1f | (M << 10))); }
DI float half_sum(float v) { auto rr = __builtin_amdgcn_permlane32_swap(__float_as_uint(v), __float_as_uint(v), false, false); return __uint_as_float(rr[0]) + __uint_as_float(rr[1]); }
DI float half_max(float v) { auto rr = __builtin_amdgcn_permlane32_swap(__float_as_uint(v), __float_as_uint(v), false, false); return fmaxf(__uint_as_float(rr[0]), __uint_as_float(rr[1])); }
DI float wave_sum(float v) { v += swz_xor<1>(v); v += swz_xor<2>(v); v += swz_xor<4>(v); v += swz_xor<8>(v); v += swz_xor<16>(v); return half_sum(v); }
DI int lane_id_now() { int l; asm volatile("v_mbcnt_lo_u32_b32 %0, -1, 0\n\tv_mbcnt_hi_u32_b32 %0, -1, %0" : "=v"(l)); return l; }
DI float fast_exp2(float x) { return __builtin_amdgcn_exp2f(x); }
DI float fast_log2(float x) { return __builtin_amdgcn_logf(x); }
DI float fast_rcp(float x) { return __builtin_amdgcn_rcpf(x); }
DI float sigmoidf_(float x) { return fast_rcp(1.0f + fast_exp2(-x * LOG2E)); }

#define XB_TMO      128
#define XB_XCNT(j)  (256  + 64 * (j))
#define XB_XSUB(j)  (1280 + 64 * (j))
#define XB_XGEN(j)  (2304 + 64 * (j))
#define XB_TOP      3328
#define XB_TOPGEN   3392
#define XCD_BAR_WORDS 3456
#define XB_SPIN_CAP (1u << 18)

__device__ __forceinline__ unsigned xb_ld(unsigned* p)              { return __hip_atomic_load(p, __ATOMIC_RELAXED, __HIP_MEMORY_SCOPE_AGENT); }
__device__ __forceinline__ unsigned xb_add(unsigned* p, unsigned v) { return __hip_atomic_fetch_add(p, v, __ATOMIC_RELAXED, __HIP_MEMORY_SCOPE_AGENT); }
__device__ __forceinline__ unsigned xb_xcc_id() { return (unsigned)__builtin_amdgcn_s_getreg((3 << 11) | 20) & 0xFu; }
#define XB_SPIN(cond, bar) do { unsigned _sp = 0; while (cond) { __builtin_amdgcn_s_sleep(1); \
    if ((++_sp & 255u) == 0u) { if (xb_ld(&(bar)[XB_TMO])) break; if (_sp > XB_SPIN_CAP) { atomicAdd(&(bar)[XB_TMO], 1u); break; } } } } while (0)

struct XcdBarrier { unsigned* bar; unsigned x; volatile LAS unsigned* st; };

__device__ __forceinline__ XcdBarrier xcd_barrier_post(unsigned* bar, volatile LAS unsigned* st) {
    XcdBarrier b; b.bar = bar; b.x = xb_xcc_id(); b.st = st;
    if (threadIdx.x == 0) (void)xb_add(&bar[XB_XCNT(b.x)], 1u);
    return b;
}
__device__ __forceinline__ void xcd_barrier_complete(unsigned* bar, unsigned x, unsigned& nloc, unsigned& nx) {
    const unsigned G = gridDim.x * gridDim.y * gridDim.z;
    unsigned sum, cnt, mine, sp = 0u;
    for (;;) {
        sum = 0u; cnt = 0u; mine = 0u;
#pragma unroll
        for (unsigned j = 0; j < 16; ++j) { const unsigned c = xb_ld(&bar[XB_XCNT(j)]); sum += c; cnt += (c > 0u) ? 1u : 0u; mine = (j == x) ? c : mine; }
        if (sum == G) break;
        __builtin_amdgcn_s_sleep(1);
        if ((++sp & 255u) == 0u) { if (xb_ld(&bar[XB_TMO])) break; if (sp > XB_SPIN_CAP) { atomicAdd(&bar[XB_TMO], 1u); break; } }
    }
    nloc = mine > 0u ? mine : 1u; nx = cnt > 0u ? cnt : 1u;
}
__device__ __forceinline__ void xcd_barrier(const XcdBarrier& b, const bool thread0  ) {
    asm volatile("s_waitcnt vmcnt(0)" ::: "memory");
    __syncthreads();
    unsigned bx = b.x; asm volatile("" : "+s"(bx));
    if (thread0) {
        unsigned* bar = b.bar; asm volatile("" : "+s"(bar));
        __builtin_amdgcn_s_waitcnt(0);
        unsigned nloc = b.st[0], nx = b.st[1];
        if (nloc == 0u) { xcd_barrier_complete(bar, bx, nloc, nx); b.st[0] = nloc; b.st[1] = nx; }
        const unsigned old = xb_add(&bar[XB_XSUB(bx)], 1u);
        const unsigned gen = old / nloc;
        if (old + 1u == (gen + 1u) * nloc) {
            __builtin_amdgcn_fence(__ATOMIC_RELEASE, "agent");
            asm volatile("s_waitcnt vmcnt(0)" ::: "memory");
            const unsigned og = xb_add(&bar[XB_TOP], 1u);
            const unsigned tg = og / nx;
            if (og + 1u == (tg + 1u) * nx) xb_add(&bar[XB_TOPGEN], 1u);
            else XB_SPIN(xb_ld(&bar[XB_TOPGEN]) == tg, bar);
            __builtin_amdgcn_fence(__ATOMIC_ACQUIRE, "agent");
            xb_add(&bar[XB_XGEN(bx)], 1u);
            asm volatile("s_waitcnt vmcnt(0)" ::: "memory");
        } else {
            XB_SPIN(xb_ld(&bar[XB_XGEN(bx)]) == gen, bar);
            __builtin_amdgcn_fence(__ATOMIC_ACQUIRE, "agent");
            asm volatile("s_waitcnt vmcnt(0)" ::: "memory");
        }
    }
    __syncthreads();
}

namespace pg8 {
constexpr int BM = 256, BK = 64, HALF = 128, HTB = HALF * BK * 2, STAGE_BYTES = 8 * HTB, NXCD = 8, WGM = 8;
DI int lds_byte(int r, int c) { const int st = (r >> 4) * 2 + (c >> 5), rr = r & 15, cc = c & 31, ob = rr * 64 + cc * 2; return st * 1024 + (ob ^ (((ob >> 9) & 1) << 5)); }
DI void stage_rc(int b, int& R, int& C) { const int st = b / 1024, sb = b % 1024, swz = sb ^ (((sb >> 9) & 1) << 5); R = (st >> 1) * 16 + swz / 64; C = (st & 1) * 32 + (swz % 64) / 2; }
DI int perm32(int rho) { const int n = rho >> 4, i = rho & 15; return 8 * (i >> 2) + 4 * n + (i & 3); }

struct Unit { int pm, pn, aux, nt; const char* a; const char* b; int sp, bar; };

DI void tile_order(int L, int nM, int nN, int& pm, int& pn) {
    const int nwg = nM * nN; int wgid = L;
    { const int q = nwg / NXCD, r = nwg % NXCD, xcd = wgid % NXCD, off = wgid / NXCD; wgid = (xcd < r ? xcd * (q + 1) : r * (q + 1) + (xcd - r) * q) + off; }
    const int nig = WGM * nN, gid = wgid / nig, fm = gid * WGM, gsz = (nM - fm) < WGM ? (nM - fm) : WGM;
    pm = fm + ((wgid % nig) % gsz); pn = (wgid % nig) / gsz;
}

typedef f32x4 Acc[2][2][4][2];

#if !SIMPLE_GEMM
#ifndef ALIGN_DEFAULT
#define ALIGN_DEFAULT true
#endif
template <class Epi, class Sched, bool ALIGN_EPI_ = false, bool FP8 = false, bool NOALIGN = false, bool MIX = false>
DI void gemm_phase(LAS unsigned char* lds, const int tid_in, const int lda, const int ldb, const Sched& S, const Epi& E) {
    constexpr bool ALIGN_EPI = ALIGN_EPI_ || (ALIGN_DEFAULT && !NOALIGN); constexpr bool F8L = FP8 || MIX;
    int tid_ = tid_in; asm volatile("" : "+v"(tid_));
    const int tid = tid_, wid = __builtin_amdgcn_readfirstlane(tid >> 6), lane = tid & 63, wr = wid >> 2, wc = wid & 3, fr = lane & 15, fq = lane >> 4;
    unsigned voffA[2], voffB[2], voffAh[2], voffBh[2];
#pragma unroll
    for (int i = 0; i < 2; ++i) { int R, C; stage_rc(tid * 16 + i * 8192, R, C); const int Rb = (R & ~31) + perm32(R & 31);
        voffA[i] = (unsigned)(R * lda + C * 2); voffB[i] = (unsigned)(Rb * ldb + C * 2); voffAh[i] = voffA[i] + (unsigned)(HALF * lda); voffBh[i] = voffB[i] + (unsigned)(HALF * ldb); }
    const size_t kstep = (size_t)(BK * 2);
    const unsigned ldsw = (unsigned)wid * 1024u;
    const int aoff = lds_byte(wr * 64 + fr, fq * 8), boff = lds_byte(wc * 32 + fr, fq * 8);
#define PG8_SA(b, h) (((b) * 2 + (h)) * HTB)
#define PG8_SB(b, h) ((4 + (b) * 2 + (h)) * HTB)
#define PG8_STAGE(bufoff, gbase, voff) do { _Pragma("unroll") for (int _i = 0; _i < 2; ++_i) \
        __builtin_amdgcn_global_load_lds((const unsigned*)((const char*)(gbase) + (voff)[_i]), (LAS unsigned*)(lds + (bufoff) + ldsw + _i * 8192), 16, 0, 0); } while (0)
#define PG8_STAGE_AH(bufoff, gbase) do { if constexpr (MIX) PG8_STAGE(bufoff, (gbase) + (size_t)HALF * lda, voffA); else PG8_STAGE(bufoff, gbase, voffAh); } while (0)
#define PG8_STAGE_BH(bufoff, gbase) do { if constexpr (MIX) PG8_STAGE(bufoff, (gbase) + (size_t)HALF * ldb, voffB); else PG8_STAGE(bufoff, gbase, voffBh); } while (0)
#define PG8_LD8(p) ({ const i32x4 lo_ = *(const LAS i32x4*)(p), hi_ = *(const LAS i32x4*)((p) + 1024); (i32x8){lo_[0], lo_[1], lo_[2], lo_[3], hi_[0], hi_[1], hi_[2], hi_[3]}; })
#define PG8_LDA(dst, b, h) do { _Pragma("unroll") for (int m = 0; m < 4; ++m) { if constexpr (F8L) dst##8[m] = PG8_LD8(lds + PG8_SA(b, h) + aoff + m * 2048); \
        else { _Pragma("unroll") for (int k = 0; k < 2; ++k) dst[m][k] = *(const LAS bf16x8*)(lds + PG8_SA(b, h) + aoff + m * 2048 + k * 1024); } } } while (0)
#define PG8_LDB(dst, b, h) do { _Pragma("unroll") for (int n = 0; n < 2; ++n) { if constexpr (F8L) dst##8[n] = PG8_LD8(lds + PG8_SB(b, h) + boff + n * 2048); \
        else { _Pragma("unroll") for (int k = 0; k < 2; ++k) dst[n][k] = *(const LAS bf16x8*)(lds + PG8_SB(b, h) + boff + n * 2048 + k * 1024); } } } while (0)
#define PG8_H0(x) __builtin_bit_cast(bf16x8, __builtin_shufflevector(x, x, 0, 1, 2, 3))
#define PG8_H1(x) __builtin_bit_cast(bf16x8, __builtin_shufflevector(x, x, 4, 5, 6, 7))
#define PG8_MMA(MODE, ai, bj, At, Bt) do { __builtin_amdgcn_s_setprio(1);   \
        if constexpr ((MODE) == 1) { _Pragma("unroll") for (int m = 0; m < 4; ++m) _Pragma("unroll") for (int n = 0; n < 2; ++n) \
            asm volatile("v_mfma_scale_f32_16x16x128_f8f6f4 %0, %1, %2, %0, %3, %3 op_sel_hi:[0,0,0]" : "+v"(acc[ai][bj][m][n]) : "v"(Bt##8[n]), "v"(At##8[m]), "v"(f8one)); } \
        else if constexpr ((MODE) == 2) {   \
            _Pragma("unroll") for (int m = 0; m < 4; ++m) _Pragma("unroll") for (int n = 0; n < 2; ++n) \
                asm volatile("v_mfma_f32_16x16x32_bf16 %0, %1, %2, %0" : "+v"(acc[ai][bj][m][n]) : "v"(PG8_H0(Bt##8[n])), "v"(PG8_H0(At##8[m]))); \
            _Pragma("unroll") for (int m = 0; m < 4; ++m) _Pragma("unroll") for (int n = 0; n < 2; ++n) \
                asm volatile("v_mfma_f32_16x16x32_bf16 %0, %1, %2, %0" : "+v"(acc[ai][bj][m][n]) : "v"(PG8_H1(Bt##8[n])), "v"(PG8_H1(At##8[m]))); } \
        else { _Pragma("unroll") for (int m = 0; m < 4; ++m) _Pragma("unroll") for (int n = 0; n < 2; ++n) _Pragma("unroll") for (int k = 0; k < 2; ++k) \
            acc[ai][bj][m][n] = __builtin_amdgcn_mfma_f32_16x16x32_bf16(Bt[n][k], At[m][k], acc[ai][bj][m][n], 0, 0, 0); } \
        __builtin_amdgcn_s_setprio(0); } while (0)
#define PG8_WAIT_V(n) asm volatile("s_waitcnt vmcnt(" #n ")" ::: "memory")
#define PG8_WAIT_L(n) asm volatile("s_waitcnt lgkmcnt(" #n ")" ::: "memory")
#define PG8_BAR __builtin_amdgcn_s_barrier()
#define PG8_SCHED __builtin_amdgcn_sched_barrier(0)
#define PG8_KLOOP(MODE) \
        for (int t = 0; t < nt; t += 2) { \
            const bool last = (t == nt - 2); \
            const char* a1 = cA + (size_t)(t + 1) * kstep; \
            const char* a2 = last ? nA : cA + (size_t)(t + 2) * kstep; const char* b2 = last ? nB : cB + (size_t)(t + 2) * kstep; \
            const char* a3 = a2 + kstep; const char* b3 = b2 + kstep; \
            PG8_LDB(B0, 0, 0); PG8_LDB(B1, 0, 1); PG8_SCHED; PG8_LDA(At, 0, 0); PG8_STAGE_AH(PG8_SA(1, 1), a1); \
            PG8_WAIT_V(8); PG8_WAIT_L(0); PG8_BAR; PG8_MMA(MODE, 0, 0, At, B0); PG8_MMA(MODE, 0, 1, At, B1); PG8_BAR; PG8_SCHED; \
            PG8_LDA(At, 0, 1); PG8_STAGE(PG8_SB(0, 0), b2, voffB); PG8_STAGE_BH(PG8_SB(0, 1), b2); PG8_STAGE(PG8_SA(0, 0), a2, voffA); \
            PG8_WAIT_V(8); PG8_WAIT_L(0); PG8_BAR; PG8_MMA(MODE, 1, 0, At, B0); PG8_MMA(MODE, 1, 1, At, B1); PG8_BAR; PG8_SCHED; \
            PG8_LDB(B0, 1, 0); PG8_LDB(B1, 1, 1); PG8_SCHED; PG8_LDA(At, 1, 0); PG8_STAGE_AH(PG8_SA(0, 1), a2); \
            PG8_WAIT_V(8); PG8_WAIT_L(0); PG8_BAR; PG8_MMA(MODE, 0, 0, At, B0); PG8_MMA(MODE, 0, 1, At, B1); PG8_BAR; PG8_SCHED; \
            PG8_LDA(At, 1, 1); PG8_STAGE(PG8_SB(1, 0), b3, voffB); PG8_STAGE_BH(PG8_SB(1, 1), b3); PG8_STAGE(PG8_SA(1, 0), a3, voffA); \
            PG8_WAIT_V(8); PG8_WAIT_L(0); PG8_BAR; PG8_MMA(MODE, 1, 0, At, B0); PG8_MMA(MODE, 1, 1, At, B1); PG8_BAR; PG8_SCHED; \
        }
    const stat_t* const sp_src = E.stat_src();
#define PG8_STATDMA(unit, par, ln) do { if (sp_src && wid < 2) __builtin_amdgcn_global_load_lds((const unsigned*)((const char*)(sp_src + (size_t)(unit).pm * 256) + (wid * 64 + (ln)) * 16), \
        (LAS unsigned*)(lds + LDS_STATP + (par) * 2048 + wid * 1024), 16, 0, 0); } while (0)
    Unit cur, nxt; int ui = 0;
    if (!S.next(0, cur)) return;
    PG8_STATDMA(cur, 0, lane);
    Acc acc;
#pragma unroll
    for (int a = 0; a < 2; ++a)
#pragma unroll
        for (int b = 0; b < 2; ++b)
#pragma unroll
            for (int m = 0; m < 4; ++m)
#pragma unroll
                for (int n = 0; n < 2; ++n) acc[a][b][m][n] = (f32x4){0.f, 0.f, 0.f, 0.f};
    bf16x8 At[4][2], B0[2][2], B1[2][2]; i32x8 At8[4], B08[2], B18[2];
    int f8one = 0x7f7f7f7f; asm volatile("" : "+v"(f8one));
    const char* cA = cur.a; const char* cB = cur.b;
    PG8_STAGE(PG8_SB(0, 0), cB, voffB); PG8_STAGE_BH(PG8_SB(0, 1), cB); PG8_STAGE(PG8_SA(0, 0), cA, voffA); PG8_STAGE_AH(PG8_SA(0, 1), cA);
    if (wr == 1) PG8_BAR;
    PG8_WAIT_V(2); PG8_BAR;
    PG8_STAGE(PG8_SB(1, 0), cB + kstep, voffB); PG8_STAGE(PG8_SA(1, 0), cA + kstep, voffA); PG8_STAGE_BH(PG8_SB(1, 1), cB + kstep);
    PG8_WAIT_V(6); PG8_BAR;
#define PG8_UNIT(MODE) { \
        const bool has_next = S.next(ui + 1, nxt); \
        const char* nA = has_next ? nxt.a : cA; const char* nB = has_next ? nxt.b : cB; \
        const int nt = cur.nt; \
        PG8_KLOOP(MODE) \
        if constexpr ((MODE) != 0) asm volatile("s_nop 15\n\ts_nop 15" ::: "memory");     \
        if constexpr (ALIGN_EPI && !Epi::BAR_INSIDE) { if (wr == 0) PG8_BAR; } \
        cur.bar = (ALIGN_EPI && Epi::BAR_INSIDE && wr == 0) ? 1 : 0; \
        const int le_ = lane_id_now();                                 \
        if (has_next) PG8_STATDMA(nxt, (ui + 1) & 1, le_); \
        cur.sp = (int)(unsigned)(unsigned long long)(lds + LDS_STATP + (ui & 1) * 2048); \
        const bool keep = E(acc, cur, wr, wc, le_ & 15, le_ >> 4); \
        if (!has_next) break; \
        if (!keep) { \
            _Pragma("unroll") for (int a = 0; a < 2; ++a) _Pragma("unroll") for (int b = 0; b < 2; ++b) _Pragma("unroll") for (int m = 0; m < 4; ++m) _Pragma("unroll") for (int n = 0; n < 2; ++n) acc[a][b][m][n] = (f32x4){0.f, 0.f, 0.f, 0.f}; \
        } \
        cur = nxt; cA = nA; cB = nB; ++ui; \
        if constexpr (ALIGN_EPI) { if (wr == 1) PG8_BAR; } }
    for (;;) {
        if constexpr (MIX) { PG8_UNIT(1) PG8_UNIT(1) PG8_UNIT(2) }
        else if constexpr (FP8) { PG8_UNIT(1) } else { PG8_UNIT(0) }
    }
    PG8_WAIT_V(0);
    if constexpr (!ALIGN_EPI) { if (wr == 0) PG8_BAR; }
    PG8_BAR;
#undef PG8_SA
#undef PG8_SB
#undef PG8_STAGE
#undef PG8_STAGE_AH
#undef PG8_STAGE_BH
#undef PG8_LDA
#undef PG8_LD8
#undef PG8_LDB
#undef PG8_MMA
#undef PG8_KLOOP
#undef PG8_STATDMA
#undef PG8_UNIT
#undef PG8_H0
#undef PG8_H1
#undef PG8_WAIT_V
#undef PG8_WAIT_L
#undef PG8_BAR
#undef PG8_SCHED
}
#else
template <class Epi, class Sched, bool ALIGN_EPI = false, bool FP8 = false>
DI void gemm_phase(LAS unsigned char* lds, const int tid_in, const int lda, const int ldb, const Sched& S, const Epi& E) {
    static_assert(!FP8, "the debug fallback is bf16 only");
    const int tid = tid_in, wid = __builtin_amdgcn_readfirstlane(tid >> 6), lane = tid & 63, wr = wid >> 2, wc = wid & 3, fr = lane & 15, fq = lane >> 4;
    Unit cur; Acc acc; bool keep = false;
    for (int ui = 0; S.next(ui, cur); ++ui) {
        if (!keep) {
#pragma unroll
            for (int a = 0; a < 2; ++a)
#pragma unroll
                for (int b = 0; b < 2; ++b)
#pragma unroll
                    for (int m = 0; m < 4; ++m)
#pragma unroll
                        for (int n = 0; n < 2; ++n) acc[a][b][m][n] = (f32x4){0.f, 0.f, 0.f, 0.f};
        }
        for (int k0 = 0; k0 < cur.nt * 64; k0 += 32) {
            bf16x8 Af[2][4], Bf[2][2];
#pragma unroll
            for (int ai = 0; ai < 2; ++ai)
#pragma unroll
                for (int m = 0; m < 4; ++m) Af[ai][m] = *(const bf16x8*)(cur.a + (size_t)(ai * 128 + wr * 64 + m * 16 + fr) * lda + (size_t)(k0 + fq * 8) * 2);
#pragma unroll
            for (int bj = 0; bj < 2; ++bj)
#pragma unroll
                for (int n = 0; n < 2; ++n) Bf[bj][n] = *(const bf16x8*)(cur.b + (size_t)(bj * 128 + wc * 32 + perm32(n * 16 + fr)) * ldb + (size_t)(k0 + fq * 8) * 2);
#pragma unroll
            for (int ai = 0; ai < 2; ++ai)
#pragma unroll
                for (int bj = 0; bj < 2; ++bj)
#pragma unroll
                    for (int m = 0; m < 4; ++m)
#pragma unroll
                        for (int n = 0; n < 2; ++n) acc[ai][bj][m][n] = __builtin_amdgcn_mfma_f32_16x16x32_bf16(Bf[bj][n], Af[ai][m], acc[ai][bj][m][n], 0, 0, 0);
        }
        if constexpr (ALIGN_EPI) __syncthreads();
        keep = E(acc, cur, wr, wc, fr, fq);
        if constexpr (ALIGN_EPI) __syncthreads();
    }
    __syncthreads();
}
#endif

struct SchedGrid {
    const char* A; const char* Bt; int lda, ldb, nM, nN, nt, G, c, pn0;
    DI bool next(int i, Unit& u) const {
        const long L = (long)i * G + c; if (L >= (long)nM * nN) return false;
        tile_order((int)L, nM, nN, u.pm, u.pn); u.pn += pn0; u.aux = 0; u.nt = nt;
        u.a = A + (size_t)u.pm * 256 * lda; u.b = Bt + (size_t)u.pn * 256 * ldb; return true;
    }
};
}

namespace epi {
using pg8::Acc; using pg8::Unit;
DI float row_rs(const stat_t* stat, int row, float inv_n) { return __builtin_amdgcn_rsqf((float)stat[row] * STAT_INV * inv_n + EPS); }

DI void load_rs(const stat_t* stat, int row0, float inv_n, float mul, float (&rs)[2][4]) {
    stat_t v[2][4];
#pragma unroll
    for (int ai = 0; ai < 2; ++ai)
#pragma unroll
        for (int m = 0; m < 4; ++m) v[ai][m] = stat ? stat[row0 + ai * 128 + m * 16] : (stat_t)0;
#pragma unroll
    for (int ai = 0; ai < 2; ++ai)
#pragma unroll
        for (int m = 0; m < 4; ++m) rs[ai][m] = stat ? mul * __builtin_amdgcn_rsqf((float)v[ai][m] * STAT_INV * inv_n + EPS) : mul;
}
DI void load_rs_lds(bool has, int sp, int rl0, float inv_n, float mul, float (&rs)[2][4]) {
    const LAS stat_t* sb = (const LAS stat_t*)(size_t)(unsigned)sp; stat_t v[2][4];
#pragma unroll
    for (int ai = 0; ai < 2; ++ai)
#pragma unroll
        for (int m = 0; m < 4; ++m) v[ai][m] = has ? sb[rl0 + ai * 128 + m * 16] : (stat_t)0;
#pragma unroll
    for (int ai = 0; ai < 2; ++ai)
#pragma unroll
        for (int m = 0; m < 4; ++m) rs[ai][m] = has ? mul * __builtin_amdgcn_rsqf((float)v[ai][m] * STAT_INV * inv_n + EPS) : mul;
}
DI void stat_atomics(const float (&ss)[2][4], stat_t* stat, int row0, int fq) {
#pragma unroll
    for (int ai = 0; ai < 2; ++ai)
#pragma unroll
        for (int m = 0; m < 4; ++m) { float s = ss[ai][m]; s += swz_xor<16>(s); s = half_sum(s);
            if (fq == 0) atomic_adds(stat + row0 + ai * 128 + m * 16, s); }
}

template <int EMASK> struct EpiIn {
    const stat_t* stat_in; bf16_t* ZC; bf16_t* KPE; bf16_t* MQK; bf16_t* PL; bf16_t* G;
    stat_t* stat_cq; stat_t* stat_ckv; float* ksum; const f32x2* cs128; const f32x2* cs64; float dsc;
    static constexpr bool BAR_INSIDE = false;
    DI const stat_t* stat_src() const { return stat_in; }
    DI bool operator()(Acc& acc, const Unit& u, int wr, int wc, int fr, int fq) const {
        asm volatile("" : "+v"(fr), "+v"(fq));
        const int row0 = u.pm * 256 + wr * 64 + fr, tile = u.pn;
        float rs[2][4]; load_rs_lds(stat_in != nullptr, u.sp, wr * 64 + fr, 1.0f / D, dsc, rs);
        if ((EMASK & 1) && tile < 4) {
            float ss[2][4];
#pragma unroll
            for (int ai = 0; ai < 2; ++ai)
#pragma unroll
                for (int m = 0; m < 4; ++m) { const int row = row0 + ai * 128 + m * 16; const float rsv = rs[ai][m]; float s = 0.f;
#pragma unroll
                    for (int bj = 0; bj < 2; ++bj) { const f32x4 v0 = acc[ai][bj][m][0] * rsv, v1 = acc[ai][bj][m][1] * rsv;
                        s += (v0[0] * v0[0] + v0[1] * v0[1]) + (v0[2] * v0[2] + v0[3] * v0[3]) + (v1[0] * v1[0] + v1[1] * v1[1]) + (v1[2] * v1[2] + v1[3] * v1[3]);
                        if constexpr (F8_B) *(u32x2*)((unsigned char*)ZC + (size_t)row * 1024 + tile * 256 + bj * 128 + wc * 32 + 8 * fq) = pack8_fp8(v0 * F8_SZ, v1 * F8_SZ);
                        else *(u32x4*)(ZC + (size_t)row * 1024 + tile * 256 + bj * 128 + wc * 32 + 8 * fq) = pack8(v0, v1); }
                    ss[ai][m] = s; }
            stat_atomics(ss, tile < 2 ? stat_cq : stat_ckv, row0, fq);
        } else if ((EMASK & 2) && tile == 4) {
            if (wc == 0) {
#pragma unroll
                for (int ai = 0; ai < 2; ++ai)
#pragma unroll
                    for (int m = 0; m < 4; ++m) { const int row = row0 + ai * 128 + m * 16; const float rsv = rs[ai][m]; const f32x2* cs = cs64 + (size_t)row * 32 + 8 * fq;
                        f32x4 o1[2], o2[2];
#pragma unroll
                        for (int n = 0; n < 2; ++n)
#pragma unroll
                            for (int e = 0; e < 4; ++e) { const f32x2 c = cs[4 * n + e]; const float x1 = acc[ai][0][m][n][e] * rsv, x2 = acc[ai][1][m][n][e] * rsv;
                                o1[n][e] = x1 * c.x - x2 * c.y; o2[n][e] = x2 * c.x + x1 * c.y; }
                        *(u32x4*)(KPE + (size_t)row * 64 + 8 * fq) = pack8(o1[0], o1[1]);
                        *(u32x4*)(KPE + (size_t)row * 64 + 32 + 8 * fq) = pack8(o2[0], o2[1]); }
            }
        } else if ((EMASK & 4) && tile < 10) {
            const int tt = tile - 5, hd = 2 * tt + (wc >> 1), dl0 = (32 * wc + 8 * fq) & 63;
            f32x4 cs1[2], cs2[2];
#pragma unroll
            for (int n = 0; n < 2; ++n) { cs1[n] = (f32x4){0.f, 0.f, 0.f, 0.f}; cs2[n] = (f32x4){0.f, 0.f, 0.f, 0.f}; }
#pragma unroll
            for (int ai = 0; ai < 2; ++ai)
#pragma unroll
                for (int m = 0; m < 4; ++m) { const int row = row0 + ai * 128 + m * 16; const float rsv = rs[ai][m]; const f32x2* cs = cs128 + (size_t)row * 64 + dl0;
                    f32x4 o1[2], o2[2];
#pragma unroll
                    for (int n = 0; n < 2; ++n)
#pragma unroll
                        for (int e = 0; e < 4; ++e) { const f32x2 c = cs[4 * n + e]; const float x1 = acc[ai][0][m][n][e] * rsv, x2 = acc[ai][1][m][n][e] * rsv;
                            o1[n][e] = x1 * c.x - x2 * c.y; o2[n][e] = x2 * c.x + x1 * c.y; }
                    *(u32x4*)(MQK + (size_t)row * 1280 + hd * 128 + dl0) = pack8(o1[0], o1[1]);
                    *(u32x4*)(MQK + (size_t)row * 1280 + hd * 128 + 64 + dl0) = pack8(o2[0], o2[1]);
                    cs1[0] += o1[0]; cs1[1] += o1[1]; cs2[0] += o2[0]; cs2[1] += o2[1]; }
            if (hd >= 5) {
                float* kd = ksum + ((size_t)u.pm * 5 + (hd - 5)) * 128 + dl0;
#pragma unroll
                for (int n = 0; n < 2; ++n)
#pragma unroll
                    for (int e = 0; e < 4; ++e) { float a = cs1[n][e], b = cs2[n][e];
                        a += swz_xor<1>(a); b += swz_xor<1>(b); a += swz_xor<2>(a); b += swz_xor<2>(b); a += swz_xor<4>(a); b += swz_xor<4>(b); a += swz_xor<8>(a); b += swz_xor<8>(b);
                        if (fr == 0) { atomic_addf(kd + 4 * n + e, a); atomic_addf(kd + 64 + 4 * n + e, b); } }
            }
        } else if ((EMASK & 8) && tile < 20) {
#pragma unroll
            for (int ai = 0; ai < 2; ++ai)
#pragma unroll
                for (int m = 0; m < 4; ++m) { const int row = row0 + ai * 128 + m * 16; const float rsv = rs[ai][m];
#pragma unroll
                    for (int bj = 0; bj < 2; ++bj)
                        *(u32x4*)(PL + (size_t)row * 2560 + (tile - 10) * 256 + bj * 128 + wc * 32 + 8 * fq) = pack8(acc[ai][bj][m][0] * rsv, acc[ai][bj][m][1] * rsv); }
        } else if (EMASK & 16) {
            unsigned char* G8 = (unsigned char*)G;
#pragma unroll
            for (int ai = 0; ai < 2; ++ai)
#pragma unroll
                for (int m = 0; m < 4; ++m) { const int row = row0 + ai * 128 + m * 16; const float rsn = rs[ai][m] * -LOG2E;
#pragma unroll
                    for (int bj = 0; bj < 2; ++bj) { unsigned q[8];
#pragma unroll
                        for (int e = 0; e < 8; ++e) { const float t = acc[ai][bj][m][e >> 2][e & 3] * rsn;
                            q[e] = __float_as_uint(fmaxf(__builtin_fmaf(fast_rcp(1.0f + fast_exp2(t)), 255.0f, 8388608.0f), 8388609.0f)); }
                        u32x2 w; w.x = __builtin_amdgcn_perm(__builtin_amdgcn_perm(q[3], q[2], 0x0c0c0400u), __builtin_amdgcn_perm(q[1], q[0], 0x0c0c0400u), 0x05040100u);
                        w.y = __builtin_amdgcn_perm(__builtin_amdgcn_perm(q[7], q[6], 0x0c0c0400u), __builtin_amdgcn_perm(q[5], q[4], 0x0c0c0400u), 0x05040100u);
                        *(u32x2*)(G8 + (size_t)row * 6144 + (tile - 20) * 256 + bj * 128 + wc * 32 + 8 * fq) = w; } }
        }
        return false;
    }
};

struct EpiPlain {
    bf16_t* O; int ldo; const stat_t* stat; float inv_n; float osc;
    static constexpr bool BAR_INSIDE = false;
    DI const stat_t* stat_src() const { return stat; }
    DI bool operator()(Acc& acc, const Unit& u, int wr, int wc, int fr, int fq) const {
        asm volatile("" : "+v"(fr), "+v"(fq));
        const int row0 = u.pm * 256 + wr * 64 + fr;
        float rs[2][4]; load_rs_lds(stat != nullptr, u.sp, wr * 64 + fr, inv_n, osc, rs);
#pragma unroll
        for (int ai = 0; ai < 2; ++ai)
#pragma unroll
            for (int m = 0; m < 4; ++m) { const int row = row0 + ai * 128 + m * 16; const float r = rs[ai][m];
#pragma unroll
                for (int bj = 0; bj < 2; ++bj)
                    *(u32x4*)(O + (size_t)row * ldo + u.pn * 256 + bj * 128 + wc * 32 + 8 * fq) = pack8(acc[ai][bj][m][0] * r, acc[ai][bj][m][1] * r); }
        return false;
    }
};

struct EpiMoeDown {
    bf16_t* YS; bf16_t* YP; int tail_row0; size_t slab; float osc;
    static constexpr bool BAR_INSIDE = false;
    DI const stat_t* stat_src() const { return nullptr; }
    DI bool operator()(Acc& acc, const Unit& u, int wr, int wc, int fr, int fq) const {
        asm volatile("" : "+v"(fr), "+v"(fq));
        const int row0 = u.pm * 256 + wr * 64 + fr;
        bf16_t* O = u.aux ? YP + (size_t)(u.aux - 1) * slab - (size_t)tail_row0 * D : YS;
#pragma unroll
        for (int ai = 0; ai < 2; ++ai)
#pragma unroll
            for (int m = 0; m < 4; ++m) { const int row = row0 + ai * 128 + m * 16;
#pragma unroll
                for (int bj = 0; bj < 2; ++bj)
                    *(u32x4*)(O + (size_t)row * D + u.pn * 256 + bj * 128 + wc * 32 + 8 * fq) = pack8(acc[ai][bj][m][0] * osc, acc[ai][bj][m][1] * osc); }
        return false;
    }
};

struct EpiUQ {
    bf16_t* QA; const stat_t* stat; const f32x2* cs64; float dsc;
    static constexpr bool BAR_INSIDE = false;
    DI const stat_t* stat_src() const { return stat; }
    DI bool operator()(Acc& acc, const Unit& u, int wr, int wc, int fr, int fq) const {
        asm volatile("" : "+v"(fr), "+v"(fq));
        const int row0 = u.pm * 256 + wr * 64 + fr, tile = u.pn;
        float rs[2][4]; load_rs_lds(stat != nullptr, u.sp, wr * 64 + fr, 1.0f / 512, dsc, rs);
        if (tile < 3) {
#pragma unroll
            for (int ai = 0; ai < 2; ++ai)
#pragma unroll
                for (int m = 0; m < 4; ++m) { const int row = row0 + ai * 128 + m * 16; const float r = rs[ai][m];
#pragma unroll
                    for (int bj = 0; bj < 2; ++bj) { const int h = tile * 2 + bj;
                        *(u32x4*)(QA + (size_t)row * 1152 + h * 192 + wc * 32 + 8 * fq) = pack8(acc[ai][bj][m][0] * r, acc[ai][bj][m][1] * r); } }
        } else { const int h = (tile - 3) * 4 + wc;
            if (h < 6) {
#pragma unroll
                for (int g = 0; g < 4; ++g) { const int ai = g >> 1, mb = (g & 1) * 2;
                    f32x4 cs[2][4];
#pragma unroll
                    for (int mm = 0; mm < 2; ++mm) { const f32x4* cp = (const f32x4*)(cs64 + (size_t)(row0 + ai * 128 + (mb + mm) * 16) * 32 + 8 * fq);
#pragma unroll
                        for (int q = 0; q < 4; ++q) cs[mm][q] = cp[q]; }
#pragma unroll
                    for (int mm = 0; mm < 2; ++mm) { const int m = mb + mm; const int row = row0 + ai * 128 + m * 16; const float r = rs[ai][m]; f32x4 o1[2], o2[2];
#pragma unroll
                        for (int n = 0; n < 2; ++n)
#pragma unroll
                            for (int e = 0; e < 4; ++e) { const f32x4 cc = cs[mm][2 * n + (e >> 1)]; const float c = cc[2 * (e & 1)], sn = cc[2 * (e & 1) + 1];
                                const float x1 = acc[ai][0][m][n][e] * r, x2 = acc[ai][1][m][n][e] * r; o1[n][e] = x1 * c - x2 * sn; o2[n][e] = x2 * c + x1 * sn; }
                        *(u32x4*)(QA + (size_t)row * 1152 + h * 192 + 128 + 8 * fq) = pack8(o1[0], o1[1]);
                        *(u32x4*)(QA + (size_t)row * 1152 + h * 192 + 160 + 8 * fq) = pack8(o2[0], o2[1]); }
                    asm volatile("" ::: "memory"); } } }
        return false;
    }
};

struct EpiUp {
    const unsigned char* G; bf16_t* MERGED;
    static constexpr bool BAR_INSIDE = true;
    DI const stat_t* stat_src() const { return nullptr; }
    DI bool operator()(Acc& acc, const Unit& u, int wr, int wc, int fr, int fq) const {
        asm volatile("" : "+v"(fr), "+v"(fq));
        const int row0 = u.pm * 256 + wr * 64 + fr, br = u.aux; const int col0 = u.pn * 256 + wc * 32 + 8 * fq;
        const bool fin = br == 2; const int gboff = fin ? 0 : 2048; const float bs = (F8_DUP && br == 1) ? F8_SO * F8_SW : 1.0f;
        u32x2 ga[2][4][2], gb[2][4][2];
#pragma unroll
        for (int ai = 0; ai < 2; ++ai)
#pragma unroll
            for (int m = 0; m < 4; ++m)
#pragma unroll
                for (int bj = 0; bj < 2; ++bj) { const unsigned char* gp = G + (size_t)(row0 + ai * 128 + m * 16) * 6144 + br * 2048 + col0 + bj * 128; ga[ai][m][bj] = *(const u32x2*)gp; gb[ai][m][bj] = *(const u32x2*)(gp + gboff); }
        if (u.bar) { asm volatile("" ::: "memory"); __builtin_amdgcn_s_barrier(); asm volatile("" ::: "memory"); }
#pragma unroll
        for (int ai = 0; ai < 2; ++ai)
#pragma unroll
            for (int m = 0; m < 4; ++m)
#pragma unroll
                for (int bj = 0; bj < 2; ++bj) {
#pragma unroll
                    for (int q = 0; q < 2; ++q) { const unsigned a = ga[ai][m][bj][q], b = gb[ai][m][bj][q];
                        const float d0 = fin ? (1.0f / 255.0f) : fast_rcp(ubf<0>(b) * bs), d1 = fin ? (1.0f / 255.0f) : fast_rcp(ubf<1>(b) * bs),
                                    d2 = fin ? (1.0f / 255.0f) : fast_rcp(ubf<2>(b) * bs), d3 = fin ? (1.0f / 255.0f) : fast_rcp(ubf<3>(b) * bs);
                        acc[ai][bj][m][q][0] *= ubf<0>(a) * d0; acc[ai][bj][m][q][1] *= ubf<1>(a) * d1;
                        acc[ai][bj][m][q][2] *= ubf<2>(a) * d2; acc[ai][bj][m][q][3] *= ubf<3>(a) * d3; }
                    if (fin) *(u32x4*)(MERGED + (size_t)(row0 + ai * 128 + m * 16) * D + col0 + bj * 128) = pack8(acc[ai][bj][m][0], acc[ai][bj][m][1]); }
        return !fin;
    }
};

struct EpiRes {
    bf16_t* HB; stat_t* stat; unsigned char* HB8; float dsc;
    static constexpr bool BAR_INSIDE = true;
    DI const stat_t* stat_src() const { return nullptr; }
    DI bool operator()(Acc& acc, const Unit& u, int wr, int wc, int fr, int fq) const {
        asm volatile("" : "+v"(fr), "+v"(fq));
        const int row0 = u.pm * 256 + wr * 64 + fr; float ss[2][4]; const int col0 = u.pn * 256 + wc * 32 + 8 * fq;
#pragma unroll
        for (int ai = 0; ai < 2; ++ai) {
            u32x4 h[4][2];
#pragma unroll
            for (int m = 0; m < 4; ++m)
#pragma unroll
                for (int bj = 0; bj < 2; ++bj) h[m][bj] = *(const u32x4*)(HB + (size_t)(row0 + ai * 128 + m * 16) * D + col0 + bj * 128);
            if (ai == 0 && u.bar) { asm volatile("" ::: "memory"); __builtin_amdgcn_s_barrier(); asm volatile("" ::: "memory"); }
#pragma unroll
            for (int m = 0; m < 4; ++m) { float s = 0.f;
#pragma unroll
                for (int bj = 0; bj < 2; ++bj) { const size_t off = (size_t)(row0 + ai * 128 + m * 16) * D + col0 + bj * 128; const u32x4 hw = h[m][bj];
                    const f32x4 v0 = (f32x4){bf_lo(hw[0]), bf_hi(hw[0]), bf_lo(hw[1]), bf_hi(hw[1])} + acc[ai][bj][m][0] * dsc, v1 = (f32x4){bf_lo(hw[2]), bf_hi(hw[2]), bf_lo(hw[3]), bf_hi(hw[3])} + acc[ai][bj][m][1] * dsc;
                    *(u32x4*)(HB + off) = pack8(v0, v1);
                    if (HB8) *(u32x2*)(HB8 + off) = pack8_fp8(v0 * F8_SA, v1 * F8_SA);
                    s += (v0[0] * v0[0] + v0[1] * v0[1]) + (v0[2] * v0[2] + v0[3] * v0[3]) + (v1[0] * v1[0] + v1[1] * v1[1]) + (v1[2] * v1[2] + v1[3] * v1[3]); }
                ss[ai][m] = s; }
            asm volatile("" ::: "memory"); }
        stat_atomics(ss, stat, row0, fq);
        return false;
    }
};

template <bool F8> struct EpiSwiglu {
    void* Ov; int ldo; const stat_t* stat; float dsc;
    static constexpr bool BAR_INSIDE = false;
    DI const stat_t* stat_src() const { return stat; }
    DI bool operator()(Acc& acc, const Unit& u, int wr, int wc, int fr, int fq) const {
        asm volatile("" : "+v"(fr), "+v"(fq));
        const int row0 = u.pm * 256 + wr * 64 + fr;
        float rs[2][4]; load_rs_lds(stat != nullptr, u.sp, wr * 64 + fr, 1.0f / D, dsc, rs);
#pragma unroll
        for (int ai = 0; ai < 2; ++ai)
#pragma unroll
            for (int m = 0; m < 4; ++m) { const int row = row0 + ai * 128 + m * 16; const float r = rs[ai][m];
                f32x4 o[2]; const float rn = r * -LOG2E, rb = r * (F8 ? F8_SA : 1.0f);
#pragma unroll
                for (int n = 0; n < 2; ++n) { const f32x4 a = acc[ai][0][m][n] * r, t = acc[ai][0][m][n] * rn, b = acc[ai][1][m][n] * rb; f32x4 sg;
#pragma unroll
                    for (int e = 0; e < 4; ++e) sg[e] = fast_rcp(1.0f + fast_exp2(t[e]));
                    o[n] = (a * sg) * b; }
                if constexpr (F8) *(u32x2*)((unsigned char*)Ov + (size_t)row * ldo + u.pn * 128 + wc * 32 + 8 * fq) = pack8_fp8(o[0], o[1]);
                else *(u32x4*)((bf16_t*)Ov + (size_t)row * ldo + u.pn * 128 + wc * 32 + 8 * fq) = pack8(o[0], o[1]); }
        return false;
    }
};

struct EpiXS {
    bf16_t* PX; LAS float* scr; const stat_t* stat; float dsc; float p8;
    static constexpr bool BAR_INSIDE = false;
    DI const stat_t* stat_src() const { return stat; }
    DI bool operator()(Acc& acc, const Unit& u, int wr, int wc, int fr, int fq) const {
        asm volatile("" : "+v"(fr), "+v"(fq));
        const int row0 = u.pm * 256 + wr * 64 + fr;
        { float rs[2][4]; load_rs_lds(stat != nullptr, u.sp, wr * 64 + fr, 1.0f / D, dsc, rs);
#pragma unroll
        for (int ai = 0; ai < 2; ++ai)
#pragma unroll
            for (int m = 0; m < 4; ++m)
#pragma unroll
                for (int bj = 0; bj < 2; ++bj) { acc[ai][bj][m][0] *= rs[ai][m]; acc[ai][bj][m][1] *= rs[ai][m]; } }
        asm volatile("" ::: "memory");
#pragma unroll
        for (int ai = 0; ai < 2; ++ai)
#pragma unroll
            for (int m = 0; m < 4; ++m) { float v = -3.0e38f;
#pragma unroll
                for (int bj = 0; bj < 2; ++bj)
#pragma unroll
                    for (int n = 0; n < 2; ++n)
#pragma unroll
                        for (int e = 0; e < 4; ++e) v = fmaxf(v, acc[ai][bj][m][n][e]);
                v = fmaxf(v, swz_xor<16>(v)); v = half_max(v);
                if (fq == 0) scr[(ai * 128 + wr * 64 + m * 16 + fr) * 4 + wc] = v; }
        asm volatile("s_waitcnt lgkmcnt(0)" ::: "memory"); __builtin_amdgcn_s_barrier(); asm volatile("" ::: "memory");
#pragma unroll
        for (int ai = 0; ai < 2; ++ai)
#pragma unroll
            for (int m = 0; m < 4; ++m) { const f32x4 q = *(const LAS f32x4*)(scr + (ai * 128 + wr * 64 + m * 16 + fr) * 4);
                const float mxr = fmaxf(fmaxf(q[0], q[1]), fmaxf(q[2], q[3])); float s = 0.f;
#pragma unroll
                for (int bj = 0; bj < 2; ++bj)
#pragma unroll
                    for (int n = 0; n < 2; ++n)
#pragma unroll
                        for (int e = 0; e < 4; ++e) { const float p = fast_exp2(acc[ai][bj][m][n][e] - mxr); acc[ai][bj][m][n][e] = p; s += p; }
                s += swz_xor<16>(s); s = half_sum(s);
                if (fq == 0) scr[1024 + (ai * 128 + wr * 64 + m * 16 + fr) * 4 + wc] = s; }
        asm volatile("s_waitcnt lgkmcnt(0)" ::: "memory"); __builtin_amdgcn_s_barrier(); asm volatile("" ::: "memory");
#pragma unroll
        for (int ai = 0; ai < 2; ++ai)
#pragma unroll
            for (int m = 0; m < 4; ++m) { const int row = row0 + ai * 128 + m * 16; const f32x4 q = *(const LAS f32x4*)(scr + 1024 + (ai * 128 + wr * 64 + m * 16 + fr) * 4);
                const float inv = (p8 > 0.f ? p8 : 1.0f) / ((q[0] + q[1]) + (q[2] + q[3]));
#pragma unroll
                for (int bj = 0; bj < 2; ++bj) {
                    if (p8 > 0.f) *(u32x2*)((unsigned char*)PX + (size_t)row * 1024 + u.pn * 256 + bj * 128 + wc * 32 + 8 * fq) = pack8_fp8(acc[ai][bj][m][0] * inv, acc[ai][bj][m][1] * inv);
                    else *(u32x4*)(PX + (size_t)row * 1024 + u.pn * 256 + bj * 128 + wc * 32 + 8 * fq) = pack8(acc[ai][bj][m][0] * inv, acc[ai][bj][m][1] * inv); } }
        return false;
    }
};
}

namespace pg8 {
struct SchedUp {
    const char* A; const char* Bt; int G, c;
    DI bool next(int i, Unit& u) const {
        const int tr = i / 3, br = i - 3 * tr; const long L = (long)tr * G + c; if (L >= 64 * 8) return false;
        tile_order((int)L, 64, 8, u.pm, u.pn); u.aux = br;
        if (F8_DUP) { u.nt = br == 2 ? 10 : 6; const int kb = br == 0 ? 0 : (br == 1 ? 768 : 2816);
            u.a = A + (size_t)u.pm * 256 * D * 2 + kb; u.b = Bt + (size_t)u.pn * 256 * D * 2 + kb; return true; }
        u.nt = br == 0 ? 12 : 10;
        const int koff = br == 0 ? 0 : (br == 1 ? 768 : 1408);
        u.a = A + ((size_t)u.pm * 256 * D + koff) * 2; u.b = Bt + ((size_t)u.pn * 256 * D + koff) * 2; return true;
    }
};
struct SchedXS {
    const char* QX; const char* KM; int G, c;
    DI bool next(int i, Unit& u) const {
        const long L = (long)i * G + c; if (L >= 256) return false;
        const int hd = (int)L & 3, rt = (int)L >> 2;
        u.pm = rt; u.pn = hd; u.aux = 0; u.nt = 8;
        u.a = QX + ((size_t)rt * 256 * D + hd * 512) * 2; u.b = KM + ((size_t)(rt >> 4) * 256 * D + hd * 512) * 2; return true;
    }
};
struct SchedXPV {
    const char* PX; const char* VT; int G, c;
    DI bool next(int i, Unit& u) const {
        const long L = (long)i * G + c; if (L >= 512) return false;
        const int pn = (int)L & 7, rt = (int)L >> 3;
        u.pm = rt; u.pn = pn; u.aux = 0; u.nt = 4;
        u.a = PX + ((size_t)rt * 256 * 1024 + (pn >> 1) * 256) * 2; u.b = VT + ((size_t)pn * 256 * 1024 + (rt >> 4) * 256) * 2; return true;
    }
};
struct MoeTail { int nused, nb_main, f; };
DI MoeTail moe_tail_plan(const unsigned* counts, int G) {
    int b = 0;
#pragma unroll
    for (int e = 0; e < 8; ++e) { const unsigned cnt = __hip_atomic_load(counts + 64 * e, __ATOMIC_RELAXED, __HIP_MEMORY_SCOPE_AGENT); b += (int)((cnt + 255u) >> 8); }
    MoeTail p; p.nused = b; p.nb_main = b; p.f = 1;
    if (MOE_TAIL && F8_MOE && (G & 7) == 0) { const int total = b * 8, nfull = (total / G) * G, R = total - nfull;
        const int f = R == 0 ? 1 : (R * 14 <= G ? 14 : (R * 7 <= G ? 7 : (R * 4 <= G ? 4 : (R * 2 <= G ? 2 : 1))));
        if (f > 1) { p.f = f; p.nb_main = nfull / 8; } }
    return p;
}
struct SchedMoE {
    const char* A; const char* Bt; int lda, nN, nt, G, c; size_t wstride; int nused; int bend[8];
    DI void init_counts(const unsigned* counts) { int b = 0;
#pragma unroll
        for (int e = 0; e < 8; ++e) { const unsigned cnt = __hip_atomic_load(counts + 64 * e, __ATOMIC_RELAXED, __HIP_MEMORY_SCOPE_AGENT); b += (int)((cnt + 255u) >> 8); bend[e] = b; }
        nused = b; }
    DI bool next(int i, Unit& u) const {
        const long L = (long)i * G + c; if (L >= (long)nused * nN) return false;
        tile_order((int)L, nused, nN, u.pm, u.pn); u.aux = 0; u.nt = nt;
        int e = 0;
#pragma unroll
        for (int q = 0; q < 7; ++q) e += (u.pm >= bend[q]) ? 1 : 0;
        u.a = A + (size_t)u.pm * 256 * lda; u.b = Bt + (size_t)e * wstride + (size_t)u.pn * 256 * (size_t)(nt * 128); return true;
    }
};
struct SchedMoEDown {
    const char* A; const char* Bt; int lda, G, c; size_t wstride; int nused, nb_main, f; int bend[8];
    DI void init_counts(const unsigned* counts) { int b = 0;
#pragma unroll
        for (int e = 0; e < 8; ++e) { const unsigned cnt = __hip_atomic_load(counts + 64 * e, __ATOMIC_RELAXED, __HIP_MEMORY_SCOPE_AGENT); b += (int)((cnt + 255u) >> 8); bend[e] = b; }
        const MoeTail p = moe_tail_plan(counts, G); nused = p.nused; nb_main = p.nb_main; f = p.f; }
    DI bool next(int i, Unit& u) const {
        const long L = (long)i * G + c; const int nmain = nb_main * 8; int koff = 0;
        if (L < nmain) { tile_order((int)L, nb_main, 8, u.pm, u.pn); u.aux = 0; u.nt = 56; }
        else { const int s_ = (int)(L - nmain), R = (nused - nb_main) * 8; if (s_ >= R * f) return false;
            const int j = s_ / R, t = s_ - j * R; u.pm = nb_main + (t >> 3); u.pn = t & 7; u.aux = j; u.nt = 56 / f; koff = j * u.nt * 128; }
        int e = 0;
#pragma unroll
        for (int q = 0; q < 7; ++q) e += (u.pm >= bend[q]) ? 1 : 0;
        u.a = A + (size_t)u.pm * 256 * lda + koff; u.b = Bt + (size_t)e * wstride + (size_t)u.pn * 256 * (size_t)lda + koff; return true;
    }
};
}

struct Params {
    const float* x; const float* mem; const int* positions;
    const float *g_mix, *w_in, *g_cq, *g_ckv, *w_uq, *w_ukv, *w_up_a, *w_up_b, *w_up_c, *w_o, *g_x, *g_mem, *w_xq, *w_xk, *w_xv, *w_xo, *g_ffn, *w_ff1, *w_ff3, *w_ff2, *w_router, *w_e1, *w_e3, *w_e2, *g_final;
    float* out; unsigned char* ws; int ph_lo, ph_hi;
};
struct Frame { LAS unsigned char* lds; int tid, lane, wave, G, bid; };
typedef const __attribute__((address_space(4))) Params* KPtr;
#define KP_HERE KPtr kp = (KPtr)__builtin_amdgcn_kernarg_segment_ptr(); asm volatile("" : "+s"(kp));
#define FRAME_HERE Frame F; { int w_ = wave_id_; asm volatile("" : "+s"(w_)); int t_ = w_ * 64 + lane_id_now(), b_ = blockIdx.x, g_ = gridDim.x; asm volatile("" : "+v"(t_)); asm volatile("" : "+s"(b_), "+s"(g_)); \
        F.lds = (LAS unsigned char*)lds_; F.tid = t_; F.lane = t_ & 63; F.wave = __builtin_amdgcn_readfirstlane(t_ >> 6); F.G = g_; F.bid = b_; }


template <bool F8, class Map>
DI void transpose_cvt(const Frame& F, const float* __restrict__ W, int ldw, int K, void* __restrict__ dstv, int ldd, int koff, int ngroups, const float* __restrict__ gain, Map map, int& rot) {
    bf16_t* dst = (bf16_t*)dstv; unsigned char* dst8 = (unsigned char*)dstv;
    LAS float* scr = (LAS float*)(F.lds + F.wave * 17408);
    const int NGW = F.G * NWAVES, gw = F.bid * NWAVES + F.wave, lane = F.lane;
    if (F8 && (K & 127) == 0) {
        const int items8 = (K / 128) * ngroups, c8 = lane & 7, nl = lane >> 3;
        int it8 = gw - rot; if (it8 < 0) it8 += NGW;
        for (; it8 < items8; it8 += NGW) {
            const int kb = it8 / ngroups, ng = it8 - kb * ngroups, k0 = kb * 128;
            int src; float sc; map(ng, src, sc);
            if (src == -2) continue;
            if (src < 0) {
#pragma unroll
                for (int j = 0; j < 4; ++j) *(u32x4*)(dst8 + (size_t)(ng * 32 + nl + 8 * j) * ldd + koff + k0 + 16 * c8) = (u32x4){0u, 0u, 0u, 0u};
                continue;
            }
            f32x4 v[16];
#pragma unroll
            for (int i = 0; i < 16; ++i) v[i] = *(const f32x4*)(W + (size_t)(k0 + 8 * i + nl) * ldw + src + 4 * c8);
#pragma unroll
            for (int i = 0; i < 16; ++i) { const float g = (gain ? gain[k0 + 8 * i + nl] : 1.0f) * sc;
                LAS float* sp = scr + (8 * (i >> 1) + nl + 64 * (i & 1)) * 33 + 4 * c8; sp[0] = v[i][0] * g; sp[1] = v[i][1] * g; sp[2] = v[i][2] * g; sp[3] = v[i][3] * g; }
            asm volatile("s_waitcnt lgkmcnt(0)" ::: "memory");
#pragma unroll
            for (int j = 0; j < 4; ++j) { const int n = nl + 8 * j; const LAS float* sp = scr + (8 * c8) * 33 + n; const LAS float* sq = sp + 64 * 33; u32x4 o;
                o.x = pk_fp8x4(sp[0 * 33], sp[1 * 33], sp[2 * 33], sp[3 * 33]); o.y = pk_fp8x4(sp[4 * 33], sp[5 * 33], sp[6 * 33], sp[7 * 33]);
                o.z = pk_fp8x4(sq[0 * 33], sq[1 * 33], sq[2 * 33], sq[3 * 33]); o.w = pk_fp8x4(sq[4 * 33], sq[5 * 33], sq[6 * 33], sq[7 * 33]);
                *(u32x4*)(dst8 + (size_t)(ng * 32 + n) * ldd + koff + k0 + 16 * c8) = o; }
            asm volatile("s_waitcnt lgkmcnt(0)" ::: "memory");
        }
        rot = (rot + items8) % NGW;
        return;
    }
    const int items = (K / 64) * ngroups;
    int it = gw - rot; if (it < 0) it += NGW;
    for (; it < items; it += NGW) {
        int kb, ng; if (F8 && !((K / 64) & 1) && !(rot & 1)) { const int pi = it >> 1, kp = pi / ngroups; ng = pi - kp * ngroups; kb = 2 * kp + (it & 1); } else { kb = it / ngroups; ng = it - kb * ngroups; }
        const int k0 = kb * 64;
        int src; float sc; map(ng, src, sc);
        const int c8 = lane & 7;
        if (src == -2) continue;
        if (src < 0) {
#pragma unroll
            for (int j = 0; j < 4; ++j) { const int n = (lane >> 3) + 8 * j; if constexpr (F8) *(u32x2*)(dst8 + (size_t)(ng * 32 + n) * ldd + koff + k0 + 8 * c8) = (u32x2){0u, 0u}; else *(u32x4*)(dst + (size_t)(ng * 32 + n) * ldd + koff + k0 + 8 * c8) = (u32x4){0u, 0u, 0u, 0u}; }
            continue;
        }
        f32x4 v[8];
#pragma unroll
        for (int i = 0; i < 8; ++i) { const int kk = 8 * i + (lane >> 3); v[i] = *(const f32x4*)(W + (size_t)(k0 + kk) * ldw + src + 4 * c8); }
#pragma unroll
        for (int i = 0; i < 8; ++i) { const int kk = 8 * i + (lane >> 3); const float g = (gain ? gain[k0 + kk] : 1.0f) * sc;
            LAS float* s = scr + kk * 33 + 4 * c8; s[0] = v[i][0] * g; s[1] = v[i][1] * g; s[2] = v[i][2] * g; s[3] = v[i][3] * g; }
        asm volatile("s_waitcnt lgkmcnt(0)" ::: "memory");
#pragma unroll
        for (int j = 0; j < 4; ++j) { const int n = (lane >> 3) + 8 * j; const LAS float* s = scr + (8 * c8) * 33 + n;
            if constexpr (F8) { u32x2 o; o.x = pk_fp8x4(s[0 * 33], s[1 * 33], s[2 * 33], s[3 * 33]); o.y = pk_fp8x4(s[4 * 33], s[5 * 33], s[6 * 33], s[7 * 33]);
                *(u32x2*)(dst8 + (size_t)(ng * 32 + n) * ldd + koff + k0 + 8 * c8) = o; }
            else { u32x4 o; o.x = cvt_pk_bf16(s[0 * 33], s[1 * 33]); o.y = cvt_pk_bf16(s[2 * 33], s[3 * 33]); o.z = cvt_pk_bf16(s[4 * 33], s[5 * 33]); o.w = cvt_pk_bf16(s[6 * 33], s[7 * 33]);
                *(u32x4*)(dst + (size_t)(ng * 32 + n) * ldd + koff + k0 + 8 * c8) = o; } }
        asm volatile("s_waitcnt lgkmcnt(0)" ::: "memory");
    }
    rot = (rot + items) % NGW;
}

DI void prologue(const Frame& F, KPtr kp) {
    unsigned char* ws = kp->ws; int rot = 0;
    const float QS128 = 0.08838834764831845f * LOG2E, QS192 = 0.07216878364870322f * LOG2E, QS512 = 0.04419417382415922f * LOG2E;
    for (int l = 0; l < 2; ++l) {
        if (F8_GATES) transpose_cvt<true>(F, kp->w_in + (size_t)l * D * IN_COLS, IN_COLS, D, ws + WS_WING8 + (size_t)l * 6144 * D, D, 0, 6144 / 32, kp->g_mix + l * D,
            [=](int ng, int& src, float& sc) { sc = F8_SW; src = 4928 + ng * 32; }, rot);
        auto win_map = [=](int ng, int& src, float& sc) { sc = 1.0f; const int n = ng * 32;
                if (n < 1024) { src = n; }
                else if (n < 1280) { const int p = n - 1024; src = (p == 0) ? 1024 : (p == 128 ? 1056 : -1); }
                else if (n < 2560) { const int tt = (n - 1280) >> 8, p = (n - 1280) & 255, bj = p >> 7, pp = p & 127, hd = 2 * tt + (pp >> 6), d = (pp & 63) + 64 * bj; src = 1088 + hd * 128 + d; if (hd < 5) sc = QS128; }
                else if (n < 5120) { src = 2368 + (n - 2560); if (src >= 3008 && src < 3648) sc = QS128; }
                else { src = 4928 + (n - 5120); } };
        constexpr int NG8 = (F8_AMM && F8_GATES) ? A8_TILES * 256 / 32 : 0;
        if (NG8) transpose_cvt<true>(F, kp->w_in + (size_t)l * D * IN_COLS, IN_COLS, D, ws + WS_WIN8X + l * SZ_WE13, D, 0, NG8, kp->g_mix + l * D,
            [=](int ng, int& src, float& sc) { win_map(ng, src, sc); sc *= F8_SW; }, rot);
        transpose_cvt<false>(F, kp->w_in + (size_t)l * D * IN_COLS, IN_COLS, D, (bf16_t*)(ws + WS_WIN + l * SZ_WIN) + (size_t)NG8 * 32 * D, D, 0, (F8_GATES ? 5120 : NIN) / 32 - NG8, kp->g_mix + l * D,
            [=](int ng, int& src, float& sc) { win_map(ng + NG8, src, sc); }, rot);
        transpose_cvt<F8_B>(F, kp->w_uq + (size_t)l * 512 * 1152, 1152, 512, ws + WS_WUQ + l * SZ_WUQ, 512, 0, 1280 / 32, kp->g_cq + l * 512,
            [=](int ng, int& src, float& sc) { sc = F8_B ? QS192 * F8_SW : QS192; const int n = ng * 32;
                if (n < 768) { src = (n >> 7) * 192 + (n & 127); }
                else { const int rt = (n - 768) >> 8, p = (n - 768) & 255, bj = p >> 7, hh = (p & 127) >> 5, h = 4 * rt + hh; src = h < 6 ? h * 192 + 128 + 32 * bj : -1; } }, rot);
        transpose_cvt<F8_B>(F, kp->w_ukv + (size_t)l * 512 * 1536, 1536, 512, ws + WS_WUKV + l * SZ_WUKV, 512, 0, 1536 / 32, kp->g_ckv + l * 512,
            [=](int ng, int& src, float& sc) { sc = F8_B ? F8_SW : 1.0f; src = ng * 32; }, rot);
        bf16_t* wup = (bf16_t*)(ws + WS_WUP + l * SZ_SQ);
        if (F8_DUP) {
            transpose_cvt<true>(F, kp->w_up_a + (size_t)l * 768 * D, D, 768, wup, 2 * D, 0, D / 32, nullptr, [=](int ng, int& src, float& sc) { sc = F8_SW; src = ng * 32; }, rot);
            transpose_cvt<true>(F, kp->w_up_b + (size_t)l * 640 * D, D, 640, wup, 2 * D, 768, D / 32, nullptr, [=](int ng, int& src, float& sc) { sc = F8_SW; src = ng * 32; }, rot);
            transpose_cvt<true>(F, kp->w_up_b + (size_t)l * 640 * D, D, 128, wup, 2 * D, 1408, D / 32, nullptr, [=](int ng, int& src, float& sc) { sc = 1.0f; src = -1; }, rot);
        } else {
        transpose_cvt<false>(F, kp->w_up_a + (size_t)l * 768 * D, D, 768, wup, D, 0, D / 32, nullptr, [=](int ng, int& src, float& sc) { sc = 1.0f; src = ng * 32; }, rot);
        transpose_cvt<false>(F, kp->w_up_b + (size_t)l * 640 * D, D, 640, wup, D, 768, D / 32, nullptr, [=](int ng, int& src, float& sc) { sc = 1.0f; src = ng * 32; }, rot); }
        transpose_cvt<false>(F, kp->w_up_c + (size_t)l * 640 * D, D, 640, wup, D, 1408, D / 32, nullptr, [=](int ng, int& src, float& sc) { sc = 1.0f; src = ng * 32; }, rot);
        transpose_cvt<false>(F, kp->w_o + (size_t)l * D * D, D, D, (bf16_t*)(ws + WS_WO + l * SZ_SQ), D, 0, D / 32, nullptr, [=](int ng, int& src, float& sc) { sc = 1.0f; src = ng * 32; }, rot);
        {
          const float* W = kp->w_xq + (size_t)l * D * D; bf16_t* O = (bf16_t*)(ws + WS_WXQ + l * SZ_SQ); const float* gx = kp->g_x + l * D;
          for (int c = F.bid * NTHR + F.tid; c < D * D / 8; c += F.G * NTHR) { const float g = gx[c >> 8] * (F8_XPRE ? QS512 * F8_SWQ : QS512);
              const f32x4 a = __builtin_nontemporal_load((const f32x4*)(W + (size_t)c * 8)), b = __builtin_nontemporal_load((const f32x4*)(W + (size_t)c * 8 + 4));
              if constexpr (F8_XPRE) *(u32x2*)((unsigned char*)O + (size_t)c * 8) = pack8_fp8(a * g, b * g);
              else *(u32x4*)(O + (size_t)c * 8) = pack8(a * g, b * g); } }
        transpose_cvt<F8_XPRE>(F, kp->w_xk + (size_t)l * D * D, D, D, ws + WS_WXK + l * SZ_SQ, D, 0, D / 32, nullptr, [=](int ng, int& src, float& sc) { sc = F8_XPRE ? F8_SW : 1.0f; src = ng * 32; }, rot);
        transpose_cvt<F8_XPRE>(F, kp->w_xv + (size_t)l * D * D, D, D, ws + WS_WXV + l * SZ_SQ, D, 0, D / 32, nullptr, [=](int ng, int& src, float& sc) { sc = F8_XPRE ? F8_SW : 1.0f; src = ng * 32; }, rot);
        transpose_cvt<F8_XPRE>(F, kp->w_xo + (size_t)l * D * D, D, D, ws + WS_WXO + l * SZ_SQ, D, 0, D / 32, nullptr, [=](int ng, int& src, float& sc) { sc = F8_XPRE ? F8_SW : 1.0f; src = ng * 32; }, rot);
    }
    { unsigned char* w13 = ws + WS_WFF13;
      for (int half = 0; half < 2; ++half) { const float* W = half ? kp->w_ff3 : kp->w_ff1;
        transpose_cvt<F8_DENSE>(F, W, DFF, D, w13, D, 0, NIN / 32, kp->g_ffn,
            [=](int ng, int& src, float& sc) { sc = F8_DENSE ? F8_SW : 1.0f; const int t = ng >> 3, bj = (ng >> 2) & 1, q = ng & 3; src = (bj == half) ? t * 128 + q * 32 : -2; }, rot); }
      transpose_cvt<(F8_DENSE || F8_DDOWN)>(F, kp->w_ff2, D, DFF, ws + WS_WFF2, DFF, 0, D / 32, nullptr, [=](int ng, int& src, float& sc) { sc = (F8_DENSE || F8_DDOWN) ? F8_SW : 1.0f; src = ng * 32; }, rot); }
    for (int e = 0; e < NEXP; ++e) {
        unsigned char* w13 = ws + WS_WE13 + e * SZ_WE13;
        for (int half = 0; half < 2; ++half) { const float* W = (half ? kp->w_e3 : kp->w_e1) + (size_t)e * D * DFE;
            transpose_cvt<F8_MOE>(F, W, DFE, D, w13, D, 0, 2 * DFE / 32, kp->g_ffn + D,
                [=](int ng, int& src, float& sc) { sc = F8_MOE ? F8_SW : 1.0f; const int t = ng >> 3, bj = (ng >> 2) & 1, q = ng & 3; src = (bj == half) ? t * 128 + q * 32 : -2; }, rot); }
        transpose_cvt<F8_MOE>(F, kp->w_e2 + (size_t)e * DFE * D, D, DFE, ws + WS_WE2 + e * SZ_WE2, DFE, 0, D / 32, nullptr, [=](int ng, int& src, float& sc) { sc = F8_MOE ? F8_SW : 1.0f; src = ng * 32; }, rot);
    }
    { f32x2* cs128 = (f32x2*)(ws + WS_CS128); f32x2* cs64 = (f32x2*)(ws + WS_CS64);
      const int gt = F.bid * NTHR + F.tid, NT_ = F.G * NTHR;
      for (int idx = gt; idx < T * 96; idx += NT_) { const int t = idx / 96, q = idx - t * 96;
          const float inv = q < 64 ? powf(10000.0f, -(float)q / 64.0f) : powf(10000.0f, -(float)(q - 64) / 32.0f);
          const float ang = (float)kp->positions[t] * inv;
          const double rev = (double)ang * 0.15915494309189535; const float fr = (float)(rev - floor(rev));
          const f32x2 v = {__builtin_amdgcn_cosf(fr), __builtin_amdgcn_sinf(fr)};
          if (q < 64) cs128[(size_t)t * 64 + q] = v; else cs64[(size_t)t * 32 + (q - 64)] = v; } }
    { const int gw = F.bid * NWAVES + F.wave, NGW = F.G * NWAVES, lane = F.lane;
      stat_t* stat = (stat_t*)((unsigned*)(ws + WS_CTL) + CW_STAT) + (ST_MIX * 2 + 0) * T;
      for (int r = gw; r < T + 1024; r += NGW) {
          const bool is_mem = r >= T; const float* src = is_mem ? kp->mem + (size_t)(r - T) * D : kp->x + (size_t)r * D;
          f32x4 v[8]; float s = 0.f;
#pragma unroll
          for (int j = 0; j < 8; ++j) { v[j] = *(const f32x4*)(src + 4 * lane + 256 * j); s += (v[j][0] * v[j][0] + v[j][1] * v[j][1]) + (v[j][2] * v[j][2] + v[j][3] * v[j][3]); }
          s = wave_sum(s);
          if (!is_mem) { if (lane == 0) stat[r] = (stat_t)(s * STAT_SCALE);
#pragma unroll
              for (int j = 0; j < 8; ++j) {
                  u32x2 w; w.x = cvt_pk_bf16(v[j][0], v[j][1]); w.y = cvt_pk_bf16(v[j][2], v[j][3]); *(u32x2*)((bf16_t*)(ws + WS_HB) + (size_t)r * D + 4 * lane + 256 * j) = w;
                  if (F8_GATES) *(unsigned*)(ws + WS_HB8 + (size_t)r * D + 4 * lane + 256 * j) = pk_fp8x4(v[j][0] * F8_SA, v[j][1] * F8_SA, v[j][2] * F8_SA, v[j][3] * F8_SA); }
          } else { const float rs = 1.0f / sqrtf(s * (1.0f / D) + EPS);
              for (int l = 0; l < 2; ++l) {
#pragma unroll
                  for (int j = 0; j < 8; ++j) { const f32x4 g = *(const f32x4*)(kp->g_mem + l * D + 4 * lane + 256 * j); const f32x4 o = v[j] * rs * g;
                      if constexpr (F8_XPRE) *(unsigned*)(ws + WS_MEMN + ((size_t)l * 1024 + (r - T)) * D + 4 * lane + 256 * j) = pk_fp8x4(o[0] * F8_SX, o[1] * F8_SX, o[2] * F8_SX, o[3] * F8_SX);
                      else { u32x2 w; w.x = cvt_pk_bf16(o[0], o[1]); w.y = cvt_pk_bf16(o[2], o[3]); *(u32x2*)((bf16_t*)(ws + WS_MEMN) + ((size_t)l * 1024 + (r - T)) * D + 4 * lane + 256 * j) = w; } } } }
      } }
}

DI void moe_router(const Frame& F, KPtr kp, const int dummy = 0) {
    unsigned char* ws = kp->ws;
    LAS float* gwt = (LAS float*)F.lds;
    LAS int* cnt = (LAS int*)(F.lds + 65536);
    for (int j = F.tid; j < D * 8; j += NTHR) { const int e = j >> 11, c = j & (D - 1); gwt[j] = kp->g_ffn[D + c] * kp->w_router[c * 8 + e]; }
    if (F.tid < 8) cnt[F.tid] = 0;
    __syncthreads();
    unsigned* tokE = (unsigned*)(ws + WS_TOK); f32x2* tokG = (f32x2*)(ws + WS_TOK + 65536); float* tokR = (float*)(ws + WS_TOK + 3 * 65536);
    const int lane = F.lane; const bf16_t* HBp = (const bf16_t*)(ws + WS_HB);
    for (int row0 = (F.bid * NWAVES + F.wave) * 2; row0 < T; row0 += F.G * NWAVES * 2) {
        u32x2 hw[2][8];
#pragma unroll
        for (int q = 0; q < 2; ++q)
#pragma unroll
            for (int j = 0; j < 8; ++j) hw[q][j] = *(const u32x2*)(HBp + (size_t)(row0 + q) * D + 4 * lane + 256 * j);
#pragma unroll
        for (int q = 0; q < 2; ++q) { const int row = row0 + q;
            float lg[8] = {0.f, 0.f, 0.f, 0.f, 0.f, 0.f, 0.f, 0.f}; float ss = 0.f;
#pragma unroll
            for (int j = 0; j < 8; ++j) { const f32x4 v = {bf_lo(hw[q][j].x), bf_hi(hw[q][j].x), bf_lo(hw[q][j].y), bf_hi(hw[q][j].y)};
                ss += (v[0] * v[0] + v[1] * v[1]) + (v[2] * v[2] + v[3] * v[3]);
#pragma unroll
                for (int e = 0; e < 8; ++e) { const f32x4 w = *(const LAS f32x4*)(gwt + e * D + 4 * lane + 256 * j); lg[e] += (v[0] * w[0] + v[1] * w[1]) + (v[2] * w[2] + v[3] * w[3]); } }
            ss = wave_sum(ss);
#pragma unroll
            for (int e = 0; e < 8; ++e) lg[e] = wave_sum(lg[e]);
            const float r = __builtin_amdgcn_rsqf(ss * (1.0f / D) + EPS);
            int i0 = 0; float v0 = lg[0];
#pragma unroll
            for (int e = 1; e < 8; ++e) if (lg[e] > v0) { v0 = lg[e]; i0 = e; }
            int i1 = -1; float v1 = -3.0e38f;
#pragma unroll
            for (int e = 0; e < 8; ++e) if (e != i0 && lg[e] > v1) { v1 = lg[e]; i1 = e; }
            const float g0 = 1.0f / (1.0f + expf((v1 - v0) * r)), g1 = 1.0f - g0;
            if (lane == 0) { tokE[row] = (unsigned)i0 | ((unsigned)i1 << 8); tokG[row] = (f32x2){g0, g1}; tokR[row] = r;
                __hip_atomic_fetch_add(cnt + i0, 1, __ATOMIC_RELAXED, __HIP_MEMORY_SCOPE_WORKGROUP); __hip_atomic_fetch_add(cnt + i1, 1, __ATOMIC_RELAXED, __HIP_MEMORY_SCOPE_WORKGROUP); } }
    }
    __syncthreads();
    if (F.tid < 8) { const int c = cnt[F.tid]; if (c) __hip_atomic_fetch_add((unsigned*)(ws + WS_CTL) + (dummy ? 700000 : CW_MOE) + 64 * F.tid, (unsigned)c, __ATOMIC_RELAXED, __HIP_MEMORY_SCOPE_AGENT); }
}
DI void moe_assign_gather(const Frame& F, KPtr kp) {
    unsigned char* ws = kp->ws;
    unsigned* ctl = (unsigned*)(ws + WS_CTL);
    const unsigned* tokE = (const unsigned*)(ws + WS_TOK); const float* tokR = (const float*)(ws + WS_TOK + 3 * 65536); int* slot = (int*)(ws + WS_TOK + 4 * 65536);
    unsigned char* XS = ws + WS_R2 + R2_XS;
    LAS int* sl = (LAS int*)F.lds;
    int pstart[8]; { int b = 0;
#pragma unroll
        for (int e = 0; e < 8; ++e) { pstart[e] = b * 256; const unsigned c = __hip_atomic_load(ctl + CW_MOE + 64 * e, __ATOMIC_RELAXED, __HIP_MEMORY_SCOPE_AGENT); b += (int)((c + 255u) >> 8); } }
    const int lane = F.lane; const bf16_t* HBp = (const bf16_t*)(ws + WS_HB);
    for (int batch = F.bid; batch < T / 64; batch += F.G) {
        if (F.wave == 0) { const int t = batch * 64 + lane; const unsigned ee = tokE[t];
#pragma unroll
            for (int k = 0; k < 2; ++k) { const int ek = (int)((ee >> (8 * k)) & 0xffu);
                unsigned long long mk[8]; int mycnt = 0;
#pragma unroll
                for (int e = 0; e < 8; ++e) { mk[e] = __ballot(ek == e); if (lane == e) mycnt = __popcll(mk[e]); }
                unsigned base = 0; if (lane < 8 && mycnt) base = __hip_atomic_fetch_add(ctl + CW_MOE + 512 + 64 * lane, (unsigned)mycnt, __ATOMIC_RELAXED, __HIP_MEMORY_SCOPE_AGENT);
                int myslot = 0;
#pragma unroll
                for (int e = 0; e < 8; ++e) { const unsigned be = (unsigned)__builtin_amdgcn_readlane((int)base, e); if (ek == e) myslot = pstart[e] + (int)be + __popcll(mk[e] & ((1ull << lane) - 1ull)); }
                sl[lane * 2 + k] = myslot; slot[t * 2 + k] = myslot; } }
        __syncthreads();
        for (int j = 0; j < 8; j += 2) {
            u32x2 hw[2][8]; int s0[2], s1[2]; float r[2];
#pragma unroll
            for (int q = 0; q < 2; ++q) { const int tl = F.wave * 8 + j + q, t = batch * 64 + tl; s0[q] = sl[tl * 2]; s1[q] = sl[tl * 2 + 1]; r[q] = tokR[t];
#pragma unroll
                for (int c = 0; c < 8; ++c) hw[q][c] = *(const u32x2*)(HBp + (size_t)t * D + 4 * lane + 256 * c); }
#pragma unroll
            for (int q = 0; q < 2; ++q)
#pragma unroll
                for (int c = 0; c < 8; ++c) { const f32x4 v = (f32x4){bf_lo(hw[q][c].x), bf_hi(hw[q][c].x), bf_lo(hw[q][c].y), bf_hi(hw[q][c].y)} * (F8_MOE ? r[q] * F8_SX : r[q]);
                    if constexpr (F8_MOE) { const unsigned w = pk_fp8x4(v[0], v[1], v[2], v[3]);
                        *(unsigned*)(XS + (size_t)s0[q] * D + 4 * lane + 256 * c) = w; *(unsigned*)(XS + (size_t)s1[q] * D + 4 * lane + 256 * c) = w; }
                    else { u32x2 w; w.x = cvt_pk_bf16(v[0], v[1]); w.y = cvt_pk_bf16(v[2], v[3]);
                        *(u32x2*)((bf16_t*)XS + (size_t)s0[q] * D + 4 * lane + 256 * c) = w; *(u32x2*)((bf16_t*)XS + (size_t)s1[q] * D + 4 * lane + 256 * c) = w; } } }
        __syncthreads();
    }
}
DI void moe_combine_final(const Frame& F, KPtr kp) {
    unsigned char* ws = kp->ws;
    const f32x2* tokG = (const f32x2*)(ws + WS_TOK + 65536); const int* slot = (const int*)(ws + WS_TOK + 4 * 65536);
    const bf16_t* YS = (const bf16_t*)(ws + WS_R2 + R2_YS); const bf16_t* HBp = (const bf16_t*)(ws + WS_HB); const int lane = F.lane;
    const pg8::MoeTail tp = pg8::moe_tail_plan((const unsigned*)(ws + WS_CTL) + CW_MOE, F.G); const int tail0 = tp.nb_main * 256; const size_t tslab = (size_t)(tp.nused - tp.nb_main) * 256 * D;
    const bf16_t* YP = (const bf16_t*)(ws + WS_R2 + R2_YP);
    for (int row0 = (F.bid * NWAVES + F.wave) * 2; row0 < T; row0 += F.G * NWAVES * 2) {
        int s0[2], s1[2]; f32x2 g[2]; u32x2 hw[2][8], ya[2][8], yb[2][8];
#pragma unroll
        for (int q = 0; q < 2; ++q) { s0[q] = slot[(row0 + q) * 2]; s1[q] = slot[(row0 + q) * 2 + 1]; g[q] = tokG[row0 + q]; }
#pragma unroll
        for (int q = 0; q < 2; ++q)
#pragma unroll
            for (int j = 0; j < 8; ++j) { const int c = 4 * lane + 256 * j; hw[q][j] = *(const u32x2*)(HBp + (size_t)(row0 + q) * D + c);
                ya[q][j] = *(const u32x2*)(YS + (size_t)s0[q] * D + c); yb[q][j] = *(const u32x2*)(YS + (size_t)s1[q] * D + c); }
        if (tp.f > 1) {
#pragma unroll
            for (int q = 0; q < 2; ++q)
#pragma unroll
                for (int w = 0; w < 2; ++w) { const int sl = w ? s1[q] : s0[q]; if (sl < tail0) continue;
                    for (int k = 1; k < tp.f; ++k) { const bf16_t* pr = YP + (size_t)(k - 1) * tslab + (size_t)(sl - tail0) * D; u32x2 pv[8];
#pragma unroll
                        for (int j = 0; j < 8; ++j) pv[j] = *(const u32x2*)(pr + 4 * lane + 256 * j);
#pragma unroll
                        for (int j = 0; j < 8; ++j) { u32x2& y = w ? yb[q][j] : ya[q][j];
                            y.x = cvt_pk_bf16(bf_lo(y.x) + bf_lo(pv[j].x), bf_hi(y.x) + bf_hi(pv[j].x)); y.y = cvt_pk_bf16(bf_lo(y.y) + bf_lo(pv[j].y), bf_hi(y.y) + bf_hi(pv[j].y)); } } }
        }
#pragma unroll
        for (int q = 0; q < 2; ++q) { f32x4 v[8]; float ss = 0.f;
#pragma unroll
            for (int j = 0; j < 8; ++j) { const u32x2 h = hw[q][j], a = ya[q][j], b = yb[q][j]; f32x4 o;
                o[0] = bf_lo(h.x) + (g[q].x * bf_lo(a.x) + g[q].y * bf_lo(b.x)); o[1] = bf_hi(h.x) + (g[q].x * bf_hi(a.x) + g[q].y * bf_hi(b.x));
                o[2] = bf_lo(h.y) + (g[q].x * bf_lo(a.y) + g[q].y * bf_lo(b.y)); o[3] = bf_hi(h.y) + (g[q].x * bf_hi(a.y) + g[q].y * bf_hi(b.y));
                v[j] = o; ss += (o[0] * o[0] + o[1] * o[1]) + (o[2] * o[2] + o[3] * o[3]); }
            ss = wave_sum(ss); const float r = __builtin_amdgcn_rsqf(ss * (1.0f / D) + EPS);
#pragma unroll
            for (int j = 0; j < 8; ++j) { const int c = 4 * lane + 256 * j; __builtin_nontemporal_store(v[j] * r * *(const f32x4*)(kp->g_final + c), (f32x4*)(kp->out + (size_t)(row0 + q) * D + c)); } }
    }
}
namespace att {
constexpr int SHM_V = 16384, NW_ATT = 8;
DI int v_st(int k, int c) { const int kk = (k & ~0xC) | ((k & 4) << 1) | ((k & 8) >> 1); return ((kk >> 3) * 4 + (c >> 5)) * 512 + ((kk & 7) * 32 + (c & 31)) * 2; }
DI int v_rd_base(int lane) { return ((lane & 3) << 3) | (((lane >> 2) & 3) << 6) | (((lane >> 4) & 1) << 5) | (((lane >> 5) & 1) << 8); }
struct Src { const bf16_t* q; const bf16_t* k; const bf16_t* k2; const bf16_t* v; bf16_t* o; int ldq, ldk, ldv; };
DI float swap_max(float x) { auto rr = __builtin_amdgcn_permlane32_swap(__float_as_uint(x), __float_as_uint(x), false, false); return fmaxf(__uint_as_float(rr[0]), __uint_as_float(rr[1])); }
DI float swap_sum(float x) { auto rr = __builtin_amdgcn_permlane32_swap(__float_as_uint(x), __float_as_uint(x), false, false); return __uint_as_float(rr[0]) + __uint_as_float(rr[1]); }
#define ATT_PK4(P, B_, OUT) do { unsigned a0 = cvt_pk_bf16(P[B_+0], P[B_+1]), a1 = cvt_pk_bf16(P[B_+2], P[B_+3]);                          \
        unsigned b0 = cvt_pk_bf16(P[B_+4], P[B_+5]), b1 = cvt_pk_bf16(P[B_+6], P[B_+7]);                                             \
        auto r0 = __builtin_amdgcn_permlane32_swap(a0, b0, false, false); auto r1 = __builtin_amdgcn_permlane32_swap(a1, b1, false, false); \
        u32x4 w = {r0[0], r1[0], r0[1], r1[1]}; OUT = __builtin_bit_cast(bf16x8, w); } while (0)

template <int KIND, int DK, int DBG = 0>
DI void tile_compute(const unsigned kaddr  , const int (&kx)[4], const unsigned vaddr  ,
                     const bf16x8 (&qr)[DK / 16], f32x16 (&o)[4], float& m_reg, float& l_reg, float& R, const int dq, const bool bmask, const bool blk_ok, const int hi) {
    constexpr int ND = DK / 16, KROW = DK * 2;
    f32x16 p0, p1;
    const bool mvalid = m_reg > -1e29f; const float base = mvalid ? m_reg : 0.f;
    const float pinit = (KIND == 2) ? 0.f : ((KIND == 1 && !blk_ok) ? -__builtin_inff() : -base);
#pragma unroll
    for (int r = 0; r < 16; ++r) { p0[r] = pinit; p1[r] = pinit; }
    constexpr int KG = ND > 8 ? 4 : ND;
    if constexpr (DBG & 1) { p0[0] = __int_as_float(kaddr & 3); }
    else
#pragma unroll
    for (int g0 = 0; g0 < ND; g0 += KG) {
        bf16x8 kf[KG][2];
#pragma unroll
        for (int d = 0; d < KG; ++d) { const int d0 = g0 + d; const LAS unsigned char* a = (const LAS unsigned char*)(size_t)(kaddr + kx[d0 & 3] + (d0 >> 2) * 128);
            if constexpr (DBG & 16) { kf[d][0] = qr[d0]; kf[d][1] = qr[(d0 + 1) % ND]; (void)a; } else { kf[d][0] = *(const LAS bf16x8*)a; kf[d][1] = *(const LAS bf16x8*)(a + 32 * KROW); } }
        __builtin_amdgcn_sched_barrier(0);
#pragma unroll
        for (int d = 0; d < KG; ++d) { p0 = __builtin_amdgcn_mfma_f32_32x32x16_bf16(kf[d][0], qr[g0 + d], p0, 0, 0, 0); p1 = __builtin_amdgcn_mfma_f32_32x32x16_bf16(kf[d][1], qr[g0 + d], p1, 0, 0, 0); }
    }
    const float NEG = -__builtin_inff();
    if constexpr (DBG & 2) { (void)NEG; }
    else if constexpr (KIND != 2) {
        if (bmask) {
#pragma unroll
            for (int r = 0; r < 16; ++r) { const int c = (r & 3) + 8 * (r >> 2); if (c > dq) p0[r] = NEG; if (c + 32 > dq) p1[r] = NEG; }
        }
        float pmax = p0[0];
#pragma unroll
        for (int r = 1; r < 16; ++r) pmax = fmaxf(pmax, p0[r]);
#pragma unroll
        for (int r = 0; r < 16; ++r) pmax = fmaxf(pmax, p1[r]);
        pmax = swap_max(pmax);
        float alpha = 1.0f, ps = 0.f;
        if (__all(mvalid && pmax <= 8.0f)) {
#pragma unroll
            for (int r = 0; r < 16; ++r) { p0[r] = fast_exp2(p0[r]); ps += p0[r]; }
#pragma unroll
            for (int r = 0; r < 16; ++r) { p1[r] = fast_exp2(p1[r]); ps += p1[r]; }
        } else {
            const float mnew = fmaxf(m_reg, base + pmax), delta = mnew - base;
            alpha = fast_exp2(m_reg - mnew); m_reg = mnew;
#pragma unroll
            for (int r = 0; r < 16; ++r) { p0[r] = fast_exp2(p0[r] - delta); ps += p0[r]; }
#pragma unroll
            for (int r = 0; r < 16; ++r) { p1[r] = fast_exp2(p1[r] - delta); ps += p1[r]; }
        }
        ps = swap_sum(ps);
        l_reg = l_reg * alpha + ps;
        if (__any(alpha < 1.0f)) {
#pragma unroll
            for (int d = 0; d < 4; ++d)
#pragma unroll
                for (int r = 0; r < 16; ++r) o[d][r] *= alpha;
        }
    } else {
        float y0[16], y1[16];
#pragma unroll
        for (int r = 0; r < 16; ++r) { const int c = (r & 3) + 8 * (r >> 2);
            const float ua = fast_exp2(fminf(p0[r], 100.f)), ub = fast_exp2(fminf(p1[r], 100.f));
            float ra = fast_rcp(1.0f + ua), rb = fast_rcp(1.0f + ub), ba = ua * ra, bb = ub * rb;
            if (bmask) { if (!(c < dq)) { ra = 1.f; ba = 0.f; } if (!(c + 32 < dq)) { rb = 1.f; bb = 0.f; } }
            y0[r] = ra; y1[r] = rb; p0[r] = ba; p1[r] = bb; }
        float pair[8], gpl[8];
#pragma unroll
        for (int k = 0; k < 8; ++k) { const float g = k < 4 ? (y0[4 * k] * y0[4 * k + 1]) * (y0[4 * k + 2] * y0[4 * k + 3]) : (y1[4 * (k - 4)] * y1[4 * (k - 4) + 1]) * (y1[4 * (k - 4) + 2] * y1[4 * (k - 4) + 3]);
            auto rr = __builtin_amdgcn_permlane32_swap(__float_as_uint(g), __float_as_uint(g), false, false);
            const float glo = __uint_as_float(rr[0]), ghi = __uint_as_float(rr[1]);
            pair[k] = glo * ghi; gpl[k] = hi ? 1.0f : ghi; }
        float off[8]; { float e = R;
#pragma unroll
            for (int k = 7; k >= 0; --k) { off[k] = e * gpl[k]; e *= pair[k]; }
            R = e; }
#pragma unroll
        for (int j = 0; j < 4; ++j) {
            { const float e3 = off[j], e2 = y0[4 * j + 3] * e3, e1 = y0[4 * j + 2] * e2, e0 = y0[4 * j + 1] * e1;
              p0[4 * j + 3] *= e3; p0[4 * j + 2] *= e2; p0[4 * j + 1] *= e1; p0[4 * j] *= e0; }
            { const float e3 = off[4 + j], e2 = y1[4 * j + 3] * e3, e1 = y1[4 * j + 2] * e2, e0 = y1[4 * j + 1] * e1;
              p1[4 * j + 3] *= e3; p1[4 * j + 2] *= e2; p1[4 * j + 1] *= e1; p1[4 * j] *= e0; } }
    }
    bf16x8 pa0, pa1, pa2, pa3;
    ATT_PK4(p0, 0, pa0); ATT_PK4(p0, 8, pa1); ATT_PK4(p1, 0, pa2); ATT_PK4(p1, 8, pa3);
#define ATT_TRRD(dst, off) asm volatile("ds_read_b64_tr_b16 %0, %1 offset:%2" : "=&v"(dst) : "v"(vaddr), "i"(off) : "memory")
#define ATT_VRD(V, d0) do { if constexpr (DBG & 32) { _Pragma("unroll") for (int q_ = 0; q_ < 8; ++q_) V[q_] = (s16x4){pa0[q_ & 7], pa1[q_ & 7], pa2[q_ & 7], pa3[q_ & 7]}; break; } constexpr int b_ = (d0) * 512; ATT_TRRD(V[0], b_); ATT_TRRD(V[1], b_ + 2048); ATT_TRRD(V[2], b_ + 4096); ATT_TRRD(V[3], b_ + 6144); ATT_TRRD(V[4], b_ + 8192); ATT_TRRD(V[5], b_ + 10240); ATT_TRRD(V[6], b_ + 12288); ATT_TRRD(V[7], b_ + 14336); } while (0)
#define ATT_VF(V, k) ((bf16x8){V[2 * (k)][0], V[2 * (k)][1], V[2 * (k)][2], V[2 * (k)][3], V[2 * (k) + 1][0], V[2 * (k) + 1][1], V[2 * (k) + 1][2], V[2 * (k) + 1][3]})
#define ATT_PVM(V, d0) do { o[d0] = __builtin_amdgcn_mfma_f32_32x32x16_bf16(ATT_VF(V, 0), pa0, o[d0], 0, 0, 0); o[d0] = __builtin_amdgcn_mfma_f32_32x32x16_bf16(ATT_VF(V, 1), pa1, o[d0], 0, 0, 0); \
        o[d0] = __builtin_amdgcn_mfma_f32_32x32x16_bf16(ATT_VF(V, 2), pa2, o[d0], 0, 0, 0); o[d0] = __builtin_amdgcn_mfma_f32_32x32x16_bf16(ATT_VF(V, 3), pa3, o[d0], 0, 0, 0); } while (0)
#define ATT_LW(n) do { asm volatile("s_waitcnt lgkmcnt(" #n ")" ::: "memory"); __builtin_amdgcn_sched_barrier(0); } while (0)
    if constexpr (DBG & 4) { o[0][0] += __builtin_bit_cast(f32x4, __builtin_bit_cast(u32x4, pa0) ^ __builtin_bit_cast(u32x4, pa1) ^ __builtin_bit_cast(u32x4, pa2) ^ __builtin_bit_cast(u32x4, pa3))[0]; }
    else { s16x4 va[8], vb[8];
      __builtin_amdgcn_sched_barrier(0);
      ATT_VRD(va, 0); ATT_VRD(vb, 1);
      ATT_LW(8); ATT_PVM(va, 0); __builtin_amdgcn_sched_barrier(0);
      ATT_VRD(va, 2);
      ATT_LW(8); ATT_PVM(vb, 1); __builtin_amdgcn_sched_barrier(0);
      ATT_VRD(vb, 3);
      ATT_LW(8); ATT_PVM(va, 2); __builtin_amdgcn_sched_barrier(0);
      ATT_LW(0); ATT_PVM(vb, 3); }
#undef ATT_LW
#undef ATT_PVM
#undef ATT_VF
#undef ATT_VRD
#undef ATT_TRRD
}

template <int KIND, int DBG = 0>
DI void attn_unit(LAS unsigned char* lds, const int tid_in, const Src& s, const int qb, const float* ksum_bh) {
    constexpr int DK = KIND == 0 ? 192 : 128, ND = DK / 16, KROW = DK * 2, SHM_K = 64 * KROW, NKC = DK / 8, NST = 64 * NKC / 512;
    int tid_ = tid_in; asm volatile("" : "+v"(tid_));
    const int tid = tid_, wid = __builtin_amdgcn_readfirstlane(tid >> 6), lane = tid & 63, r32 = lane & 31, hi = lane >> 5;
    const int P0 = qb * 256, qlo = P0 + wid * 32, qpos = qlo + r32, NT = 4 * (qb + 1);
    bf16x8 qr[ND];
#pragma unroll
    for (int d0 = 0; d0 < ND; ++d0) qr[d0] = *(const bf16x8*)(s.q + (size_t)qpos * s.ldq + d0 * 16 + hi * 8);
    unsigned allowed = 0xffffffffu;
    LAS float* ksl = (LAS float*)(lds + 98304);
    f32x4 ksv = {0.f, 0.f, 0.f, 0.f};
    if constexpr (KIND == 1) { if (tid < qb * 32) ksv = *(const f32x4*)(ksum_bh + (size_t)(tid >> 5) * 640 + (tid & 31) * 4); }
    f32x16 o[4];
#pragma unroll
    for (int d = 0; d < 4; ++d)
#pragma unroll
        for (int r = 0; r < 16; ++r) o[d][r] = 0.f;
    float m_reg = -1e30f, l_reg = 0.f, R = (KIND == 2) ? 1.0f : 0.f;
    LAS unsigned char* Vl = lds; LAS unsigned char* Kl = lds + 3 * SHM_V;
    const bf16_t* ksrc[NST]; int kstr[NST];
#pragma unroll
    for (int i = 0; i < NST; ++i) { const int ci = tid + 512 * i, row = ci / NKC, ccp = ci - row * NKC, cc = ccp ^ (row & 7);
        if (KIND == 0 && cc >= 16) { ksrc[i] = s.k2 + (size_t)row * 64 + (cc - 16) * 8; kstr[i] = 64; } else { ksrc[i] = s.k + (size_t)row * s.ldk + cc * 8; kstr[i] = s.ldk; } }
    unsigned vsrc[2];
#pragma unroll
    for (int i = 0; i < 2; ++i) { const int j = tid + 512 * i, st = j >> 5, sl = j & 31, kk = (st >> 2) * 8 + (sl >> 2), c = (st & 3) * 32 + 8 * (sl & 3);
        const int k = (kk & ~0xC) | ((kk & 4) << 1) | ((kk & 8) >> 1); vsrc[i] = (unsigned)((k * s.ldv + c) * 2); }
    const unsigned vbase = (unsigned)(unsigned long long)Vl + (unsigned)v_rd_base(lane);
    const unsigned kbase = (unsigned)(unsigned long long)Kl + (unsigned)(r32 * KROW);
    int kx[4];
#pragma unroll
    for (int dd = 0; dd < 4; ++dd) kx[dd] = (dd * 32 + hi * 16) ^ ((r32 & 7) << 4);
    constexpr int NDMA = NST + 2;
#define ATT_DMA(t, slot) do { const int kb_ = (t) * 64; const char* vb_ = (const char*)(s.v + (size_t)kb_ * s.ldv); \
        _Pragma("unroll") for (int i_ = 0; i_ < 2; ++i_) __builtin_amdgcn_global_load_lds((const unsigned*)(vb_ + vsrc[i_]), (LAS unsigned*)(Vl + (slot) * SHM_V + (wid * 64 + 512 * i_) * 16), 16, 0, 0); \
        _Pragma("unroll") for (int i_ = 0; i_ < NST; ++i_) __builtin_amdgcn_global_load_lds((const unsigned*)(ksrc[i_] + (size_t)kb_ * kstr[i_]), (LAS unsigned*)(Kl + (slot) * SHM_K + (wid * 64 + 512 * i_) * 16), 16, 0, 0); } while (0)
#define ATT_TILE(i_) ((KIND == 2) ? (NT - 1 - (i_)) : (i_))
#define ATT_WAITV(n) asm volatile("s_waitcnt vmcnt(%0)" :: "i"(n) : "memory")
#define ATT_BARRIER() do { asm volatile("s_waitcnt lgkmcnt(0)" ::: "memory"); __builtin_amdgcn_s_barrier(); asm volatile("" ::: "memory"); } while (0)
    volatile LAS int* wdone_cnt = (volatile LAS int*)(lds + LDS_MISC) + 5;
    bool wdone = false;
    if (KIND == 2 && tid == 0) *wdone_cnt = 0;
    ATT_DMA(ATT_TILE(0), 0); ATT_DMA(ATT_TILE(1), 1);
    if constexpr (KIND == 1) {
        if (tid < qb * 32) *(LAS f32x4*)(ksl + tid * 4) = ksv;
        ATT_BARRIER();
        allowed = 1u << qb;
        float v0 = -__builtin_inff(), v1 = v0, v2 = v0; int i0 = -1, i1 = -1, i2 = -1;
        for (int n = 0; n < qb; ++n) {
            const LAS float* kp = ksl + n * 128 + hi * 8; float g = 0.f;
#pragma unroll
            for (int d0 = 0; d0 < 8; ++d0) { const f32x4 k0 = *(const LAS f32x4*)(kp + d0 * 16), k1 = *(const LAS f32x4*)(kp + d0 * 16 + 4); const u32x4 qw = __builtin_bit_cast(u32x4, qr[d0]);
                g += bf_lo(qw[0]) * k0[0] + bf_hi(qw[0]) * k0[1] + bf_lo(qw[1]) * k0[2] + bf_hi(qw[1]) * k0[3] + bf_lo(qw[2]) * k1[0] + bf_hi(qw[2]) * k1[1] + bf_lo(qw[3]) * k1[2] + bf_hi(qw[3]) * k1[3]; }
            g = swap_sum(g);
            if (g > v0) { v2 = v1; i2 = i1; v1 = v0; i1 = i0; v0 = g; i0 = n; } else if (g > v1) { v2 = v1; i2 = i1; v1 = g; i1 = n; } else if (g > v2) { v2 = g; i2 = n; }
        }
        if (i0 >= 0) allowed |= 1u << i0; if (i1 >= 0) allowed |= 1u << i1; if (i2 >= 0) allowed |= 1u << i2;
    }
    ATT_WAITV(NDMA); ATT_BARRIER();
    int slot = 0;
    for (int i = 0; i < NT; ++i) {
        const int t_ = ATT_TILE(i), kb_ = t_ * 64; const int s2 = slot == 0 ? 2 : slot - 1;
        const bool more = !(DBG & 8) && (i + 2 < NT);
        if (more) ATT_DMA(ATT_TILE(i + 2), s2);
        if (kb_ <= qlo + 31 && !wdone) { const bool bm_ = (KIND == 2) ? (kb_ + 63 >= qlo) : (kb_ + 63 > qlo);
            tile_compute<KIND, DK, DBG>(kbase + slot * SHM_K, kx, vbase + slot * SHM_V, qr, o, m_reg, l_reg, R, qpos - kb_ - 4 * hi, bm_, ((allowed >> (kb_ >> 8)) & 1u) != 0u, hi);
            if (KIND == 2 && !(DBG & 64) && __all(R == 0.0f)) { wdone = true; if (lane == 0) __hip_atomic_fetch_add((LAS int*)wdone_cnt, 1, __ATOMIC_RELAXED, __HIP_MEMORY_SCOPE_WORKGROUP); } }
        if (more) ATT_WAITV(NDMA); else ATT_WAITV(0);
        ATT_BARRIER();
        slot = slot == 2 ? 0 : slot + 1;
        if (KIND == 2) {
            const int c_ = __builtin_amdgcn_readfirstlane(*wdone_cnt); ATT_BARRIER();
            if (c_ == NW_ATT) { ATT_WAITV(0); ATT_BARRIER(); break; } }
    }
#undef ATT_BARRIER
#undef ATT_WAITV
#undef ATT_TILE
#undef ATT_DMA
    const float inv = (KIND == 2) ? 1.0f : 1.0f / l_reg;
    if constexpr (F8_DUP && KIND != 2) {
        unsigned char* ob = (unsigned char*)s.o + (size_t)qpos * (2 * D) + 8 * hi; const float i8 = inv * F8_SO;
#pragma unroll
        for (int d0 = 0; d0 < 4; ++d0)
#pragma unroll
            for (int g = 0; g < 4; g += 2) {
                const unsigned a = pk_fp8x4(o[d0][4 * g] * i8, o[d0][4 * g + 1] * i8, o[d0][4 * g + 2] * i8, o[d0][4 * g + 3] * i8), b = pk_fp8x4(o[d0][4 * g + 4] * i8, o[d0][4 * g + 5] * i8, o[d0][4 * g + 6] * i8, o[d0][4 * g + 7] * i8);
                auto r = __builtin_amdgcn_permlane32_swap(a, b, false, false);
                *(u32x2*)(ob + 32 * d0 + 8 * g) = (u32x2){r[0], r[1]}; }
        return; }
    bf16_t* orow = s.o + (size_t)qpos * D + 8 * hi;
#pragma unroll
    for (int d0 = 0; d0 < 4; ++d0)
#pragma unroll
        for (int g = 0; g < 4; g += 2) {
            const unsigned a0 = cvt_pk_bf16(o[d0][4 * g] * inv, o[d0][4 * g + 1] * inv), a1 = cvt_pk_bf16(o[d0][4 * g + 2] * inv, o[d0][4 * g + 3] * inv);
            const unsigned b0 = cvt_pk_bf16(o[d0][4 * g + 4] * inv, o[d0][4 * g + 5] * inv), b1 = cvt_pk_bf16(o[d0][4 * g + 6] * inv, o[d0][4 * g + 7] * inv);
            auto r0 = __builtin_amdgcn_permlane32_swap(a0, b0, false, false); auto r1 = __builtin_amdgcn_permlane32_swap(a1, b1, false, false);
            const u32x4 w = {r0[0], r1[0], r0[1], r1[1]};
            *(u32x4*)(orow + 32 * d0 + 8 * g) = w; }
}
}

namespace pg8 {
struct SchedMemKV {
    const char* MEMN; const char* WXK; const char* WXV; int G, c, eb;
    DI bool next(int i, Unit& u) const {
        const long L = (long)i * G + c; if (L >= 128) return false;
        const int ll = (int)L >> 6, kind = ((int)L >> 5) & 1, r = (int)L & 31; u.aux = ll * 2 + kind; u.nt = 16 * eb;
        u.pm = r >> 3; u.pn = r & 7; u.a = MEMN + (size_t)ll * 1024 * D * eb + (size_t)u.pm * 256 * D * eb; u.b = (kind ? WXV : WXK) + (size_t)ll * SZ_SQ + (size_t)u.pn * 256 * D * eb;
        return true;
    }
};
struct SchedXPre {
    const char* KMEM; const char* VMEM; const char* WXQN; const char* WXO; int G, c, eb;
    DI bool next(int i, Unit& u) const {
        const long L = (long)i * G + c; if (L >= 512) return false;
        const int kind = (int)L >> 8, r = (int)L & 255, ll = r >> 7, bh = (r >> 3) & 15, b = bh >> 2, h = bh & 3, p = r & 7; u.aux = kind; u.nt = 4 * eb;
        const size_t mem = ((size_t)(ll * 1024 + b * 256) * D + h * 512) * eb, wgt = (size_t)ll * SZ_SQ + ((size_t)p * 256 * D + h * 512) * eb;
        if (kind == 0) { u.a = KMEM + mem; u.b = WXQN + wgt; u.pm = (ll * 4 + b) * 4 + h; u.pn = p; }
        else { u.a = WXO + wgt; u.b = VMEM + mem; u.pm = (ll * 4 + b) * 8 + p; u.pn = h; }
        return true;
    }
};
struct SchedXS2 {
    const char* HBp; const char* MT; int l, G, c, eb;
    DI bool next(int i, Unit& u) const {
        const long L = (long)i * G + c; if (L >= 256) return false;
        const int hd = (int)L & 3, rt = (int)L >> 2; u.pm = rt; u.pn = hd; u.aux = 0; u.nt = 16 * eb;
        u.a = HBp + (size_t)rt * 256 * D * eb; u.b = MT + ((size_t)((l * 4 + (rt >> 4)) * 1024 + hd * 256) * D) * eb; return true;
    }
};
struct SchedXO {
    const char* PX; const char* NT; int l, G, c, eb;
    DI bool next(int i, Unit& u) const {
        const long L = (long)i * G + c; if (L >= 512) return false;
        tile_order((int)L, 64, 8, u.pm, u.pn); u.aux = 0; u.nt = 8 * eb;
        u.a = PX + (size_t)u.pm * 256 * 1024 * eb; u.b = NT + ((size_t)((l * 4 + (u.pm >> 4)) * 2048 + u.pn * 256) * 1024) * eb; return true;
    }
};
}
namespace epi {
struct EpiTwo {
    bf16_t* O0; bf16_t* O1; int ld0, ld1; size_t slab; float sc0 = 0.f, sc1 = 0.f;
    static constexpr bool BAR_INSIDE = false;
    DI const stat_t* stat_src() const { return nullptr; }
    DI bool operator()(Acc& acc, const Unit& u, int wr, int wc, int fr, int fq) const {
        asm volatile("" : "+v"(fr), "+v"(fq));
        const int kind = u.aux & 1; const int ldo = kind ? ld1 : ld0; const float sc = kind ? sc1 : sc0;
        const int row0 = u.pm * 256 + wr * 64 + fr;
        if (sc > 0.f) { unsigned char* O = (unsigned char*)(kind ? O1 : O0) + (size_t)(u.aux >> 1) * slab;
#pragma unroll
            for (int ai = 0; ai < 2; ++ai)
#pragma unroll
                for (int m = 0; m < 4; ++m) { const int row = row0 + ai * 128 + m * 16;
#pragma unroll
                    for (int bj = 0; bj < 2; ++bj)
                        *(u32x2*)(O + (size_t)row * ldo + u.pn * 256 + bj * 128 + wc * 32 + 8 * fq) = pack8_fp8(acc[ai][bj][m][0] * sc, acc[ai][bj][m][1] * sc); }
            return false; }
        bf16_t* O = (kind ? O1 : O0) + (size_t)(u.aux >> 1) * slab;
#pragma unroll
        for (int ai = 0; ai < 2; ++ai)
#pragma unroll
            for (int m = 0; m < 4; ++m) { const int row = row0 + ai * 128 + m * 16;
#pragma unroll
                for (int bj = 0; bj < 2; ++bj)
                    *(u32x4*)(O + (size_t)row * ldo + u.pn * 256 + bj * 128 + wc * 32 + 8 * fq) = pack8(acc[ai][bj][m][0], acc[ai][bj][m][1]); }
        return false;
    }
};
}

#ifndef ATT_DBG
#define ATT_DBG 0
#endif
template <int DBG = 0>
DI void attn_phase(const Frame& F, KPtr kp, const int l, const int qoff = 0, const int kmask = 7) {
    unsigned char* ws = kp->ws; unsigned* ctl = (unsigned*)(ws + WS_CTL);
    volatile LAS int* misc = (volatile LAS int*)(F.lds + LDS_MISC);
    const bf16_t* QA = (const bf16_t*)(ws + WS_R2 + R2_QA); const bf16_t* KVA = (const bf16_t*)(ws + WS_R2 + R2_KVA); const bf16_t* KPE = (const bf16_t*)(ws + WS_R1 + R1_KPE);
    const bf16_t* MQK = (const bf16_t*)(ws + WS_R1 + R1_MQK); const bf16_t* PL = (const bf16_t*)(ws + WS_R1 + R1_PL); bf16_t* OCAT = qoff ? (bf16_t*)(ws + WS_R1 + 352 * MiB) : (bf16_t*)(ws + WS_R2 + R2_OCAT);
    const float* ksum = (const float*)(ws + WS_CTL) + CW_KSUM + l * KSUM_L;
#define ATT_U0 att::attn_unit<0, DBG>
#define ATT_U1 att::attn_unit<1, DBG>
#define ATT_U2 att::attn_unit<2, DBG>
#define ATT_QUEUE_LOOP(KIND, NH, BODY) for (;;) { if (F.tid == 0) misc[4] = (int)__hip_atomic_fetch_add(ctl + CW_QUEUE + (qoff * 6 + l * 3 + (KIND)) * 64, 1u, __ATOMIC_RELAXED, __HIP_MEMORY_SCOPE_AGENT); \
        __syncthreads(); const int it = __builtin_amdgcn_readfirstlane(misc[4]); __syncthreads(); if (it >= 16 * NB * (NH)) break; \
        const int qb = 15 - it / (NB * (NH)), r_ = it % (NB * (NH)), b = r_ / (NH), h = r_ % (NH); const size_t t0 = (size_t)b * SEQ; att::Src s; BODY }
#ifndef ATT_MASK
#define ATT_MASK 7
#endif
#define ATT_SRC_MLA { s.q = QA + t0 * 1152 + h * 192; s.k = KVA + t0 * 1536 + h * 256; s.k2 = KPE + t0 * 64; s.v = KVA + t0 * 1536 + h * 256 + 128; s.o = F8_DUP ? (bf16_t*)((unsigned char*)(OCAT + t0 * D) + h * 128) : OCAT + t0 * D + h * 128; \
        s.ldq = 1152; s.ldk = 1536; s.ldv = 1536; ATT_U0(F.lds, F.tid, s, qb, nullptr); }
#define ATT_SRC_MOBA { s.q = MQK + t0 * 1280 + h * 128; s.k = MQK + t0 * 1280 + (5 + h) * 128; s.k2 = nullptr; s.v = PL + t0 * 2560 + h * 128; s.o = F8_DUP ? (bf16_t*)((unsigned char*)(OCAT + t0 * D) + 768 + h * 128) : OCAT + t0 * D + 768 + h * 128; \
        s.ldq = 1280; s.ldk = 1280; s.ldv = 2560; ATT_U1(F.lds, F.tid, s, qb, ksum + ((size_t)b * 16 * 5 + h) * 128); }
    if ((ATT_MASK & 3) == 3 && (kmask & 3) == 3) {
        for (;;) { if (F.tid == 0) misc[4] = (int)__hip_atomic_fetch_add(ctl + CW_QUEUE + (qoff * 6 + l * 3 + 0) * 64, 1u, __ATOMIC_RELAXED, __HIP_MEMORY_SCOPE_AGENT);
            __syncthreads(); const int it = __builtin_amdgcn_readfirstlane(misc[4]); __syncthreads(); if (it >= 16 * NB * 11) break;
            const int lvl = it / (NB * 11), r_ = it - lvl * (NB * 11), qb = 15 - lvl; att::Src s;
            if (r_ < NB * 6) { const int b = r_ / 6, h = r_ - b * 6; const size_t t0 = (size_t)b * SEQ; ATT_SRC_MLA }
            else { const int rr = r_ - NB * 6, b = rr / 5, h = rr - b * 5; const size_t t0 = (size_t)b * SEQ; ATT_SRC_MOBA } }
    } else {
    if ((ATT_MASK & 1) && (kmask & 1)) ATT_QUEUE_LOOP(0, 6, ATT_SRC_MLA)
    if ((ATT_MASK & 2) && (kmask & 2)) ATT_QUEUE_LOOP(1, 5, ATT_SRC_MOBA)
    }
#undef ATT_SRC_MLA
#undef ATT_SRC_MOBA
    if ((ATT_MASK & 4) && (kmask & 4)) ATT_QUEUE_LOOP(2, 5, { s.q = PL + t0 * 2560 + 640 + h * 128; s.k = PL + t0 * 2560 + 1280 + h * 128; s.k2 = nullptr; s.v = PL + t0 * 2560 + 1920 + h * 128; s.o = OCAT + t0 * D + 1408 + h * 128;
        s.ldq = 2560; s.ldk = 2560; s.ldv = 2560; ATT_U2(F.lds, F.tid, s, qb, nullptr); })
#undef ATT_QUEUE_LOOP
}

constexpr int NPH = 26;
__global__ void __launch_bounds__(NTHR, 2) fwd(Params P) {
    extern __shared__ __attribute__((aligned(16))) unsigned char lds_[];
    int wave_id_ = __builtin_amdgcn_readfirstlane(threadIdx.x >> 6); asm volatile("" : "+s"(wave_id_));
    volatile LAS unsigned* MISC = (volatile LAS unsigned*)((LAS unsigned char*)lds_ + LDS_MISC);
    if (threadIdx.x < 32) MISC[threadIdx.x] = 0u;
    __syncthreads();
#if N_LAUNCH_MODE == 1
    constexpr int lo = 0, hi = 26;
#else
    const int lo = P.ph_lo, hi = P.ph_hi;
#endif
    XcdBarrier bar; bar.bar = (unsigned*)(P.ws + WS_CTL) + CW_BAR; bar.x = 0; bar.st = nullptr;
    if (hi - lo > 1) bar = xcd_barrier_post((unsigned*)(P.ws + WS_CTL) + CW_BAR, MISC + 8);
#ifndef PH_ONLY
#define PH_ONLY -1
#endif
#ifndef DUPMASK
#define DUPMASK 0
#endif
#ifndef PH_MASK
#define PH_MASK 0xffffffffu
#endif
#define IN(k) ((PH_ONLY < 0 || PH_ONLY == (k)) && ((PH_MASK >> ((k) >= 12 ? (k) - 11 : (k))) & 1u) && lo <= (k) && (k) < hi)
#ifdef TPROBE_A
#define STAMP(k) do { if (blockIdx.x == 0 && threadIdx.x == 0) ((unsigned long long*)((unsigned*)(P.ws + WS_CTL) + CW_TS))[(k)] = __builtin_amdgcn_s_memrealtime(); } while (0)
#else
#define STAMP(k) do { } while (0)
#endif
#define T0_HERE (wave_id_ == 0 && lane_id_now() == 0)
#ifndef DUP_BAR
#define DUP_BAR 0
#endif
#define SEAM(k) do { if (IN(k) && IN((k) + 1)) { xcd_barrier(bar, T0_HERE); if (DUP_BAR) xcd_barrier(bar, T0_HERE); } STAMP((k) + 1); } while (0)
#define OPQ KP_HERE FRAME_HERE unsigned char* ws = kp->ws; float* out = kp->out; unsigned* ctl = (unsigned*)(ws + WS_CTL); float* ctlf = (float*)(ws + WS_CTL); bf16_t* HB = (bf16_t*)(ws + WS_HB); \
        const int G = F.G, bid = F.bid; (void)ctl; (void)ctlf; (void)HB; (void)out; (void)G; (void)bid; \
        stat_t* stq = (stat_t*)(ctl + CW_STAT); stat_t* st_mix = stq + (ST_MIX * 2 + l) * T; stat_t* st_cq = stq + (ST_CQ * 2 + l) * T; stat_t* st_ckv = stq + (ST_CKV * 2 + l) * T; \
        stat_t* st_x = stq + (ST_X * 2 + l) * T; stat_t* st_ffn = stq + (ST_FFN * 2 + l) * T; stat_t* stq_dummy = (stat_t*)(ctl + 600000); bf16_t* hdummy = (bf16_t*)(ws + WS_R1 + 352 * MiB); (void)stq_dummy; (void)hdummy; (void)st_mix; (void)st_cq; (void)st_ckv; (void)st_x; (void)st_ffn;

    STAMP(0);
    if (IN(0)) { KP_HERE FRAME_HERE prologue(F, kp); } SEAM(0);
#ifdef DUP_PROLOGUE
    if (IN(0)) { KP_HERE FRAME_HERE prologue(F, kp); } SEAM(0);
#endif

    for (int l = 0; l < 2; ++l) {
        const int base = l ? 12 : 1;
        for (int rep_ = 0; rep_ < (((DUPMASK >> 1) & 1) ? 2 : 1); ++rep_) {
        if (IN(base + 0)) {
#ifndef NO_MEMKV
            if (l == 0) { OPQ constexpr bool XP = F8_XPRE && F8_XATTN; constexpr int EB = XP ? 1 : 2;
                pg8::SchedMemKV S{(const char*)(ws + WS_MEMN), (const char*)(ws + WS_WXK), (const char*)(ws + WS_WXV), G, (bid + 128) % G, EB};
                epi::EpiTwo E{(bf16_t*)(ws + WS_KMEM), (bf16_t*)(ws + WS_VMEMT), 2048, 2048, (size_t)1024 * D, XP ? 1.0f / F8_SW : 0.f, XP ? 1.0f / F8_SW : 0.f};
                pg8::gemm_phase<epi::EpiTwo, pg8::SchedMemKV, false, XP>(F.lds, F.tid, D * EB, D * EB, S, E); }
#endif
            constexpr bool AMM = F8_AMM && F8_GATES;
            { OPQ constexpr int EB = AMM ? 1 : 2;
              pg8::SchedGrid S{(const char*)(AMM ? ws + WS_HB8 : (unsigned char*)HB), (const char*)(AMM ? ws + WS_WIN8X + l * SZ_WE13 : ws + WS_WIN + l * SZ_WIN), D * EB, D * EB, 64, 5, 16 * EB, G, bid, 0};
              if (rep_) { st_cq = stq_dummy; st_ckv = stq_dummy + T; }
              epi::EpiIn<3> E{st_mix, (bf16_t*)(ws + WS_R1 + R1_ZC), (bf16_t*)(ws + WS_R1 + R1_KPE), (bf16_t*)(ws + WS_R1 + R1_MQK), (bf16_t*)(ws + WS_R1 + R1_PL), (bf16_t*)(ws + WS_R1 + R1_G),
                         st_cq, st_ckv, ctlf + CW_KSUM + l * KSUM_L, (const f32x2*)(ws + WS_CS128), (const f32x2*)(ws + WS_CS64), AMM ? 1.0f / (F8_SA * F8_SW) : 1.0f};
              pg8::gemm_phase<epi::EpiIn<3>, pg8::SchedGrid, false, AMM>(F.lds, F.tid, D * EB, D * EB, S, E); }
            if (AMM) {
            { OPQ pg8::SchedGrid S{(const char*)(ws + WS_HB8), (const char*)(ws + WS_WIN8X + l * SZ_WE13), D, D, 64, A8_TILES - 5, 16, G, (bid + G - 64) % G, 5};
              float* ksum_ = rep_ ? (float*)(stq_dummy + 2 * T) : ctlf + CW_KSUM + l * KSUM_L;
              epi::EpiIn<12> E{st_mix, (bf16_t*)(ws + WS_R1 + R1_ZC), (bf16_t*)(ws + WS_R1 + R1_KPE), (bf16_t*)(ws + WS_R1 + R1_MQK), (bf16_t*)(ws + WS_R1 + R1_PL), (bf16_t*)(ws + WS_R1 + R1_G),
                         st_cq, st_ckv, ksum_, (const f32x2*)(ws + WS_CS128), (const f32x2*)(ws + WS_CS64), 1.0f / (F8_SA * F8_SW)};
              pg8::gemm_phase<epi::EpiIn<12>, pg8::SchedGrid, false, true>(F.lds, F.tid, D, D, S, E); }
            { OPQ pg8::SchedGrid S{(const char*)HB, (const char*)(ws + WS_WIN + l * SZ_WIN), 4096, 4096, 64, 20 - A8_TILES, 32, G, (A8_TILES == 12) ? bid : (bid + G - 64) % G, A8_TILES};
              epi::EpiIn<8> E{st_mix, (bf16_t*)(ws + WS_R1 + R1_ZC), (bf16_t*)(ws + WS_R1 + R1_KPE), (bf16_t*)(ws + WS_R1 + R1_MQK), (bf16_t*)(ws + WS_R1 + R1_PL), (bf16_t*)(ws + WS_R1 + R1_G),
                         st_cq, st_ckv, nullptr, (const f32x2*)(ws + WS_CS128), (const f32x2*)(ws + WS_CS64), 1.0f};
              pg8::gemm_phase<epi::EpiIn<8>, pg8::SchedGrid>(F.lds, F.tid, 4096, 4096, S, E); }
            { OPQ pg8::SchedGrid S{(const char*)(ws + WS_HB8), (const char*)(ws + WS_WING8 + (size_t)l * 6144 * D) - (size_t)20 * 256 * D, 2048, 2048, 64, 24, 16, G, bid, 20};
              epi::EpiIn<16> E{st_mix, (bf16_t*)(ws + WS_R1 + R1_ZC), (bf16_t*)(ws + WS_R1 + R1_KPE), (bf16_t*)(ws + WS_R1 + R1_MQK), (bf16_t*)(ws + WS_R1 + R1_PL), (bf16_t*)(ws + WS_R1 + R1_G),
                         st_cq, st_ckv, nullptr, (const f32x2*)(ws + WS_CS128), (const f32x2*)(ws + WS_CS64), 1.0f / (F8_SA * F8_SW)};
              pg8::gemm_phase<epi::EpiIn<16>, pg8::SchedGrid, false, true>(F.lds, F.tid, 2048, 2048, S, E); }
            } else if (F8_GATES) {
            { OPQ pg8::SchedGrid S{(const char*)HB, (const char*)(ws + WS_WIN + l * SZ_WIN), 4096, 4096, 64, 15, 32, G, (bid + G - 64) % G, 5};
              float* ksum_ = rep_ ? (float*)(stq_dummy + 2 * T) : ctlf + CW_KSUM + l * KSUM_L;
              epi::EpiIn<12> E{st_mix, (bf16_t*)(ws + WS_R1 + R1_ZC), (bf16_t*)(ws + WS_R1 + R1_KPE), (bf16_t*)(ws + WS_R1 + R1_MQK), (bf16_t*)(ws + WS_R1 + R1_PL), (bf16_t*)(ws + WS_R1 + R1_G),
                         st_cq, st_ckv, ksum_, (const f32x2*)(ws + WS_CS128), (const f32x2*)(ws + WS_CS64), 1.0f};
              pg8::gemm_phase<epi::EpiIn<12>, pg8::SchedGrid>(F.lds, F.tid, 4096, 4096, S, E); }
            { OPQ pg8::SchedGrid S{(const char*)(ws + WS_HB8), (const char*)(ws + WS_WING8 + (size_t)l * 6144 * D) - (size_t)20 * 256 * D, 2048, 2048, 64, 24, 16, G, bid, 20};
              epi::EpiIn<16> E{st_mix, (bf16_t*)(ws + WS_R1 + R1_ZC), (bf16_t*)(ws + WS_R1 + R1_KPE), (bf16_t*)(ws + WS_R1 + R1_MQK), (bf16_t*)(ws + WS_R1 + R1_PL), (bf16_t*)(ws + WS_R1 + R1_G),
                         st_cq, st_ckv, nullptr, (const f32x2*)(ws + WS_CS128), (const f32x2*)(ws + WS_CS64), 1.0f / (F8_SA * F8_SW)};
              pg8::gemm_phase<epi::EpiIn<16>, pg8::SchedGrid, false, true>(F.lds, F.tid, 2048, 2048, S, E); }
            } else {
            { OPQ pg8::SchedGrid S{(const char*)HB, (const char*)(ws + WS_WIN + l * SZ_WIN), 4096, 4096, 64, 39, 32, G, (bid + G - 64) % G, 5};
              float* ksum_ = rep_ ? (float*)(stq_dummy + 2 * T) : ctlf + CW_KSUM + l * KSUM_L;
              epi::EpiIn<28> E{st_mix, (bf16_t*)(ws + WS_R1 + R1_ZC), (bf16_t*)(ws + WS_R1 + R1_KPE), (bf16_t*)(ws + WS_R1 + R1_MQK), (bf16_t*)(ws + WS_R1 + R1_PL), (bf16_t*)(ws + WS_R1 + R1_G),
                         st_cq, st_ckv, ksum_, (const f32x2*)(ws + WS_CS128), (const f32x2*)(ws + WS_CS64), 1.0f};
              pg8::gemm_phase<epi::EpiIn<28>, pg8::SchedGrid>(F.lds, F.tid, 4096, 4096, S, E); }
            }
        }
        SEAM(base + 0);
        }
        for (int rep_ = 0; rep_ < (((DUPMASK >> 2) & 1) ? 2 : 1); ++rep_) {
        if (IN(base + 1)) {
            if (l == 0) { OPQ constexpr bool XP = F8_XPRE && F8_XATTN; constexpr int EB = XP ? 1 : 2;
                pg8::SchedXPre S{(const char*)(ws + WS_KMEM), (const char*)(ws + WS_VMEMT), (const char*)(ws + WS_WXQ), (const char*)(ws + WS_WXO), G, bid, EB};
                epi::EpiTwo E{(bf16_t*)(ws + WS_MT), (bf16_t*)(ws + WS_NT), 2048, 1024, 0, XP ? F8_SM / (F8_SX * F8_SWQ) : (F8_XATTN ? F8_SM : 0.f), XP ? F8_SN / (F8_SW * F8_SX) : (F8_XATTN ? F8_SN : 0.f)};
                pg8::gemm_phase<epi::EpiTwo, pg8::SchedXPre, false, XP>(F.lds, F.tid, D * EB, D * EB, S, E); }
            if (F8_DUP && !rep_) { OPQ
              unsigned z_ = 0u; asm volatile("" : "+v"(z_));
              for (int j = bid * NTHR + F.tid; j < T * 8; j += G * NTHR) *(u32x4*)(ws + WS_R2 + R2_OCAT + (size_t)(j >> 3) * (2 * D) + 1408 + 16 * (j & 7)) = (u32x4){z_, z_, z_, z_}; }
            { OPQ constexpr int EB = F8_B ? 1 : 2;
              pg8::SchedGrid S{(const char*)(ws + WS_R1 + R1_ZC), (const char*)(ws + WS_WUQ + l * SZ_WUQ), 1024 * EB, 512 * EB, 64, 5, 4 * EB, G, bid, 0};
              epi::EpiUQ E{(bf16_t*)(ws + WS_R2 + R2_QA), st_cq, (const f32x2*)(ws + WS_CS64), F8_B ? 1.0f / (F8_SZ * F8_SW) : 1.0f};
              pg8::gemm_phase<epi::EpiUQ, pg8::SchedGrid, false, F8_B>(F.lds, F.tid, 1024 * EB, 512 * EB, S, E); }
            { OPQ constexpr int EB = F8_B ? 1 : 2;
              pg8::SchedGrid S{(const char*)(ws + WS_R1 + R1_ZC) + 512 * EB, (const char*)(ws + WS_WUKV + l * SZ_WUKV), 1024 * EB, 512 * EB, 64, 6, 4 * EB, G, (bid + G - 64) % G, 0};
              epi::EpiPlain E{(bf16_t*)(ws + WS_R2 + R2_KVA), 1536, st_ckv, 1.0f / 512, F8_B ? 1.0f / (F8_SZ * F8_SW) : 1.0f};
              pg8::gemm_phase<epi::EpiPlain, pg8::SchedGrid, false, F8_B>(F.lds, F.tid, 1024 * EB, 512 * EB, S, E); }
        }
        SEAM(base + 1);
        }
        if (IN(base + 2)) { KP_HERE FRAME_HERE attn_phase(F, kp, l); }
        SEAM(base + 2);
#ifdef DUP_ATTN
        if (IN(base + 2)) { KP_HERE FRAME_HERE attn_phase<ATT_DBG>(F, kp, l, 1, DUP_ATTN); }
        SEAM(base + 2);
#endif
        for (int rep_ = 0; rep_ < (((DUPMASK >> 4) & 1) ? 2 : 1); ++rep_) {
        if (IN(base + 3)) {
            OPQ
            pg8::SchedUp S{(const char*)(ws + WS_R2 + R2_OCAT), (const char*)(ws + WS_WUP + l * SZ_SQ), G, bid};
            epi::EpiUp E{(const unsigned char*)(ws + WS_R1 + R1_G), (bf16_t*)(ws + WS_R2 + R2_MERGED)};
            pg8::gemm_phase<epi::EpiUp, pg8::SchedUp, false, false, false, F8_DUP>(F.lds, F.tid, 4096, 4096, S, E);
        }
        SEAM(base + 3);
        }
        for (int rep_ = 0; rep_ < (((DUPMASK >> 5) & 1) ? 2 : 1); ++rep_) {
        if (IN(base + 4)) {
            OPQ
            pg8::SchedGrid S{(const char*)(ws + WS_R2 + R2_MERGED), (const char*)(ws + WS_WO + l * SZ_SQ), 4096, 4096, 64, 8, 32, G, bid, 0};
            epi::EpiRes E{rep_ ? hdummy : HB, rep_ ? stq_dummy : st_x, (F8_XATTN && !rep_) ? ws + WS_HB8 : nullptr, 1.0f};
            pg8::gemm_phase<epi::EpiRes, pg8::SchedGrid>(F.lds, F.tid, 4096, 4096, S, E);
        }
        SEAM(base + 4);
        }
        for (int rep_ = 0; rep_ < (((DUPMASK >> 7) & 1) ? 2 : 1); ++rep_) {
        if (IN(base + 6)) {
            OPQ
            constexpr int EB = F8_XATTN ? 1 : 2;
            pg8::SchedXS2 S{(const char*)(F8_XATTN ? ws + WS_HB8 : (unsigned char*)HB), (const char*)(ws + WS_MT), l, G, bid, EB};
            epi::EpiXS E{(bf16_t*)(ws + WS_R2 + R2_PX), (LAS float*)(F.lds + LDS_EPI), st_x, F8_XATTN ? 1.0f / (F8_SA * F8_SM) : 1.0f, F8_XATTN ? F8_SP : 0.f};
            pg8::gemm_phase<epi::EpiXS, pg8::SchedXS2, true, F8_XATTN>(F.lds, F.tid, D * EB, D * EB, S, E);
        }
        SEAM(base + 6);
        }
        for (int rep_ = 0; rep_ < (((DUPMASK >> 9) & 1) ? 2 : 1); ++rep_) {
        if (IN(base + 8)) {
            OPQ
            constexpr int EB = F8_XATTN ? 1 : 2;
            pg8::SchedXO S{(const char*)(ws + WS_R2 + R2_PX), (const char*)(ws + WS_NT), l, G, bid, EB};
            epi::EpiRes E{rep_ ? hdummy : HB, rep_ ? stq_dummy : st_ffn, (l == 0 && F8_DENSE) ? ws + WS_HB8 : nullptr, F8_XATTN ? 1.0f / (F8_SP * F8_SN) : 1.0f};
            pg8::gemm_phase<epi::EpiRes, pg8::SchedXO, false, F8_XATTN>(F.lds, F.tid, 1024 * EB, 1024 * EB, S, E);
        }
        SEAM(base + 8);
        }
        if (l == 0) {
            for (int rep_ = 0; rep_ < (((DUPMASK >> 10) & 1) ? 2 : 1); ++rep_) {
        if (IN(10)) {
                OPQ
                constexpr int EB = F8_DENSE ? 1 : 2;
                pg8::SchedGrid S{(const char*)(F8_DENSE ? ws + WS_HB8 : (unsigned char*)HB), (const char*)(ws + WS_WFF13), D * EB, D * EB, 64, 44, 16 * EB, G, bid, 0};
                epi::EpiSwiglu<(F8_DENSE || F8_DDOWN)> E{ws + WS_R1 + R1_ACT, DFF, st_ffn, F8_DENSE ? 1.0f / (F8_SA * F8_SW) : 1.0f};
                pg8::gemm_phase<epi::EpiSwiglu<(F8_DENSE || F8_DDOWN)>, pg8::SchedGrid, false, F8_DENSE>(F.lds, F.tid, D * EB, D * EB, S, E);
            }
            SEAM(10);
        }
            for (int rep_ = 0; rep_ < (((DUPMASK >> 11) & 1) ? 2 : 1); ++rep_) {
        if (IN(11)) {
                OPQ
                constexpr bool F8K = F8_DENSE || F8_DDOWN; constexpr int EB = F8K ? 1 : 2;
                pg8::SchedGrid S{(const char*)(ws + WS_R1 + R1_ACT), (const char*)(ws + WS_WFF2), DFF * EB, DFF * EB, 64, 8, DFF * EB / 128, G, bid, 0};
                epi::EpiRes E{rep_ ? hdummy : HB, rep_ ? stq_dummy : stq + (ST_MIX * 2 + 1) * T, (F8_GATES && !rep_) ? ws + WS_HB8 : nullptr, F8K ? 1.0f / (F8_SA * F8_SW) : 1.0f};
                pg8::gemm_phase<epi::EpiRes, pg8::SchedGrid, false, F8K>(F.lds, F.tid, DFF * EB, DFF * EB, S, E);
            }
            SEAM(11);
        }
        } else {
            for (int rep_ = 0; rep_ < (((DUPMASK >> 21) & 1) ? 2 : 1); ++rep_) {
            if (IN(21)) { KP_HERE FRAME_HERE moe_router(F, kp, rep_); }
            SEAM(21); }
            if (IN(22)) { KP_HERE FRAME_HERE moe_assign_gather(F, kp); }
            SEAM(22);
            for (int rep_ = 0; rep_ < (((DUPMASK >> 12) & 1) ? 2 : 1); ++rep_) {
        if (IN(23)) {
                OPQ
                pg8::SchedMoE S; S.A = (const char*)(ws + WS_R2 + R2_XS); S.Bt = (const char*)(ws + WS_WE13); constexpr int EB = F8_MOE ? 1 : 2; S.lda = D * EB; S.nN = 56; S.nt = 16 * EB; S.G = G; S.c = bid; S.wstride = SZ_WE13; S.init_counts(ctl + CW_MOE);
                epi::EpiSwiglu<F8_MOE> E{ws + WS_R1 + R1_ACTE, DFE, nullptr, F8_MOE ? 1.0f / (F8_SX * F8_SW) : 1.0f};
                pg8::gemm_phase<epi::EpiSwiglu<F8_MOE>, pg8::SchedMoE, false, F8_MOE>(F.lds, F.tid, D * EB, D * EB, S, E);
            }
            SEAM(23);
        }
            for (int rep_ = 0; rep_ < (((DUPMASK >> 13) & 1) ? 2 : 1); ++rep_) {
        if (IN(24)) {
                OPQ
                constexpr int EB = F8_MOE ? 1 : 2;
                if constexpr (MOE_TAIL && F8_MOE) {
                pg8::SchedMoEDown S; S.A = (const char*)(ws + WS_R1 + R1_ACTE); S.Bt = (const char*)(ws + WS_WE2); S.lda = DFE; S.G = G; S.c = bid; S.wstride = SZ_WE2; S.init_counts(ctl + CW_MOE);
                epi::EpiMoeDown E{(bf16_t*)(ws + WS_R2 + R2_YS), (bf16_t*)(ws + WS_R2 + R2_YP), S.nb_main * 256, (size_t)(S.nused - S.nb_main) * 256 * D, 1.0f / (F8_SA * F8_SW)};
                pg8::gemm_phase<epi::EpiMoeDown, pg8::SchedMoEDown, false, true>(F.lds, F.tid, DFE, DFE, S, E);
                } else {
                pg8::SchedMoE S; S.A = (const char*)(ws + WS_R1 + R1_ACTE); S.Bt = (const char*)(ws + WS_WE2); S.lda = DFE * EB; S.nN = 8; S.nt = DFE * EB / 128; S.G = G; S.c = bid; S.wstride = SZ_WE2; S.init_counts(ctl + CW_MOE);
                epi::EpiPlain E{(bf16_t*)(ws + WS_R2 + R2_YS), 2048, nullptr, 0.f, F8_MOE ? 1.0f / (F8_SA * F8_SW) : 1.0f};
                pg8::gemm_phase<epi::EpiPlain, pg8::SchedMoE, false, F8_MOE>(F.lds, F.tid, DFE * EB, DFE * EB, S, E); }
            }
            SEAM(24);
        }
            for (int rep_ = 0; rep_ < (((DUPMASK >> 25) & 1) ? 2 : 1); ++rep_) { if (rep_) xcd_barrier(bar, T0_HERE);
            if (IN(25)) { KP_HERE FRAME_HERE moe_combine_final(F, kp); } }
        }
    }
#ifdef TPROBE_A
    xcd_barrier(bar, T0_HERE); STAMP(26);
    xcd_barrier(bar, T0_HERE);
    { const unsigned long long* ts = (const unsigned long long*)((unsigned*)(P.ws + WS_CTL) + CW_TS);
      unsigned long long ta = 0, tb = 0;
      for (int k = 0; k < 26; ++k) { const unsigned long long d = __hip_atomic_load(ts + k + 1, __ATOMIC_RELAXED, __HIP_MEMORY_SCOPE_AGENT) - __hip_atomic_load(ts + k, __ATOMIC_RELAXED, __HIP_MEMORY_SCOPE_AGENT);
          if ((TPROBE_A >> k) & 1) ta += d; if ((TPROBE_B >> k) & 1) tb += d; }
      const float k2 = (float)ta * 0.01f, k1 = (float)tb * 10.0f;
      for (size_t i = (size_t)blockIdx.x * NTHR + threadIdx.x; i < (size_t)T * D; i += (size_t)gridDim.x * NTHR) P.out[i] = (i == 0) ? k1 : k2; }
#endif
#undef IN
#undef SEAM
#undef OPQ
}

extern "C" void kernel_launch(void* const* d_in, const int* in_sizes, int n_in, void* d_out, int out_size, void* d_ws, size_t ws_size, hipStream_t stream) {
    static int grid = 0;
    if (grid == 0) {
        if (n_in != 28 || out_size != T * D || ws_size < WS_END) { fprintf(stderr, "kernel_launch: unexpected shapes (n_in %d, out %d, ws %zu, need %zu)\n", n_in, out_size, ws_size, (size_t)WS_END); grid = -1; return; }
        int dev = 0, cus = 0, per_cu = 0;
        if (hipGetDevice(&dev) != hipSuccess || hipDeviceGetAttribute(&cus, hipDeviceAttributeMultiprocessorCount, dev) != hipSuccess) { grid = -1; return; }
        if (hipFuncSetAttribute((const void*)fwd, hipFuncAttributeMaxDynamicSharedMemorySize, LDS_BYTES) != hipSuccess) { fprintf(stderr, "kernel_launch: hipFuncSetAttribute failed\n"); grid = -1; return; }
        if (hipOccupancyMaxActiveBlocksPerMultiprocessor(&per_cu, (const void*)fwd, NTHR, LDS_BYTES) != hipSuccess || per_cu < 1) { fprintf(stderr, "kernel_launch: occupancy query says %d\n", per_cu); grid = -1; (void)hipGetLastError(); return; }
        grid = cus;
    }
    if (grid < 0) return;
    (void)hipMemsetAsync((char*)d_ws + WS_CTL, 0, CTL_BYTES, stream);
    Params p{};
    p.x = (const float*)d_in[0]; p.mem = (const float*)d_in[1]; p.positions = (const int*)d_in[2];
    p.g_mix = (const float*)d_in[3]; p.w_in = (const float*)d_in[4]; p.g_cq = (const float*)d_in[5]; p.g_ckv = (const float*)d_in[6]; p.w_uq = (const float*)d_in[7]; p.w_ukv = (const float*)d_in[8];
    p.w_up_a = (const float*)d_in[9]; p.w_up_b = (const float*)d_in[10]; p.w_up_c = (const float*)d_in[11]; p.w_o = (const float*)d_in[12]; p.g_x = (const float*)d_in[13]; p.g_mem = (const float*)d_in[14];
    p.w_xq = (const float*)d_in[15]; p.w_xk = (const float*)d_in[16]; p.w_xv = (const float*)d_in[17]; p.w_xo = (const float*)d_in[18]; p.g_ffn = (const float*)d_in[19];
    p.w_ff1 = (const float*)d_in[20]; p.w_ff3 = (const float*)d_in[21]; p.w_ff2 = (const float*)d_in[22]; p.w_router = (const float*)d_in[23]; p.w_e1 = (const float*)d_in[24]; p.w_e3 = (const float*)d_in[25];
    p.w_e2 = (const float*)d_in[26]; p.g_final = (const float*)d_in[27];
    p.out = (float*)d_out; p.ws = (unsigned char*)d_ws;
#if N_LAUNCH_MODE == 1
    p.ph_lo = 0; p.ph_hi = NPH;
    hipLaunchKernelGGL(fwd, dim3(grid), dim3(NTHR), LDS_BYTES, stream, p);
#else
    for (int ph = 0; ph < NPH; ++ph) { p.ph_lo = ph; p.ph_hi = ph + 1; hipLaunchKernelGGL(fwd, dim3(grid), dim3(NTHR), LDS_BYTES, stream, p); }
#endif
}
```
